# Optimizing an MI355X kernel written in HIP

```python
import jax, jax.numpy as jnp
from jax import lax
import numpy as np

D_MODEL = 2048
BATCH = 2
SEQ = 4096
DEPTH = 4

GRID_W = 64
RET_HEADS = 8
RET_DK = 128
RET_DV = 128
RET_CHUNK = 128
ROPE_THETA = 10000.0
NA_HEADS = 8
NA_DH = 128
NA_WIN_ROWS = 8
NA_WIN_COLS = 16
SC_WIDTH = 1024
SC_WIDTH_K = 3
CF_WIDTH = 1024
CF_WIDTH_K = 31
D_FF = 4 * D_MODEL
N_BRANCH = 4
EPS = 1e-6

IN_SPLITS = (RET_HEADS * RET_DK, RET_HEADS * RET_DK, RET_HEADS * RET_DV, RET_HEADS * RET_DV,
             NA_HEADS * NA_DH, NA_HEADS * NA_DH, NA_HEADS * NA_DH,
             SC_WIDTH, SC_WIDTH, SC_WIDTH,
             2 * CF_WIDTH,
             N_BRANCH * D_MODEL)
D_IN = (2 * RET_HEADS * RET_DK + 2 * RET_HEADS * RET_DV + 3 * NA_HEADS * NA_DH
        + 3 * SC_WIDTH + 2 * CF_WIDTH + N_BRANCH * D_MODEL)

kernel_name = "hybrid_gated_branch_encoder"


def rms_norm(x, g):
    xf = x.astype(jnp.float32)
    y = xf * lax.rsqrt(jnp.mean(xf * xf, axis=-1, keepdims=True) + EPS)
    return (y * g.astype(jnp.float32)).astype(x.dtype)


def layer_norm(x, g, b):
    xf = x.astype(jnp.float32)
    mu = jnp.mean(xf, axis=-1, keepdims=True)
    var = jnp.mean(jnp.square(xf - mu), axis=-1, keepdims=True)
    y = (xf - mu) * lax.rsqrt(var + EPS)
    return (y * g.astype(jnp.float32) + b.astype(jnp.float32)).astype(x.dtype)


def split_cols(z, sizes):
    outs, start = [], 0
    for s in sizes:
        outs.append(z[..., start:start + s])
        start += s
    return outs


def rope(x, pos):
    half = x.shape[-1] // 2
    inv = ROPE_THETA ** (-jnp.arange(half, dtype=jnp.float32) / half)
    ang = pos.astype(jnp.float32)[:, None] * inv[None, :]
    cos = jnp.cos(ang)[None, :, None, :]
    sin = jnp.sin(ang)[None, :, None, :]
    x1 = x[..., :half].astype(jnp.float32)
    x2 = x[..., half:].astype(jnp.float32)
    return jnp.concatenate([x1 * cos - x2 * sin, x1 * sin + x2 * cos], axis=-1)


def depthwise_conv(x, w):
    k = w.shape[0]
    return lax.conv_general_dilated(
        x, w[:, None, :].astype(x.dtype), (1,), [(k // 2, k // 2)],
        dimension_numbers=('NWC', 'WIO', 'NWC'), feature_group_count=x.shape[-1])


def retention_scan(q, k, v, log_gamma, include_diag):
    b, t, h, dk = q.shape
    dv = v.shape[-1]
    c = RET_CHUNK
    n = t // c
    qc = q.reshape(b, n, c, h, dk).transpose(1, 0, 3, 2, 4)
    kc = k.reshape(b, n, c, h, dk).transpose(1, 0, 3, 2, 4)
    vc = v.reshape(b, n, c, h, dv).transpose(1, 0, 3, 2, 4)
    j = jnp.arange(c, dtype=jnp.float32)
    diff = j[:, None] - j[None, :]
    mask = (diff >= 0) if include_diag else (diff > 0)
    inner_decay = jnp.where(mask[None], jnp.exp(log_gamma[:, None, None] * jnp.where(mask, diff, 0.0)[None]), 0.0)
    q_decay = jnp.exp(log_gamma[:, None] * (j[None, :] + 1.0))
    k_decay = jnp.exp(log_gamma[:, None] * (c - 1.0 - j[None, :]))
    chunk_decay = jnp.exp(log_gamma * c)

    def step(state, xs):
        qi, ki, vi = xs
        s = jnp.einsum('bhqd,bhkd->bhqk', qi, ki) * inner_decay
        inner = jnp.einsum('bhqk,bhkv->bhqv', s, vi)
        cross = jnp.einsum('bhqd,bhdv->bhqv', qi * q_decay[..., None], state)
        state = chunk_decay[:, None, None] * state + jnp.einsum('bhkd,bhkv->bhdv', ki * k_decay[..., None], vi)
        return state, inner + cross

    state0 = jnp.zeros((b, h, dk, dv), jnp.float32)
    _, out = lax.scan(step, state0, (qc, kc, vc))
    return out.transpose(1, 0, 3, 2, 4).reshape(b, t, h, dv)


def retention_branch(rq, rk, rv, rg, decay_logit_f, decay_logit_b, pos):
    b, t, _ = rq.shape
    q = rope(rq.reshape(b, t, RET_HEADS, RET_DK), pos)
    k = rope(rk.reshape(b, t, RET_HEADS, RET_DK), pos) * (RET_DK ** -0.5)
    v = rv.reshape(b, t, RET_HEADS, RET_DV).astype(jnp.float32)
    lg_f = jax.nn.log_sigmoid(decay_logit_f.astype(jnp.float32))
    lg_b = jax.nn.log_sigmoid(decay_logit_b.astype(jnp.float32))
    y_f = retention_scan(q, k, v, lg_f, True)
    y_b = jnp.flip(retention_scan(jnp.flip(q, 1), jnp.flip(k, 1), jnp.flip(v, 1), lg_b, False), 1)
    y = y_f + y_b
    mu = jnp.mean(y, axis=-1, keepdims=True)
    var = jnp.mean(jnp.square(y - mu), axis=-1, keepdims=True)
    y = ((y - mu) * lax.rsqrt(var + EPS)).reshape(b, t, RET_HEADS * RET_DV)
    return jax.nn.silu(rg) * y.astype(rg.dtype)


def neighborhood_attention(nq, nk, nv, rpb):
    b, t, _ = nq.shape
    rows = t // GRID_W
    kr = min(NA_WIN_ROWS, rows)
    kc = NA_WIN_COLS
    qg = nq.reshape(b, rows, GRID_W, NA_HEADS, NA_DH)
    kg = nk.reshape(b, rows, GRID_W, NA_HEADS, NA_DH)
    vg = nv.reshape(b, rows, GRID_W, NA_HEADS, NA_DH)
    cols = jnp.arange(GRID_W)
    col_start = jnp.clip(cols - kc // 2, 0, GRID_W - kc)
    col_idx = col_start[:, None] + jnp.arange(kc)[None, :]
    dc = col_idx - cols[:, None] + (NA_WIN_COLS - 1)
    rpb32 = rpb.astype(jnp.float32)
    scale = NA_DH ** -0.5

    def one_row(r):
        row_start = jnp.clip(r - kr // 2, 0, rows - kr)
        q_r = lax.dynamic_index_in_dim(qg, r, axis=1, keepdims=False)
        k_rows = lax.dynamic_slice_in_dim(kg, row_start, kr, axis=1)
        v_rows = lax.dynamic_slice_in_dim(vg, row_start, kr, axis=1)
        k_win = k_rows[:, :, col_idx]
        v_win = v_rows[:, :, col_idx]
        dr = row_start + jnp.arange(kr) - r + (NA_WIN_ROWS - 1)
        bias = rpb32[:, dr[:, None, None], dc[None, :, :]]
        s = jnp.einsum('bqhd,brqkhd->bhqrk', q_r, k_win).astype(jnp.float32) * scale
        s = s + bias.transpose(0, 2, 1, 3)[None]
        p = jax.nn.softmax(s.reshape(b, NA_HEADS, GRID_W, kr * kc), axis=-1)
        p = p.reshape(b, NA_HEADS, GRID_W, kr, kc).astype(v_win.dtype)
        return jnp.einsum('bhqrk,brqkhd->bqhd', p, v_win)

    out = lax.map(one_row, jnp.arange(rows))
    return out.transpose(1, 0, 2, 3, 4).reshape(b, t, NA_HEADS * NA_DH)


def hybrid_mixer(h, w_in, dec_f, dec_b, rpb, sc_w, cf_w, cf_g, cf_b, w_ret_o, w_na_o, w_sc_o, w_cf_o, w_o, pos):
    b, t, _ = h.shape
    z = jnp.einsum('btd,de->bte', h, w_in)
    rq, rk, rv, rg, nq, nk, nv, s_b, s_c, s_x, c_glu, g_br = split_cols(z, IN_SPLITS)
    y_ret = retention_branch(rq, rk, rv, rg, dec_f, dec_b, pos)
    y_na = neighborhood_attention(nq, nk, nv, rpb)
    y_sc = s_b * depthwise_conv(s_c * s_x, sc_w)
    a, g = jnp.split(c_glu, 2, axis=-1)
    y_cf = jax.nn.silu(layer_norm(depthwise_conv(a * jax.nn.sigmoid(g), cf_w), cf_g, cf_b))
    gates = jax.nn.sigmoid(g_br.reshape(b, t, N_BRANCH, D_MODEL))
    merged = (gates[:, :, 0] * jnp.einsum('btk,kd->btd', y_ret, w_ret_o)
              + gates[:, :, 1] * jnp.einsum('btk,kd->btd', y_na, w_na_o)
              + gates[:, :, 2] * jnp.einsum('btk,kd->btd', y_sc, w_sc_o)
              + gates[:, :, 3] * jnp.einsum('btk,kd->btd', y_cf, w_cf_o))
    return jnp.einsum('btd,de->bte', merged, w_o)


def setup_inputs(seed: int = 0) -> dict:
    key = jax.random.key(seed)
    ks = jax.random.split(key, 24)
    f32 = jnp.float32
    nrm = lambda k, shape, s: jax.random.normal(k, shape, f32) * s
    base_logit = jnp.log(2.0 ** (5.0 + jnp.arange(RET_HEADS, dtype=f32)) - 1.0)
    return {
        "x": nrm(ks[0], (BATCH, SEQ, D_MODEL), 1.0),
        "c": nrm(ks[1], (BATCH, D_MODEL), 1.0),
        "w_ada": nrm(ks[2], (DEPTH, D_MODEL, 6 * D_MODEL), D_MODEL ** -0.5),
        "b_ada": nrm(ks[3], (DEPTH, 6 * D_MODEL), 0.02),
        "g_pre_mix": 1.0 + nrm(ks[4], (DEPTH, D_MODEL), 0.05),
        "g_post_mix": 1.0 + nrm(ks[5], (DEPTH, D_MODEL), 0.05),
        "g_pre_mlp": 1.0 + nrm(ks[6], (DEPTH, D_MODEL), 0.05),
        "g_post_mlp": 1.0 + nrm(ks[7], (DEPTH, D_MODEL), 0.05),
        "w_in": nrm(ks[8], (DEPTH, D_MODEL, D_IN), D_MODEL ** -0.5),
        "ret_decay_fwd": base_logit[None] + nrm(ks[9], (DEPTH, RET_HEADS), 0.1),
        "ret_decay_bwd": base_logit[None] + nrm(ks[10], (DEPTH, RET_HEADS), 0.1),
        "na_rpb": nrm(ks[11], (DEPTH, NA_HEADS, 2 * NA_WIN_ROWS - 1, 2 * NA_WIN_COLS - 1), 0.1),
        "sc_conv": nrm(ks[12], (DEPTH, SC_WIDTH_K, SC_WIDTH), SC_WIDTH_K ** -0.5),
        "cf_conv": nrm(ks[13], (DEPTH, CF_WIDTH_K, CF_WIDTH), CF_WIDTH_K ** -0.5),
        "cf_ln_g": 1.0 + nrm(ks[14], (DEPTH, CF_WIDTH), 0.05),
        "cf_ln_b": nrm(ks[15], (DEPTH, CF_WIDTH), 0.02),
        "w_ret_o": nrm(ks[16], (DEPTH, RET_HEADS * RET_DV, D_MODEL), (RET_HEADS * RET_DV) ** -0.5),
        "w_na_o": nrm(ks[17], (DEPTH, NA_HEADS * NA_DH, D_MODEL), (NA_HEADS * NA_DH) ** -0.5),
        "w_sc_o": nrm(ks[18], (DEPTH, SC_WIDTH, D_MODEL), SC_WIDTH ** -0.5),
        "w_cf_o": nrm(ks[19], (DEPTH, CF_WIDTH, D_MODEL), CF_WIDTH ** -0.5),
        "w_o": nrm(ks[20], (DEPTH, D_MODEL, D_MODEL), D_MODEL ** -0.5),
        "w_ff1": nrm(ks[21], (DEPTH, D_MODEL, D_FF), D_MODEL ** -0.5),
        "w_ff2": nrm(ks[22], (DEPTH, D_FF, D_MODEL), D_FF ** -0.5),
    }


def reference(x, c, w_ada, b_ada, g_pre_mix, g_post_mix, g_pre_mlp, g_post_mlp, w_in,
              ret_decay_fwd, ret_decay_bwd, na_rpb, sc_conv, cf_conv, cf_ln_g, cf_ln_b,
              w_ret_o, w_na_o, w_sc_o, w_cf_o, w_o, w_ff1, w_ff2):
    t = x.shape[1]
    pos = jnp.arange(t, dtype=jnp.int32)
    c_act = jax.nn.silu(c)
    for l in range(DEPTH):
        mod = jnp.einsum('bd,de->be', c_act, w_ada[l]) + b_ada[l]
        sh1, sc1, ga1, sh2, sc2, ga2 = jnp.split(mod[:, None, :], 6, axis=-1)
        h = rms_norm(x, g_pre_mix[l]) * (1 + sc1) + sh1
        y = hybrid_mixer(h, w_in[l], ret_decay_fwd[l], ret_decay_bwd[l], na_rpb[l], sc_conv[l], cf_conv[l],
                         cf_ln_g[l], cf_ln_b[l], w_ret_o[l], w_na_o[l], w_sc_o[l], w_cf_o[l], w_o[l], pos)
        x = x + ga1 * rms_norm(y, g_post_mix[l])
        h = rms_norm(x, g_pre_mlp[l]) * (1 + sc2) + sh2
        u = jnp.square(jax.nn.relu(jnp.einsum('btd,df->btf', h, w_ff1[l])))
        y = jnp.einsum('btf,fd->btd', u, w_ff2[l])
        x = x + ga2 * rms_norm(y, g_post_mlp[l])
    return x
```

```cpp
#include <hip/hip_runtime.h>
#include <cstdio>
#include <cstdint>

#define LAS __attribute__((address_space(3)))
#define GAS __attribute__((address_space(1)))
#ifndef MK_SINGLE_LAUNCH
#define MK_SINGLE_LAUNCH 0
#endif

typedef unsigned short bf16;
typedef short bf16x8 __attribute__((ext_vector_type(8)));
typedef float f32x4 __attribute__((ext_vector_type(4)));
typedef float f32x2 __attribute__((ext_vector_type(2)));
typedef unsigned u32x4 __attribute__((ext_vector_type(4)));
typedef unsigned u32x2 __attribute__((ext_vector_type(2)));

__device__ __forceinline__ unsigned pk_bf16(float lo, float hi) { unsigned r; asm("v_cvt_pk_bf16_f32 %0, %1, %2" : "=v"(r) : "v"(lo), "v"(hi)); return r; }
__device__ __forceinline__ float bf_lo(unsigned w) { return __uint_as_float(w << 16); }
__device__ __forceinline__ float bf_hi(unsigned w) { return __uint_as_float(w & 0xffff0000u); }
__device__ __forceinline__ float fsigmoid(float x) { return __builtin_amdgcn_rcpf(1.0f + __expf(-x)); }
__device__ __forceinline__ float wave_sum(float v) {
#pragma unroll
    for (int o = 1; o < 64; o <<= 1) v += __shfl_xor(v, o);
    return v;
}
#define MFMA16(a, b, c) __builtin_amdgcn_mfma_f32_16x16x32_bf16((a), (b), (c), 0, 0, 0)
#define LDS_WAIT() asm volatile("s_waitcnt lgkmcnt(0)" ::: "memory")
#define VM_WAIT() asm volatile("s_waitcnt vmcnt(0)" ::: "memory")

namespace pg8 {
#define PG8_LAS __attribute__((address_space(3)))
typedef unsigned short bf16_t;
constexpr int BM = 256, BK = 64, HALF = 128, HTB = HALF * BK * 2, STAGE_BYTES = 8 * HTB, NXCD = 8, WGM = 8;

__host__ __device__ __forceinline__ int lds_byte(int r, int c) { const int st = (r >> 4) * 2 + (c >> 5), rr = r & 15, cc = c & 31, ob = rr * 64 + cc * 2; return st * 1024 + (ob ^ (((ob >> 9) & 1) << 5)); }
__host__ __device__ __forceinline__ void stage_rc(int b, int& R, int& C) { const int st = b / 1024, sb = b % 1024, swz = sb ^ (((sb >> 9) & 1) << 5); R = (st >> 1) * 16 + swz / 64; C = (st & 1) * 32 + (swz % 64) / 2; }
__host__ __device__ __forceinline__ int perm32(int rho) { const int n = rho >> 4, i = rho & 15; return 8 * (i >> 2) + 4 * n + (i & 3); }

struct Unit { int pm, pn; };
struct Gemm { const bf16_t* A; const bf16_t* Bt; int M, N, K; };

struct StaticOrder {
    int nM, nN, nwg, G, c;
    __host__ __device__ void init(int M, int N, int G_, int c_) { nM = M / BM; nN = N / BM; nwg = nM * nN; G = G_; c = c_; }
    __host__ __device__ bool next(int i, Unit& u) const {
        const long L = (long)i * G + c; if (L >= nwg) return false;
        int wgid = (int)L; { const int q = nwg / NXCD, r = nwg % NXCD, xcd = wgid % NXCD, off = wgid / NXCD; wgid = (xcd < r ? xcd * (q + 1) : r * (q + 1) + (xcd - r) * q) + off; }
        const int nig = WGM * nN, gid = wgid / nig, fm = gid * WGM, gsz = (nM - fm) < WGM ? (nM - fm) : WGM;
        u.pm = fm + ((wgid % nig) % gsz); u.pn = (wgid % nig) / gsz; return true;
    }
    __device__ __forceinline__ void a_ready(const Unit&) const {}
    __device__ __forceinline__ void done(const Unit&) const {}
};

struct EpiF32 {
    static constexpr bool PERM = false, AFTER_DRAIN = false, KHOOK = false;
    float* C; int ldc;
    __device__ __forceinline__ void operator()(const f32x4 (&acc)[2][2][4][2], const Unit& u, int wr, int wc, int fr, int fq) const {
        const int row0 = u.pm * BM + wr * 64 + fr, col0 = u.pn * BM + wc * 32 + 4 * fq;
#pragma unroll
        for (int ai = 0; ai < 2; ++ai)
#pragma unroll
            for (int m = 0; m < 4; ++m) { float* rowp = C + (size_t)(row0 + ai * HALF + m * 16) * ldc + col0;
#pragma unroll
                for (int bj = 0; bj < 2; ++bj)
#pragma unroll
                    for (int n = 0; n < 2; ++n) *(f32x4*)(rowp + bj * HALF + n * 16) = acc[ai][bj][m][n]; }
    }
    __device__ __forceinline__ void khook(f32x4 (&)[2][2][4][2], const Unit&, int, int, int, int, int) const {}
};
template <int ACT> struct EpiBf16 {
    static constexpr bool PERM = true, AFTER_DRAIN = false, KHOOK = false;
    bf16_t* O; int ldc; int sig_pn0;
    __device__ __forceinline__ void operator()(const f32x4 (&acc)[2][2][4][2], const Unit& u, int wr, int wc, int fr, int fq) const {
        const int row0 = u.pm * BM + wr * 64 + fr; const int col0 = u.pn * BM + wc * 32 + 8 * fq;
        const bool sig = (ACT == 2) && (u.pn >= sig_pn0);
#pragma unroll
        for (int ai = 0; ai < 2; ++ai)
#pragma unroll
            for (int m = 0; m < 4; ++m) { bf16_t* rowp = O + (size_t)(row0 + ai * HALF + m * 16) * ldc + col0;
#pragma unroll
                for (int bj = 0; bj < 2; ++bj) { f32x4 v0 = acc[ai][bj][m][0], v1 = acc[ai][bj][m][1];
                    if (ACT == 1) {
#pragma unroll
                        for (int j = 0; j < 4; ++j) { const float a = fmaxf(v0[j], 0.f), b = fmaxf(v1[j], 0.f); v0[j] = a * a; v1[j] = b * b; } }
                    if (ACT == 2) { if (sig) {
#pragma unroll
                        for (int j = 0; j < 4; ++j) { v0[j] = fmaxf(fsigmoid(v0[j]), 1e-20f); v1[j] = fmaxf(fsigmoid(v1[j]), 1e-20f); } } }
                    u32x4 w; w.x = pk_bf16(v0[0], v0[1]); w.y = pk_bf16(v0[2], v0[3]); w.z = pk_bf16(v1[0], v1[1]); w.w = pk_bf16(v1[2], v1[3]);
                    *(u32x4*)(rowp + bj * HALF) = w; } }
    }
    __device__ __forceinline__ void khook(f32x4 (&)[2][2][4][2], const Unit&, int, int, int, int, int) const {}
};
struct EpiMerge {
    static constexpr bool PERM = true, AFTER_DRAIN = false, KHOOK = true;
    const bf16_t* G; int ldg;
    bf16_t* O; int ldc;
    __device__ __forceinline__ void khook(f32x4 (&acc)[2][2][4][2], const Unit& u, int b, int wr, int wc, int fr, int fq) const {
        const int row0 = u.pm * BM + wr * 64 + fr; const int col0 = u.pn * BM + wc * 32 + 8 * fq;
#pragma unroll
        for (int ai = 0; ai < 2; ++ai) {
#pragma unroll
            for (int m = 0; m < 4; ++m) { const bf16_t* gp = G + (size_t)(row0 + ai * HALF + m * 16) * ldg + col0;
#pragma unroll
                for (int bj = 0; bj < 2; ++bj) { const u32x4 ga = *(const u32x4*)(gp + (b - 1) * 2048 + bj * HALF), gb = *(const u32x4*)(gp + b * 2048 + bj * HALF);
                    f32x4 r0, r1;
                    r0[0] = bf_lo(ga.x) * __builtin_amdgcn_rcpf(bf_lo(gb.x)); r0[1] = bf_hi(ga.x) * __builtin_amdgcn_rcpf(bf_hi(gb.x));
                    r0[2] = bf_lo(ga.y) * __builtin_amdgcn_rcpf(bf_lo(gb.y)); r0[3] = bf_hi(ga.y) * __builtin_amdgcn_rcpf(bf_hi(gb.y));
                    r1[0] = bf_lo(ga.z) * __builtin_amdgcn_rcpf(bf_lo(gb.z)); r1[1] = bf_hi(ga.z) * __builtin_amdgcn_rcpf(bf_hi(gb.z));
                    r1[2] = bf_lo(ga.w) * __builtin_amdgcn_rcpf(bf_lo(gb.w)); r1[3] = bf_hi(ga.w) * __builtin_amdgcn_rcpf(bf_hi(gb.w));
                    acc[ai][bj][m][0] *= r0; acc[ai][bj][m][1] *= r1; }
                if (m & 1) asm volatile("" ::: "memory"); } }
    }
    __device__ __forceinline__ void operator()(const f32x4 (&acc)[2][2][4][2], const Unit& u, int wr, int wc, int fr, int fq) const {
        const int row0 = u.pm * BM + wr * 64 + fr; const int col0 = u.pn * BM + wc * 32 + 8 * fq;
#pragma unroll
        for (int ai = 0; ai < 2; ++ai)
#pragma unroll
            for (int m = 0; m < 4; ++m) { const size_t r = (size_t)(row0 + ai * HALF + m * 16);
#pragma unroll
                for (int bj = 0; bj < 2; ++bj) { const u32x4 g = *(const u32x4*)(G + r * ldg + col0 + 3 * 2048 + bj * HALF);
                    f32x4 v0 = acc[ai][bj][m][0], v1 = acc[ai][bj][m][1];
                    v0[0] *= bf_lo(g.x); v0[1] *= bf_hi(g.x); v0[2] *= bf_lo(g.y); v0[3] *= bf_hi(g.y);
                    v1[0] *= bf_lo(g.z); v1[1] *= bf_hi(g.z); v1[2] *= bf_lo(g.w); v1[3] *= bf_hi(g.w);
                    u32x4 w; w.x = pk_bf16(v0[0], v0[1]); w.y = pk_bf16(v0[2], v0[3]); w.z = pk_bf16(v1[0], v1[1]); w.w = pk_bf16(v1[2], v1[3]);
                    *(u32x4*)(O + r * ldc + col0 + bj * HALF) = w; } }
    }
};

template <class Epi, class Sched, bool ALIGN_EPI = false, bool SP2 = false>
__device__ __forceinline__ void gemm_phase(PG8_LAS unsigned char* lds, const Gemm g, const Sched& S, const Epi& E, const int tid) {
    const int wid = __builtin_amdgcn_readfirstlane(tid >> 6), lane = tid & 63, wr = wid >> 2, wc = wid & 3, fr = lane & 15, fq = lane >> 4;
    const int K = g.K, nt = K / BK;
    unsigned voffA[2], voffB[2];
#pragma unroll
    for (int i = 0; i < 2; ++i) { int R, C; stage_rc(tid * 16 + i * 8192, R, C); const int Rb = Epi::PERM ? ((R & ~31) + perm32(R & 31)) : R;
        voffA[i] = (unsigned)(R * K + C) * 2u; voffB[i] = (unsigned)(Rb * K + C) * 2u; }
    const size_t kstep = (size_t)(BK * 2);
    const size_t hstep = (size_t)HALF * K * 2;
    const size_t tstep = 2 * hstep;
    const unsigned ldsw = (unsigned)wid * 1024u;
    const int aoff = lds_byte(wr * 64 + fr, fq * 8), boff = lds_byte(wc * 32 + fr, fq * 8);
#define PG8_SA(b, h) (((b) * 2 + (h)) * HTB)
#define PG8_SB(b, h) ((4 + (b) * 2 + (h)) * HTB)
#define PG8_STAGE(bufoff, gbase, voff) do { _Pragma("unroll") for (int _i = 0; _i < 2; ++_i) \
        __builtin_amdgcn_global_load_lds((const unsigned*)((const char*)(gbase) + (voff)[_i]), (PG8_LAS unsigned*)(lds + (bufoff) + ldsw + _i * 8192), 16, 0, 0); } while (0)
#define PG8_LDA(dst, b, h) do { _Pragma("unroll") for (int m = 0; m < 4; ++m) _Pragma("unroll") for (int k = 0; k < 2; ++k) dst[m][k] = *(const PG8_LAS bf16x8*)(lds + PG8_SA(b, h) + aoff + m * 2048 + k * 1024); } while (0)
#define PG8_LDB(dst, b, h) do { _Pragma("unroll") for (int n = 0; n < 2; ++n) _Pragma("unroll") for (int k = 0; k < 2; ++k) dst[n][k] = *(const PG8_LAS bf16x8*)(lds + PG8_SB(b, h) + boff + n * 2048 + k * 1024); } while (0)
#define PG8_MMA(ai, bj, At, Bt) do { __builtin_amdgcn_s_setprio(1); _Pragma("unroll") for (int m = 0; m < 4; ++m) _Pragma("unroll") for (int n = 0; n < 2; ++n) _Pragma("unroll") for (int k = 0; k < 2; ++k) \
        acc[ai][bj][m][n] = __builtin_amdgcn_mfma_f32_16x16x32_bf16(Bt[n][k], At[m][k], acc[ai][bj][m][n], 0, 0, 0); __builtin_amdgcn_s_setprio(0); } while (0)
#define PG8_WAIT_V(n) asm volatile("s_waitcnt vmcnt(" #n ")" ::: "memory")
#define PG8_WAIT_L(n) asm volatile("s_waitcnt lgkmcnt(" #n ")" ::: "memory")
#define PG8_BAR __builtin_amdgcn_s_barrier()
#define PG8_SCHED __builtin_amdgcn_sched_barrier(0)
    Unit cur, nxt; int ui = 0;
    if (!S.next(0, cur)) return;
    f32x4 acc[2][2][4][2];
#pragma unroll
    for (int a = 0; a < 2; ++a)
#pragma unroll
        for (int b = 0; b < 2; ++b)
#pragma unroll
            for (int m = 0; m < 4; ++m)
#pragma unroll
                for (int n = 0; n < 2; ++n) acc[a][b][m][n] = (f32x4){0.f, 0.f, 0.f, 0.f};
    bf16x8 At[4][2], B0[2][2], B1[2][2];
    const char* cA = (const char*)g.A + (size_t)cur.pm * tstep; const char* cB = (const char*)g.Bt + (size_t)cur.pn * tstep;
    S.a_ready(cur);
    if constexpr (SP2) {
        PG8_STAGE(PG8_SB(0, 0), cB, voffB); PG8_STAGE(PG8_SB(0, 1), cB + hstep, voffB); PG8_STAGE(PG8_SA(0, 0), cA, voffA); PG8_STAGE(PG8_SA(0, 1), cA + hstep, voffA);
        if (wr == 1) PG8_BAR;
        PG8_WAIT_V(2); PG8_BAR;
        PG8_STAGE(PG8_SB(1, 0), cB + kstep, voffB); PG8_STAGE(PG8_SA(1, 0), cA + kstep, voffA); PG8_STAGE(PG8_SB(1, 1), cB + hstep + kstep, voffB);
        PG8_WAIT_V(6); PG8_BAR;
    } else {
        PG8_STAGE(PG8_SB(0, 0), cB, voffB); PG8_STAGE(PG8_SA(0, 0), cA, voffA); PG8_STAGE(PG8_SB(0, 1), cB + hstep, voffB); PG8_STAGE(PG8_SA(0, 1), cA + hstep, voffA);
        if (wr == 1) PG8_BAR;
        PG8_WAIT_V(4); PG8_BAR;
        PG8_STAGE(PG8_SB(1, 0), cB + kstep, voffB); PG8_STAGE(PG8_SA(1, 0), cA + kstep, voffA); PG8_STAGE(PG8_SB(1, 1), cB + hstep + kstep, voffB);
        PG8_WAIT_V(6); PG8_BAR;
    }
    for (;;) {
        const bool has_next = S.next(ui + 1, nxt);
        const char* nA = has_next ? (const char*)g.A + (size_t)nxt.pm * tstep : cA; const char* nB = has_next ? (const char*)g.Bt + (size_t)nxt.pn * tstep : cB;
        for (int t = 0; t < nt; t += 2) {
            const bool last = (t == nt - 2);
            const char* a1 = cA + (size_t)(t + 1) * kstep;
            const char* a2 = last ? nA : cA + (size_t)(t + 2) * kstep; const char* b2 = last ? nB : cB + (size_t)(t + 2) * kstep;
            const char* a3 = a2 + kstep; const char* b3 = b2 + kstep;
            if (last && has_next) S.a_ready(nxt);
            if constexpr (Epi::KHOOK) { if (t != 0 && (t & 15) == 0) E.khook(acc, cur, t >> 4, wr, wc, fr, fq); }
            if constexpr (SP2) {
            PG8_LDB(B0, 0, 0); PG8_LDB(B1, 0, 1); PG8_SCHED; PG8_LDA(At, 0, 0); PG8_STAGE(PG8_SA(1, 1), a1 + hstep, voffA);
            PG8_WAIT_V(8); PG8_WAIT_L(0); PG8_BAR; PG8_MMA(0, 0, At, B0); PG8_MMA(0, 1, At, B1); PG8_BAR; PG8_SCHED;
            PG8_LDA(At, 0, 1); PG8_STAGE(PG8_SB(0, 0), b2, voffB); PG8_STAGE(PG8_SB(0, 1), b2 + hstep, voffB); PG8_STAGE(PG8_SA(0, 0), a2, voffA);
            PG8_WAIT_V(8); PG8_WAIT_L(0); PG8_BAR; PG8_MMA(1, 0, At, B0); PG8_MMA(1, 1, At, B1); PG8_BAR; PG8_SCHED;
            PG8_LDB(B0, 1, 0); PG8_LDB(B1, 1, 1); PG8_SCHED; PG8_LDA(At, 1, 0); PG8_STAGE(PG8_SA(0, 1), a2 + hstep, voffA);
            PG8_WAIT_V(8); PG8_WAIT_L(0); PG8_BAR; PG8_MMA(0, 0, At, B0); PG8_MMA(0, 1, At, B1); PG8_BAR; PG8_SCHED;
            PG8_LDA(At, 1, 1); PG8_STAGE(PG8_SB(1, 0), b3, voffB); PG8_STAGE(PG8_SB(1, 1), b3 + hstep, voffB); PG8_STAGE(PG8_SA(1, 0), a3, voffA);
            PG8_WAIT_V(8); PG8_WAIT_L(0); PG8_BAR; PG8_MMA(1, 0, At, B0); PG8_MMA(1, 1, At, B1); PG8_BAR; PG8_SCHED;
            } else {
            PG8_LDB(B0, 0, 0); PG8_SCHED; PG8_LDA(At, 0, 0); PG8_STAGE(PG8_SA(1, 1), a1 + hstep, voffA);
            PG8_WAIT_L(8); PG8_BAR; PG8_WAIT_L(0); PG8_MMA(0, 0, At, B0); PG8_BAR; PG8_SCHED;
            PG8_LDB(B1, 0, 1); PG8_STAGE(PG8_SB(0, 0), b2, voffB);
            PG8_BAR; PG8_WAIT_L(0); PG8_MMA(0, 1, At, B1); PG8_BAR;
            PG8_LDA(At, 0, 1); PG8_STAGE(PG8_SA(0, 0), a2, voffA);
            PG8_BAR; PG8_WAIT_L(0); PG8_MMA(1, 0, At, B0); PG8_BAR; PG8_SCHED;
            PG8_STAGE(PG8_SB(0, 1), b2 + hstep, voffB);
            PG8_WAIT_V(6); PG8_BAR; PG8_MMA(1, 1, At, B1); PG8_BAR;
            PG8_LDB(B0, 1, 0); PG8_SCHED; PG8_LDA(At, 1, 0); PG8_STAGE(PG8_SA(0, 1), a2 + hstep, voffA);
            PG8_WAIT_L(8); PG8_BAR; PG8_WAIT_L(0); PG8_MMA(0, 0, At, B0); PG8_BAR; PG8_SCHED;
            PG8_LDB(B1, 1, 1); PG8_STAGE(PG8_SB(1, 0), b3, voffB);
            PG8_BAR; PG8_WAIT_L(0); PG8_MMA(0, 1, At, B1); PG8_BAR;
            PG8_LDA(At, 1, 1); PG8_STAGE(PG8_SA(1, 0), a3, voffA);
            PG8_BAR; PG8_WAIT_L(0); PG8_MMA(1, 0, At, B0); PG8_BAR; PG8_SCHED;
            PG8_STAGE(PG8_SB(1, 1), b3 + hstep, voffB);
            PG8_WAIT_V(6); PG8_BAR; PG8_MMA(1, 1, At, B1); PG8_BAR;
            }
        }
        if constexpr (ALIGN_EPI) { if (wr == 0) PG8_BAR; }
        if constexpr (!Epi::AFTER_DRAIN) { E(acc, cur, wr, wc, fr, fq); S.done(cur); }
        if (!has_next) break;
#pragma unroll
        for (int a = 0; a < 2; ++a)
#pragma unroll
            for (int b = 0; b < 2; ++b)
#pragma unroll
                for (int m = 0; m < 4; ++m)
#pragma unroll
                    for (int n = 0; n < 2; ++n) acc[a][b][m][n] = (f32x4){0.f, 0.f, 0.f, 0.f};
        cur = nxt; cA = nA; cB = nB; ++ui;
        if constexpr (ALIGN_EPI) { if (wr == 1) PG8_BAR; }
    }
    PG8_WAIT_V(0);
    if constexpr (!ALIGN_EPI) { if (wr == 0) PG8_BAR; }
    PG8_BAR;
#undef PG8_SA
#undef PG8_SB
#undef PG8_STAGE
#undef PG8_LDA
#undef PG8_LDB
#undef PG8_MMA
#undef PG8_WAIT_V
#undef PG8_WAIT_L
#undef PG8_BAR
#undef PG8_SCHED
}
}

#define XB_TMO      128
#define XB_XCNT(j)  (256  + 64 * (j))
#define XB_XSUB(j)  (1280 + 64 * (j))
#define XB_XGEN(j)  (2304 + 64 * (j))
#define XB_TOP      3328
#define XB_TOPGEN   3392
#define XCD_BAR_WORDS 3456
#define XB_SPIN_CAP (1u << 18)

__device__ __forceinline__ unsigned xb_ld(unsigned* p)              { return __hip_atomic_load(p, __ATOMIC_RELAXED, __HIP_MEMORY_SCOPE_AGENT); }
__device__ __forceinline__ unsigned xb_add(unsigned* p, unsigned v) { return __hip_atomic_fetch_add(p, v, __ATOMIC_RELAXED, __HIP_MEMORY_SCOPE_AGENT); }
__device__ __forceinline__ unsigned xb_xcc_id() { return (unsigned)__builtin_amdgcn_s_getreg((3 << 11) | 20) & 0xFu; }
#define XB_SPIN(cond, bar) do { unsigned _sp = 0; while (cond) { __builtin_amdgcn_s_sleep(1); \
    if ((++_sp & 255u) == 0u) { if (xb_ld(&(bar)[XB_TMO])) break; if (_sp > XB_SPIN_CAP) { atomicAdd(&(bar)[XB_TMO], 1u); break; } } } } while (0)

struct XcdBarrier {
    unsigned* bar; unsigned x;
    volatile LAS unsigned* st;
    int wave;
};
__device__ __forceinline__ int lane_id() { int l; asm volatile("v_mbcnt_lo_u32_b32 %0, -1, 0\n\tv_mbcnt_hi_u32_b32 %0, -1, %0" : "=v"(l)); return l; }
__device__ __forceinline__ XcdBarrier xcd_barrier_post(unsigned* bar, volatile LAS unsigned* st, int wave) {
    XcdBarrier b; b.bar = bar; b.x = xb_xcc_id(); b.st = st; b.wave = wave;
    if (wave == 0 && lane_id() == 0) (void)xb_add(&bar[XB_XCNT(b.x)], 1u);
    return b;
}
__device__ __forceinline__ void xcd_barrier_complete(unsigned* bar, unsigned x, unsigned& nloc, unsigned& nx) {
    const unsigned G = gridDim.x * gridDim.y * gridDim.z;
    unsigned sum, cnt, mine, sp = 0u;
    for (;;) {
        sum = 0u; cnt = 0u; mine = 0u;
#pragma unroll
        for (unsigned j = 0; j < 16; ++j) { const unsigned c = xb_ld(&bar[XB_XCNT(j)]); sum += c; cnt += (c > 0u) ? 1u : 0u; mine = (j == x) ? c : mine; }
        if (sum == G) break;
        __builtin_amdgcn_s_sleep(1);
        if ((++sp & 255u) == 0u) { if (xb_ld(&bar[XB_TMO])) break; if (sp > XB_SPIN_CAP) { atomicAdd(&bar[XB_TMO], 1u); break; } }
    }
    nloc = mine > 0u ? mine : 1u; nx = cnt > 0u ? cnt : 1u;
}
__device__ __forceinline__ void xcd_barrier(const XcdBarrier& b) {
    asm volatile("s_waitcnt vmcnt(0)" ::: "memory");
    __syncthreads();
    if (b.wave == 0 && lane_id() == 0) {
        unsigned* bar = b.bar;
        __builtin_amdgcn_s_waitcnt(0);
        unsigned nloc = b.st[0], nx = b.st[1];
        if (nloc == 0u) { xcd_barrier_complete(bar, b.x, nloc, nx); b.st[0] = nloc; b.st[1] = nx; }
        const unsigned old = xb_add(&bar[XB_XSUB(b.x)], 1u);
        const unsigned gen = old / nloc;
        if (old + 1u == (gen + 1u) * nloc) {
            __builtin_amdgcn_fence(__ATOMIC_RELEASE, "agent");
            asm volatile("s_waitcnt vmcnt(0)" ::: "memory");
            const unsigned og = xb_add(&bar[XB_TOP], 1u);
            const unsigned tg = og / nx;
            if (og + 1u == (tg + 1u) * nx) xb_add(&bar[XB_TOPGEN], 1u);
            else XB_SPIN(xb_ld(&bar[XB_TOPGEN]) == tg, bar);
            __builtin_amdgcn_fence(__ATOMIC_ACQUIRE, "agent");
            xb_add(&bar[XB_XGEN(b.x)], 1u);
            asm volatile("s_waitcnt vmcnt(0)" ::: "memory");
        } else {
            XB_SPIN(xb_ld(&bar[XB_XGEN(b.x)]) == gen, bar);
            __builtin_amdgcn_fence(__ATOMIC_ACQUIRE, "agent");
            asm volatile("s_waitcnt vmcnt(0)" ::: "memory");
        }
    }
    __syncthreads();
}

constexpr int BATCH = 2, T = 4096, D = 2048, DEPTH = 4, M = BATCH * T;
constexpr int DIN = 20480, DFF = 8192, NH = 8, NCH = 32;
constexpr float EPS = 1e-6f;
constexpr int ZC_RQ = 0, ZC_RK = 1024, ZC_RV = 2048, ZC_RG = 3072, ZC_NQ = 4096, ZC_NK = 5120, ZC_NV = 6144, ZC_SB = 7168, ZC_SC = 8192, ZC_SX = 9216, ZC_CA = 10240, ZC_CG = 11264, ZC_GATE = 12288;
constexpr int YC_RET = 0, YC_NA = 1024, YC_SC = 2048, YC_CF = 3072, YCW = 4096;
constexpr int MODW = 6 * D;

constexpr size_t MiB = (size_t)1 << 20;
constexpr size_t WS_CTL = 0, CTL_ZERO_BYTES = 1 * MiB;
constexpr size_t WS_MOD = 1 * MiB;
constexpr size_t WS_ROPE = 2 * MiB;
constexpr size_t WS_WIN = 4 * MiB;
constexpr size_t WS_WCAT = 324 * MiB;
constexpr size_t WS_WO = 388 * MiB;
constexpr size_t WS_W1 = 420 * MiB;
constexpr size_t WS_W2 = 548 * MiB;
constexpr size_t WS_H = 676 * MiB;
constexpr size_t WS_Z = 708 * MiB;
constexpr size_t WS_LST = 1028 * MiB;
constexpr size_t WS_SST = 1092 * MiB;
constexpr size_t WS_YCAT = 1124 * MiB;
constexpr size_t WS_MERGED = 1188 * MiB;
constexpr size_t WS_Y = 1220 * MiB;
constexpr size_t WS_U = 1284 * MiB;
constexpr size_t WS_END = 1412 * MiB;
constexpr int CW_BAR = 4096;

constexpr int RING_BYTES = 131072;
constexpr int LDSCTL_OFF = RING_BYTES, MISC_OFF = LDSCTL_OFF + 320;
constexpr int LDS_BYTES = 147456;

constexpr int N_PHASES = 2 + 10 * DEPTH;

struct Args { const float* in[23]; float* out; unsigned char* ws; int ph_lo, ph_hi; };

__device__ __forceinline__ void transpose_item(const float* W, int N, bf16* WT, int ldk, int koff, LAS float* scr, int kb, int nb, int lane) {
    const int k0 = 64 * kb, n0 = 32 * nb;
#pragma unroll 8
    for (int i = 0; i < 32; ++i) { const int kk = 2 * i + (lane >> 5); scr[kk * 33 + (lane & 31)] = W[(size_t)(k0 + kk) * N + n0 + (lane & 31)]; }
    LDS_WAIT(); asm volatile("" ::: "memory");
    const int c = lane & 7;
#pragma unroll
    for (int j = 0; j < 4; ++j) { const int n = (lane >> 3) + 8 * j; const LAS float* s = scr + (8 * c) * 33 + n;
        u32x4 o; o.x = pk_bf16(s[0 * 33], s[1 * 33]); o.y = pk_bf16(s[2 * 33], s[3 * 33]); o.z = pk_bf16(s[4 * 33], s[5 * 33]); o.w = pk_bf16(s[6 * 33], s[7 * 33]);
        *(u32x4*)(WT + (size_t)(n0 + n) * ldk + koff + k0 + 8 * c) = o; }
    LDS_WAIT(); asm volatile("" ::: "memory");
}

__device__ __forceinline__ void phase_prologue(const Args& a, LAS unsigned char* lds, int tid, int lane, int wave, int bid, int G) {
    unsigned char* ws = a.ws;
    {
        LAS float* scr = (LAS float*)(lds + wave * 16384);
        const int gw = bid * 8 + wave, NGW = G * 8;
        constexpr int I_IN = 32 * 640, I_BR = 16 * 64, I_O = 32 * 64, I_1 = 32 * 256, I_2 = 128 * 64, I_L = I_IN + 4 * I_BR + I_O + I_1 + I_2;
        for (int it = gw; it < DEPTH * I_L; it += NGW) {
            const int l = it / I_L; int r = it - l * I_L;
            if (r < I_IN) { transpose_item(a.in[8] + (size_t)l * D * DIN, DIN, (bf16*)(ws + WS_WIN) + (size_t)l * DIN * D, D, 0, scr, r / 640, r % 640, lane); continue; } r -= I_IN;
            if (r < 4 * I_BR) { const int br = r / I_BR, rr = r % I_BR;
                transpose_item(a.in[16 + br] + (size_t)l * 1024 * D, D, (bf16*)(ws + WS_WCAT) + (size_t)l * D * YCW, YCW, 1024 * br, scr, rr / 64, rr % 64, lane); continue; } r -= 4 * I_BR;
            if (r < I_O) { transpose_item(a.in[20] + (size_t)l * D * D, D, (bf16*)(ws + WS_WO) + (size_t)l * D * D, D, 0, scr, r / 64, r % 64, lane); continue; } r -= I_O;
            if (r < I_1) { transpose_item(a.in[21] + (size_t)l * D * DFF, DFF, (bf16*)(ws + WS_W1) + (size_t)l * DFF * D, D, 0, scr, r / 256, r % 256, lane); continue; } r -= I_1;
            transpose_item(a.in[22] + (size_t)l * DFF * D, D, (bf16*)(ws + WS_W2) + (size_t)l * D * DFF, DFF, 0, scr, r / 64, r % 64, lane);
        }
    }
    __syncthreads();
    {
        LAS float* cact = (LAS float*)lds;
        LAS float* red = (LAS float*)(lds + 16384);
        const float* c = a.in[1];
        for (int i = tid; i < 2 * D; i += 512) { const float v = c[i]; cact[i] = v * fsigmoid(v) ; }
        __syncthreads();
        for (int it = bid; it < DEPTH * 48; it += G) {
            const int l = it / 48, cb = it % 48;
            const float* W = a.in[2] + (size_t)l * D * MODW + cb * 256 + 4 * lane;
            f32x4 a0 = {0.f, 0.f, 0.f, 0.f}, a1 = {0.f, 0.f, 0.f, 0.f};
            const int kb = wave * 256;
#pragma unroll 8
            for (int k = 0; k < 256; ++k) { const f32x4 w = *(const f32x4*)(W + (size_t)(kb + k) * MODW); a0 += w * cact[kb + k]; a1 += w * cact[D + kb + k]; }
            *(LAS f32x4*)(red + (wave * 2 + 0) * 256 + 4 * lane) = a0;
            *(LAS f32x4*)(red + (wave * 2 + 1) * 256 + 4 * lane) = a1;
            __syncthreads();
            { const int b = tid >> 8, col = tid & 255; float s = a.in[3][(size_t)l * MODW + cb * 256 + col];
#pragma unroll
              for (int w = 0; w < 8; ++w) s += red[(w * 2 + b) * 256 + col];
              ((float*)(ws + WS_MOD))[((size_t)l * 2 + b) * MODW + cb * 256 + col] = s; }
            __syncthreads();
        }
    }
    {
        f32x2* tab = (f32x2*)(ws + WS_ROPE);
        for (int e = bid * 512 + tid; e < T * 64; e += G * 512) {
            const int pos = e >> 6, i = e & 63;
            double inv = 1.0; const double rr = 0.8659643233600653;
            for (int k = 0; k < i; ++k) inv *= rr;
            const double ang = (double)pos * inv;
            const double n = __builtin_rint(ang * 0.6366197723675814);
            double r = __builtin_fma(-n, 1.5707963267948966, ang); r = __builtin_fma(-n, 6.123233995736766e-17, r);
            const double r2 = r * r;
            const double sn = r * (1.0 + r2 * (-1.0 / 6 + r2 * (1.0 / 120 + r2 * (-1.0 / 5040 + r2 * (1.0 / 362880 + r2 * (-1.0 / 39916800 + r2 * (1.0 / 6227020800.0)))))));
            const double cs = 1.0 + r2 * (-0.5 + r2 * (1.0 / 24 + r2 * (-1.0 / 720 + r2 * (1.0 / 40320 + r2 * (-1.0 / 3628800 + r2 * (1.0 / 479001600 + r2 * (-1.0 / 87178291200.0)))))));
            const int q = (int)((long long)n & 3);
            double co, si;
            if (q == 0) { co = cs; si = sn; } else if (q == 1) { co = -sn; si = cs; } else if (q == 2) { co = -cs; si = -sn; } else { co = sn; si = -cs; }
            tab[e] = (f32x2){(float)co, (float)si};
        }
    }
}

__device__ __forceinline__ void norm_rows(const float* xsrc, float* xdst, const float* y, const float* ga  , const float* gpost,
                                          bool do_h, const float* sc, const float* sh, const float* gpre, bf16* hout, int gw, int NGW, int lane) {
    for (int row = gw; row < M; row += NGW) {
        const int b = row >> 12;
        const f32x4* xr = (const f32x4*)(xsrc + (size_t)row * D) + lane;
        f32x4 xv[8];
#pragma unroll
        for (int j = 0; j < 8; ++j) xv[j] = xr[64 * j];
        if (y) {
            const f32x4* yr = (const f32x4*)(y + (size_t)row * D) + lane;
            f32x4 yv[8]; float ss = 0.f;
#pragma unroll
            for (int j = 0; j < 8; ++j) { yv[j] = yr[64 * j]; ss += (yv[j].x * yv[j].x + yv[j].y * yv[j].y) + (yv[j].z * yv[j].z + yv[j].w * yv[j].w); }
            ss = wave_sum(ss);
            const float r = 1.0f / sqrtf(ss * (1.0f / D) + EPS);
            const f32x4* gar = (const f32x4*)(ga + (size_t)b * MODW) + lane; const f32x4* gp = (const f32x4*)gpost + lane;
#pragma unroll
            for (int j = 0; j < 8; ++j) xv[j] += gar[64 * j] * ((yv[j] * r) * gp[64 * j]);
        }
        f32x4* xw = (f32x4*)(xdst + (size_t)row * D) + lane;
#pragma unroll
        for (int j = 0; j < 8; ++j) xw[64 * j] = xv[j];
        if (do_h) {
            float ss = 0.f;
#pragma unroll
            for (int j = 0; j < 8; ++j) ss += (xv[j].x * xv[j].x + xv[j].y * xv[j].y) + (xv[j].z * xv[j].z + xv[j].w * xv[j].w);
            ss = wave_sum(ss);
            const float r = 1.0f / sqrtf(ss * (1.0f / D) + EPS);
            const f32x4* scr = (const f32x4*)(sc + (size_t)b * MODW) + lane; const f32x4* shr = (const f32x4*)(sh + (size_t)b * MODW) + lane; const f32x4* gp = (const f32x4*)gpre + lane;
            u32x2* ho = (u32x2*)(hout + (size_t)row * D) + lane;
#pragma unroll
            for (int j = 0; j < 8; ++j) { const f32x4 hv = ((xv[j] * r) * gp[64 * j]) * (scr[64 * j] + 1.0f) + shr[64 * j];
                u32x2 w; w.x = pk_bf16(hv.x, hv.y); w.y = pk_bf16(hv.z, hv.w); ho[64 * j] = w; }
        }
    }
}

constexpr int CT = 16;
__device__ __forceinline__ void conv_units(const bf16* Z, bf16* YC, const float* scw, const float* cfw, const float* cfg, const float* cfb,
                                           LAS unsigned char* lds, int tid, int lane, int wave, int bid, int G) {
    const unsigned c00 = 2u * (unsigned)tid;
    LAS unsigned char* U = lds;
    LAS float* red = (LAS float*)(lds + (CT + 30) * 2048);
    LAS float* tot = red + 8 * 2 * CT;
    for (int u = bid; u < M / CT; u += G) {
        const int row0 = CT * u, b = row0 >> 12, ts = row0 & 4095;
        unsigned c0 = c00; asm volatile("" : "+v"(c0));
        const bf16* Zb = Z + (size_t)b * T * DIN;
        for (int it = tid; it < (CT + 30) * 128; it += 512) {
            const int row = it >> 7, ch = it & 127, tok = ts - 15 + row;
            u32x4 o = {0u, 0u, 0u, 0u};
            if (tok >= 0 && tok < T) {
                const u32x4 av = *(const u32x4*)(Zb + (size_t)tok * DIN + ZC_CA + 8 * ch), gv = *(const u32x4*)(Zb + (size_t)tok * DIN + ZC_CG + 8 * ch);
                o.x = pk_bf16(bf_lo(av.x) * fsigmoid(bf_lo(gv.x)), bf_hi(av.x) * fsigmoid(bf_hi(gv.x)));
                o.y = pk_bf16(bf_lo(av.y) * fsigmoid(bf_lo(gv.y)), bf_hi(av.y) * fsigmoid(bf_hi(gv.y)));
                o.z = pk_bf16(bf_lo(av.z) * fsigmoid(bf_lo(gv.z)), bf_hi(av.z) * fsigmoid(bf_hi(gv.z)));
                o.w = pk_bf16(bf_lo(av.w) * fsigmoid(bf_lo(gv.w)), bf_hi(av.w) * fsigmoid(bf_hi(gv.w)));
            }
            *(LAS u32x4*)(U + row * 2048 + ch * 16) = o;
        }
        __syncthreads();
        float w[31][2];
#pragma unroll
        for (int k = 0; k < 31; ++k) { const f32x2 t = *(const f32x2*)((cfw + k * 1024) + c0); w[k][0] = t.x; w[k][1] = t.y; }
        float acc[CT][2];
#pragma unroll
        for (int t = 0; t < CT; ++t) { acc[t][0] = 0.f; acc[t][1] = 0.f; }
#pragma unroll
        for (int j = 0; j < CT + 30; ++j) {
            const unsigned uv = *(const LAS unsigned*)(U + (j * 2048u + c0 * 2u));
            const float u0 = bf_lo(uv), u1 = bf_hi(uv);
#pragma unroll
            for (int t = 0; t < CT; ++t) { const int k = j - t; if (k >= 0 && k <= 30) { acc[t][0] += w[k][0] * u0; acc[t][1] += w[k][1] * u1; } }
            if ((j & 7) == 7) asm volatile("" ::: "memory");
        }
        const f32x2 lg = *(const f32x2*)(cfg + c0), lb = *(const f32x2*)(cfb + c0);
        float st[2 * CT];
#pragma unroll
        for (int t = 0; t < CT; ++t) { st[t] = wave_sum(acc[t][0] + acc[t][1]); st[CT + t] = wave_sum(acc[t][0] * acc[t][0] + acc[t][1] * acc[t][1]); }
        if (lane == 0) {
#pragma unroll
            for (int i = 0; i < 2 * CT; ++i) red[wave * 2 * CT + i] = st[i]; }
        __syncthreads();
        if (tid < 2 * CT) { float s = 0.f;
#pragma unroll
            for (int wv = 0; wv < 8; ++wv) s += red[wv * 2 * CT + tid];
            tot[tid] = s; }
        __syncthreads();
#pragma unroll
        for (int t = 0; t < CT; ++t) {
            const float mu = tot[t] * (1.0f / 1024), var = fmaxf(tot[CT + t] * (1.0f / 1024) - mu * mu, 0.f), rs = 1.0f / sqrtf(var + EPS);
            float y0 = (acc[t][0] - mu) * rs * lg.x + lb.x, y1 = (acc[t][1] - mu) * rs * lg.y + lb.y;
            y0 *= fsigmoid(y0); y1 *= fsigmoid(y1);
            *(unsigned*)(YC + (size_t)(row0 + t) * YCW + YC_CF + c0) = pk_bf16(y0, y1);
        }
        LAS float* P = (LAS float*)U;
        for (int it = tid; it < (CT + 2) * 128; it += 512) {
            const int row = it >> 7, ch = it & 127, tok = ts - 1 + row;
            f32x4 p0 = {0.f, 0.f, 0.f, 0.f}, p1 = {0.f, 0.f, 0.f, 0.f};
            if (tok >= 0 && tok < T) {
                const u32x4 cv = *(const u32x4*)(Zb + (size_t)tok * DIN + ZC_SC + 8 * ch), xv = *(const u32x4*)(Zb + (size_t)tok * DIN + ZC_SX + 8 * ch);
                p0 = (f32x4){bf_lo(cv.x) * bf_lo(xv.x), bf_hi(cv.x) * bf_hi(xv.x), bf_lo(cv.y) * bf_lo(xv.y), bf_hi(cv.y) * bf_hi(xv.y)};
                p1 = (f32x4){bf_lo(cv.z) * bf_lo(xv.z), bf_hi(cv.z) * bf_hi(xv.z), bf_lo(cv.w) * bf_lo(xv.w), bf_hi(cv.w) * bf_hi(xv.w)};
            }
            *(LAS f32x4*)(P + row * 1024 + ch * 8) = p0; *(LAS f32x4*)(P + row * 1024 + ch * 8 + 4) = p1;
        }
        __syncthreads();
        {
            float w3[3][2];
#pragma unroll
            for (int k = 0; k < 3; ++k) { const f32x2 t = *(const f32x2*)((scw + k * 1024) + c0); w3[k][0] = t.x; w3[k][1] = t.y; }
            f32x2 pa = *(const LAS f32x2*)(P + 0 * 1024 + c0), pb = *(const LAS f32x2*)(P + 1 * 1024 + c0);
            for (int t = 0; t < CT; ++t) {
                const f32x2 pc = *(const LAS f32x2*)(P + (t + 2) * 1024 + c0);
                const unsigned sb2 = *(const unsigned*)(Zb + (size_t)(ts + t) * DIN + ZC_SB + c0);
                const float o0 = w3[0][0] * pa.x + w3[1][0] * pb.x + w3[2][0] * pc.x;
                const float o1 = w3[0][1] * pa.y + w3[1][1] * pb.y + w3[2][1] * pc.y;
                *(unsigned*)(YC + (size_t)(row0 + t) * YCW + YC_SC + c0) = pk_bf16(bf_lo(sb2) * o0, bf_hi(sb2) * o1);
                pa = pb; pb = pc;
            }
        }
        __syncthreads();
    }
}

__device__ __forceinline__ float log2_sigmoid(float x) { return -log1pf(expf(-x)) * 1.4426950408889634f; }
constexpr int RP = 136 * 2;

__device__ __forceinline__ void ret_local_units(const bf16* Z, const f32x2* rope, const float* dec_f, const float* dec_b, float* LST,
                                                LAS unsigned char* lds, int tid, int lane, int wave, int bid, int G) {
    LAS unsigned char* Ktf = lds; LAS unsigned char* Ktb = lds + 128 * RP; LAS unsigned char* Vt = lds + 2 * 128 * RP;
    const int fr = lane & 15, g = lane >> 4;
    for (int u = bid; u < 16 * NCH; u += G) {
        const int chunk = u & 31, bh = u >> 5, b = bh >> 3, h = bh & 7;
        const float lf2 = log2_sigmoid(dec_f[h]), lb2 = log2_sigmoid(dec_b[h]);
        const size_t rowb = (size_t)b * T + chunk * 128;
#pragma unroll
        for (int rep = 0; rep < 2; ++rep) {
            const int it = tid + 512 * rep, j = it & 127, c = it >> 7;
            const bf16* zr = Z + (rowb + j) * DIN + ZC_RK + h * 128 + 8 * c;
            const u32x4 k1 = *(const u32x4*)zr, k2 = *(const u32x4*)(zr + 64);
            const f32x4* cs = (const f32x4*)(rope + (size_t)(chunk * 128 + j) * 64 + 8 * c);
            const f32x4 cs0 = cs[0], cs1 = cs[1], cs2 = cs[2], cs3 = cs[3];
            const float cosv[8] = {cs0.x, cs0.z, cs1.x, cs1.z, cs2.x, cs2.z, cs3.x, cs3.z}, sinv[8] = {cs0.y, cs0.w, cs1.y, cs1.w, cs2.y, cs2.w, cs3.y, cs3.w};
            const unsigned k1w[4] = {k1.x, k1.y, k1.z, k1.w}, k2w[4] = {k2.x, k2.y, k2.z, k2.w};
            const float df = exp2f(lf2 * (float)(127 - j)) * 0.08838834764831845f, db = exp2f(lb2 * (float)j) * 0.08838834764831845f;
#pragma unroll
            for (int e = 0; e < 8; ++e) {
                const float x1 = (e & 1) ? bf_hi(k1w[e >> 1]) : bf_lo(k1w[e >> 1]), x2 = (e & 1) ? bf_hi(k2w[e >> 1]) : bf_lo(k2w[e >> 1]);
                const float o1 = x1 * cosv[e] - x2 * sinv[e], o2 = x1 * sinv[e] + x2 * cosv[e];
                const unsigned pf = pk_bf16(o1 * df, o2 * df), pb = pk_bf16(o1 * db, o2 * db);
                *(LAS bf16*)(Ktf + (8 * c + e) * RP + 2 * j) = (bf16)(pf & 0xffffu); *(LAS bf16*)(Ktf + (64 + 8 * c + e) * RP + 2 * j) = (bf16)(pf >> 16);
                *(LAS bf16*)(Ktb + (8 * c + e) * RP + 2 * j) = (bf16)(pb & 0xffffu); *(LAS bf16*)(Ktb + (64 + 8 * c + e) * RP + 2 * j) = (bf16)(pb >> 16);
            }
        }
#pragma unroll
        for (int rep = 0; rep < 4; ++rep) {
            const int it = tid + 512 * rep, j = it & 127, c = it >> 7;
            const u32x4 v = *(const u32x4*)(Z + (rowb + j) * DIN + ZC_RV + h * 128 + 8 * c);
            const unsigned vw[4] = {v.x, v.y, v.z, v.w};
#pragma unroll
            for (int e = 0; e < 8; ++e) *(LAS bf16*)(Vt + (8 * c + e) * RP + 2 * j) = (bf16)((e & 1) ? (vw[e >> 1] >> 16) : (vw[e >> 1] & 0xffffu));
        }
        __syncthreads();
        f32x4 acc[2][8];
#pragma unroll
        for (int d = 0; d < 2; ++d)
#pragma unroll
            for (int i = 0; i < 8; ++i) acc[d][i] = (f32x4){0.f, 0.f, 0.f, 0.f};
#pragma unroll
        for (int ks = 0; ks < 4; ++ks) {
            const bf16x8 bv = *(const LAS bf16x8*)(Vt + (16 * wave + fr) * RP + (32 * ks + 8 * g) * 2);
#pragma unroll
            for (int i = 0; i < 8; ++i) {
                const bf16x8 af = *(const LAS bf16x8*)(Ktf + (16 * i + fr) * RP + (32 * ks + 8 * g) * 2);
                const bf16x8 ab = *(const LAS bf16x8*)(Ktb + (16 * i + fr) * RP + (32 * ks + 8 * g) * 2);
                acc[0][i] = MFMA16(af, bv, acc[0][i]); acc[1][i] = MFMA16(ab, bv, acc[1][i]);
            }
        }
#pragma unroll
        for (int d = 0; d < 2; ++d) { float* Lb = LST + ((size_t)((d * 16 + bh) * NCH + chunk)) * 16384 + (size_t)(16 * wave + fr) * 128 + 4 * g;
#pragma unroll
            for (int i = 0; i < 8; ++i) *(f32x4*)(Lb + 16 * i) = acc[d][i]; }
        __syncthreads();
    }
}

__device__ __forceinline__ void ret_scan(const float* LST, bf16* SST, const float* dec_f, const float* dec_b, int tid, int bid, int G) {
    for (int e = bid * 512 + tid; e < 2 * 16 * 4096; e += G * 512) {
        const int dir = e >> 16, rem = e & 65535, bh = rem >> 12, q4 = rem & 4095, h = bh & 7;
        const float dec = exp2f(log2_sigmoid(dir ? dec_b[h] : dec_f[h]) * 128.0f);
        const size_t base = (size_t)((dir * 16 + bh) * NCH) * 16384 + 4 * (size_t)q4;
        f32x4 s = {0.f, 0.f, 0.f, 0.f};
        if (dir == 0) {
#pragma unroll 8
            for (int i = 0; i < NCH; ++i) { u32x2 w; w.x = pk_bf16(s.x, s.y); w.y = pk_bf16(s.z, s.w); *(u32x2*)(SST + base + (size_t)i * 16384) = w;
                s = *(const f32x4*)(LST + base + (size_t)i * 16384) + s * dec; }
        } else {
#pragma unroll 8
            for (int i = NCH - 1; i >= 0; --i) { u32x2 w; w.x = pk_bf16(s.x, s.y); w.y = pk_bf16(s.z, s.w); *(u32x2*)(SST + base + (size_t)i * 16384) = w;
                s = *(const f32x4*)(LST + base + (size_t)i * 16384) + s * dec; }
        }
    }
}

__device__ __forceinline__ void ret_out_units(const bf16* Z, const f32x2* rope, const float* dec_f, const float* dec_b, const bf16* SST, bf16* YC,
                                              LAS unsigned char* lds, int tid, int lane, int wave, int bid, int G) {
    LAS unsigned char* Kl = lds; LAS unsigned char* Vt = lds + 128 * RP; LAS unsigned char* Pl = lds + 2 * 128 * RP + wave * 16 * RP;
    const int fr = lane & 15, g = lane >> 4;
    for (int u = bid; u < 16 * NCH; u += G) {
        const int chunk = u & 31, bh = u >> 5, b = bh >> 3, h = bh & 7;
        const float lf2 = log2_sigmoid(dec_f[h]), lb2 = log2_sigmoid(dec_b[h]);
        const size_t rowb = (size_t)b * T + chunk * 128;
#pragma unroll
        for (int rep = 0; rep < 2; ++rep) {
            const int it = tid + 512 * rep, j = it >> 3, c = it & 7;
            const bf16* zr = Z + (rowb + j) * DIN + ZC_RK + h * 128 + 8 * c;
            const u32x4 k1 = *(const u32x4*)zr, k2 = *(const u32x4*)(zr + 64);
            const f32x4* cs = (const f32x4*)(rope + (size_t)(chunk * 128 + j) * 64 + 8 * c);
            const f32x4 cs0 = cs[0], cs1 = cs[1], cs2 = cs[2], cs3 = cs[3];
            const float cosv[8] = {cs0.x, cs0.z, cs1.x, cs1.z, cs2.x, cs2.z, cs3.x, cs3.z}, sinv[8] = {cs0.y, cs0.w, cs1.y, cs1.w, cs2.y, cs2.w, cs3.y, cs3.w};
            const unsigned k1w[4] = {k1.x, k1.y, k1.z, k1.w}, k2w[4] = {k2.x, k2.y, k2.z, k2.w};
            float o1[8], o2[8];
#pragma unroll
            for (int e = 0; e < 8; ++e) {
                const float x1 = (e & 1) ? bf_hi(k1w[e >> 1]) : bf_lo(k1w[e >> 1]), x2 = (e & 1) ? bf_hi(k2w[e >> 1]) : bf_lo(k2w[e >> 1]);
                o1[e] = (x1 * cosv[e] - x2 * sinv[e]) * 0.08838834764831845f; o2[e] = (x1 * sinv[e] + x2 * cosv[e]) * 0.08838834764831845f;
            }
            u32x4 w1, w2; w1.x = pk_bf16(o1[0], o1[1]); w1.y = pk_bf16(o1[2], o1[3]); w1.z = pk_bf16(o1[4], o1[5]); w1.w = pk_bf16(o1[6], o1[7]);
            w2.x = pk_bf16(o2[0], o2[1]); w2.y = pk_bf16(o2[2], o2[3]); w2.z = pk_bf16(o2[4], o2[5]); w2.w = pk_bf16(o2[6], o2[7]);
            *(LAS u32x4*)(Kl + j * RP + 16 * c) = w1; *(LAS u32x4*)(Kl + j * RP + 128 + 16 * c) = w2;
        }
#pragma unroll
        for (int rep = 0; rep < 4; ++rep) {
            const int it = tid + 512 * rep, j = it & 127, c = it >> 7;
            const u32x4 v = *(const u32x4*)(Z + (rowb + j) * DIN + ZC_RV + h * 128 + 8 * c);
            const unsigned vw[4] = {v.x, v.y, v.z, v.w};
#pragma unroll
            for (int e = 0; e < 8; ++e) *(LAS bf16*)(Vt + (8 * c + e) * RP + 2 * j) = (bf16)((e & 1) ? (vw[e >> 1] >> 16) : (vw[e >> 1] & 0xffffu));
        }
        const int q = 16 * wave + fr;
        bf16x8 qf[4];
        {
            const bf16* zr = Z + (rowb + q) * DIN + ZC_RQ + h * 128 + 8 * g;
#pragma unroll
            for (int ks = 0; ks < 2; ++ks) {
                const u32x4 x1v = *(const u32x4*)(zr + 32 * ks), x2v = *(const u32x4*)(zr + 32 * ks + 64);
                const f32x4* cs = (const f32x4*)(rope + (size_t)(chunk * 128 + q) * 64 + 32 * ks + 8 * g);
                const f32x4 cs0 = cs[0], cs1 = cs[1], cs2 = cs[2], cs3 = cs[3];
                const float cosv[8] = {cs0.x, cs0.z, cs1.x, cs1.z, cs2.x, cs2.z, cs3.x, cs3.z}, sinv[8] = {cs0.y, cs0.w, cs1.y, cs1.w, cs2.y, cs2.w, cs3.y, cs3.w};
                const unsigned x1w[4] = {x1v.x, x1v.y, x1v.z, x1v.w}, x2w[4] = {x2v.x, x2v.y, x2v.z, x2v.w};
                float o1[8], o2[8];
#pragma unroll
                for (int e = 0; e < 8; ++e) {
                    const float x1 = (e & 1) ? bf_hi(x1w[e >> 1]) : bf_lo(x1w[e >> 1]), x2 = (e & 1) ? bf_hi(x2w[e >> 1]) : bf_lo(x2w[e >> 1]);
                    o1[e] = x1 * cosv[e] - x2 * sinv[e]; o2[e] = x1 * sinv[e] + x2 * cosv[e];
                }
                u32x4 w1, w2; w1.x = pk_bf16(o1[0], o1[1]); w1.y = pk_bf16(o1[2], o1[3]); w1.z = pk_bf16(o1[4], o1[5]); w1.w = pk_bf16(o1[6], o1[7]);
                w2.x = pk_bf16(o2[0], o2[1]); w2.y = pk_bf16(o2[2], o2[3]); w2.z = pk_bf16(o2[4], o2[5]); w2.w = pk_bf16(o2[6], o2[7]);
                qf[ks] = __builtin_bit_cast(bf16x8, w1); qf[ks + 2] = __builtin_bit_cast(bf16x8, w2);
            }
        }
        __syncthreads();
#pragma unroll
        for (int kt = 0; kt < 8; ++kt) {
            f32x4 s = {0.f, 0.f, 0.f, 0.f};
#pragma unroll
            for (int ks = 0; ks < 4; ++ks) { const bf16x8 a = *(const LAS bf16x8*)(Kl + (16 * kt + fr) * RP + (32 * ks + 8 * g) * 2); s = MFMA16(a, qf[ks], s); }
            float pv[4];
#pragma unroll
            for (int r = 0; r < 4; ++r) { const int m = 16 * kt + 4 * g + r, diff = q - m;
                const float dc = diff >= 0 ? exp2f(lf2 * (float)diff) : exp2f(lb2 * (float)(-diff)); pv[r] = s[r] * dc; }
            u32x2 w; w.x = pk_bf16(pv[0], pv[1]); w.y = pk_bf16(pv[2], pv[3]);
            *(LAS u32x2*)(Pl + fr * RP + (16 * kt + 4 * g) * 2) = w;
        }
        LDS_WAIT();
        f32x4 o[8];
#pragma unroll
        for (int i = 0; i < 8; ++i) o[i] = (f32x4){0.f, 0.f, 0.f, 0.f};
#pragma unroll
        for (int ks = 0; ks < 4; ++ks) {
            const bf16x8 pb = *(const LAS bf16x8*)(Pl + fr * RP + (32 * ks + 8 * g) * 2);
#pragma unroll
            for (int i = 0; i < 8; ++i) { const bf16x8 a = *(const LAS bf16x8*)(Vt + (16 * i + fr) * RP + (32 * ks + 8 * g) * 2); o[i] = MFMA16(a, pb, o[i]); }
        }
#pragma unroll
        for (int d = 0; d < 2; ++d) {
            const float qd = d == 0 ? exp2f(lf2 * (float)(q + 1)) : exp2f(lb2 * (float)(128 - q));
            const bf16* Sb = SST + ((size_t)((d * 16 + bh) * NCH + chunk)) * 16384 + (size_t)fr * 128 + 8 * g;
#pragma unroll
            for (int i = 0; i < 8; ++i) {
                f32x4 c = {0.f, 0.f, 0.f, 0.f};
#pragma unroll
                for (int ks = 0; ks < 4; ++ks) { const bf16x8 a = *(const bf16x8*)(Sb + (size_t)(16 * i) * 128 + 32 * ks); c = MFMA16(a, qf[ks], c); }
                o[i] += c * qd;
            }
        }
        float s1 = 0.f;
#pragma unroll
        for (int i = 0; i < 8; ++i) s1 += (o[i].x + o[i].y) + (o[i].z + o[i].w);
        s1 += __shfl_xor(s1, 16); s1 += __shfl_xor(s1, 32);
        const float mu = s1 * (1.0f / 128);
        float s2 = 0.f;
#pragma unroll
        for (int i = 0; i < 8; ++i) { const f32x4 dd = o[i] - mu; s2 += (dd.x * dd.x + dd.y * dd.y) + (dd.z * dd.z + dd.w * dd.w); }
        s2 += __shfl_xor(s2, 16); s2 += __shfl_xor(s2, 32);
        const float rs = 1.0f / sqrtf(s2 * (1.0f / 128) + EPS);
        const bf16* rgp = Z + (rowb + q) * DIN + ZC_RG + h * 128 + 4 * g;
        bf16* yo = YC + (rowb + q) * YCW + YC_RET + h * 128 + 4 * g;
#pragma unroll
        for (int i = 0; i < 8; ++i) {
            const u32x2 rg = *(const u32x2*)(rgp + 16 * i);
            const float g0 = bf_lo(rg.x), g1 = bf_hi(rg.x), g2 = bf_lo(rg.y), g3 = bf_hi(rg.y);
            u32x2 w; w.x = pk_bf16(g0 * fsigmoid(g0) * ((o[i].x - mu) * rs), g1 * fsigmoid(g1) * ((o[i].y - mu) * rs));
            w.y = pk_bf16(g2 * fsigmoid(g2) * ((o[i].z - mu) * rs), g3 * fsigmoid(g3) * ((o[i].w - mu) * rs));
            *(u32x2*)(yo + 16 * i) = w;
        }
        __syncthreads();
    }
}

constexpr int NP = 72 * 2;
__device__ __forceinline__ void na_units(const bf16* Z, const float* rpb  , bf16* YC, LAS unsigned char* lds, int tid, int lane, int wave, int bid, int G) {
    LAS unsigned char* Kl = lds;
    LAS unsigned char* Vt = lds + 64 * RP;
    LAS unsigned char* Pl = lds + 64 * RP + 128 * NP + wave * 16 * NP;
    LAS float* bias = (LAS float*)(lds + 64 * RP + 128 * NP + 8 * 16 * NP);
    const int fr = lane & 15, g = lane >> 4;
    for (int u = bid; u < 16 * 32; u += G) {
        const int rp = u & 31, bh = u >> 5, b = bh >> 3, h = bh & 7, r0 = 2 * rp;
        for (int i = tid; i < 465; i += 512) bias[i] = rpb[h * 465 + i];
        const int qr = r0 + (wave >> 2), c = 16 * (wave & 3) + fr;
        const size_t rowq = (size_t)b * T + qr * 64 + c;
        bf16x8 qf[4];
#pragma unroll
        for (int ks = 0; ks < 4; ++ks) qf[ks] = *(const bf16x8*)(Z + rowq * DIN + ZC_NQ + h * 128 + 32 * ks + 8 * g);
        const int rs_q = min(max(qr - 4, 0), 56), cs_q = min(max(c - 8, 0), 48);
        const int kr_lo = min(max(r0 - 4, 0), 56), kr_hi = min(max(r0 - 3, 0), 56) + 7;
        float m_run = -INFINITY, l_run = 0.f;
        f32x4 o[8];
#pragma unroll
        for (int i = 0; i < 8; ++i) o[i] = (f32x4){0.f, 0.f, 0.f, 0.f};
        for (int kr = kr_lo; kr <= kr_hi; ++kr) {
            const size_t rowk = (size_t)b * T + kr * 64;
#pragma unroll
            for (int rep = 0; rep < 2; ++rep) { const int it = tid + 512 * rep, kc = it >> 4, ch = it & 15;
                *(LAS u32x4*)(Kl + kc * RP + 16 * ch) = *(const u32x4*)(Z + (rowk + kc) * DIN + ZC_NK + h * 128 + 8 * ch); }
#pragma unroll
            for (int rep = 0; rep < 2; ++rep) { const int it = tid + 512 * rep, kc = it & 63, ch = it >> 6;
                const u32x4 v = *(const u32x4*)(Z + (rowk + kc) * DIN + ZC_NV + h * 128 + 8 * ch);
                const unsigned vw[4] = {v.x, v.y, v.z, v.w};
#pragma unroll
                for (int e = 0; e < 8; ++e) *(LAS bf16*)(Vt + (8 * ch + e) * NP + 2 * kc) = (bf16)((e & 1) ? (vw[e >> 1] >> 16) : (vw[e >> 1] & 0xffffu)); }
            __syncthreads();
            if (kr >= rs_q && kr < rs_q + 8) {
                float s[4][4]; float mx = -INFINITY;
#pragma unroll
                for (int kt = 0; kt < 4; ++kt) {
                    f32x4 a4 = {0.f, 0.f, 0.f, 0.f};
#pragma unroll
                    for (int ks = 0; ks < 4; ++ks) { const bf16x8 a = *(const LAS bf16x8*)(Kl + (16 * kt + fr) * RP + (32 * ks + 8 * g) * 2); a4 = MFMA16(a, qf[ks], a4); }
#pragma unroll
                    for (int r = 0; r < 4; ++r) { const int kc = 16 * kt + 4 * g + r; const bool valid = (kc >= cs_q) && (kc < cs_q + 16);
                        const int bi = valid ? ((kr - qr + 7) * 31 + (kc - c + 15)) : 0;
                        const float sv = valid ? (a4[r] * 0.08838834764831845f + bias[bi]) : -INFINITY; s[kt][r] = sv; mx = fmaxf(mx, sv); }
                }
                mx = fmaxf(mx, __shfl_xor(mx, 16)); mx = fmaxf(mx, __shfl_xor(mx, 32));
                const float m_new = fmaxf(m_run, mx), alpha = __expf(m_run - m_new);
                float ps = 0.f;
#pragma unroll
                for (int kt = 0; kt < 4; ++kt) {
#pragma unroll
                    for (int r = 0; r < 4; ++r) { s[kt][r] = __expf(s[kt][r] - m_new); ps += s[kt][r]; }
                    u32x2 w; w.x = pk_bf16(s[kt][0], s[kt][1]); w.y = pk_bf16(s[kt][2], s[kt][3]);
                    *(LAS u32x2*)(Pl + fr * NP + (16 * kt + 4 * g) * 2) = w;
                }
                ps += __shfl_xor(ps, 16); ps += __shfl_xor(ps, 32);
                l_run = l_run * alpha + ps; m_run = m_new;
#pragma unroll
                for (int i = 0; i < 8; ++i) o[i] *= alpha;
                LDS_WAIT();
#pragma unroll
                for (int ks = 0; ks < 2; ++ks) {
                    const bf16x8 pb = *(const LAS bf16x8*)(Pl + fr * NP + (32 * ks + 8 * g) * 2);
#pragma unroll
                    for (int i = 0; i < 8; ++i) { const bf16x8 a = *(const LAS bf16x8*)(Vt + (16 * i + fr) * NP + (32 * ks + 8 * g) * 2); o[i] = MFMA16(a, pb, o[i]); }
                }
            }
            __syncthreads();
        }
        const float inv = 1.0f / l_run;
        bf16* yo = YC + rowq * YCW + YC_NA + h * 128 + 4 * g;
#pragma unroll
        for (int i = 0; i < 8; ++i) { u32x2 w; w.x = pk_bf16(o[i].x * inv, o[i].y * inv); w.y = pk_bf16(o[i].z * inv, o[i].w * inv); *(u32x2*)(yo + 16 * i) = w; }
    }
}

#define PH_BEGIN() int wave = wave0; asm volatile("" : "+s"(wave)); const int lane = lane_id(); const int tid = wave * 64 + lane; \
    int G = G0, bid = bid0; asm volatile("" : "+s"(G), "+s"(bid)); unsigned char* ws = args.ws; asm volatile("" : "+s"(ws)); \
    LAS unsigned char* lds = lds0; asm volatile("" : "+s"(lds)); (void)lane; (void)wave; (void)G; (void)bid; (void)ws; (void)lds
__global__ void __launch_bounds__(512, 2) fwd(Args args) {
    extern __shared__ __attribute__((aligned(16))) unsigned char lds_raw[];
    LAS unsigned char* lds0 = (LAS unsigned char*)lds_raw;
    const int wave0 = __builtin_amdgcn_readfirstlane(threadIdx.x >> 6);
    const int G0 = gridDim.x, bid0 = blockIdx.x;
    volatile LAS unsigned* MISC = (volatile LAS unsigned*)(lds0 + MISC_OFF);
    for (int u = wave0 * 64 + lane_id(); u < (LDS_BYTES - LDSCTL_OFF) / 4; u += 512) ((LAS unsigned*)(lds0 + LDSCTL_OFF))[u] = 0u;
    __syncthreads();
    const int lo = args.ph_lo, hi = args.ph_hi;
    XcdBarrier bar; bar.bar = (unsigned*)(args.ws + WS_CTL) + CW_BAR; bar.x = 0; bar.st = nullptr; bar.wave = wave0;
    if (hi - lo > 1) bar = xcd_barrier_post((unsigned*)(args.ws + WS_CTL) + CW_BAR, MISC + 8, wave0);
#define IN(k) (lo <= (k) && (k) < hi)
#define SEAM(k) do { if (IN((k) + 1)) { XcdBarrier bb_ = bar; asm volatile("" : "+s"(bb_.bar), "+s"(bb_.x), "+s"(bb_.wave)); xcd_barrier(bb_); } } while (0)

    if (IN(0)) { PH_BEGIN(); phase_prologue(args, lds, tid, lane, wave, bid, G); SEAM(0); }
    if (IN(1)) {
        PH_BEGIN(); const float* MOD = (const float*)(ws + WS_MOD);
        norm_rows(args.in[0], args.out, nullptr, nullptr, nullptr, true, MOD + 1 * D, MOD + 0 * D, args.in[4], (bf16*)(ws + WS_H), bid * 8 + wave, G * 8, lane);
        SEAM(1);
    }
#define LAYER_BODY(l) do { \
        const int p0 = 2 + 10 * l; \
        if (IN(p0 + 0)) { \
            PH_BEGIN(); \
            pg8::Gemm g{(const bf16*)(ws + WS_H), (const bf16*)(ws + WS_WIN) + (size_t)l * DIN * D, M, DIN, D}; pg8::StaticOrder S; S.init(M, DIN, G, bid); \
            pg8::EpiBf16<2> E{(bf16*)(ws + WS_Z), DIN, ZC_GATE / 256}; \
            pg8::gemm_phase<pg8::EpiBf16<2>, pg8::StaticOrder, true, true>(lds, g, S, E, tid); \
            SEAM(p0 + 0); \
        } \
        if (IN(p0 + 1)) { \
            PH_BEGIN(); \
            ret_local_units((const bf16*)(ws + WS_Z), (const f32x2*)(ws + WS_ROPE), args.in[9] + l * NH, args.in[10] + l * NH, (float*)(ws + WS_LST), lds, tid, lane, wave, bid, G); \
            conv_units((const bf16*)(ws + WS_Z), (bf16*)(ws + WS_YCAT), args.in[12] + (size_t)l * 3 * 1024, args.in[13] + (size_t)l * 31 * 1024, args.in[14] + (size_t)l * 1024, args.in[15] + (size_t)l * 1024, lds, tid, lane, wave, bid, G); \
            SEAM(p0 + 1); \
        } \
        if (IN(p0 + 2)) { \
            PH_BEGIN(); \
            ret_scan((const float*)(ws + WS_LST), (bf16*)(ws + WS_SST), args.in[9] + l * NH, args.in[10] + l * NH, tid, bid, G); \
            na_units((const bf16*)(ws + WS_Z), args.in[11] + (size_t)l * NH * 465, (bf16*)(ws + WS_YCAT), lds, tid, lane, wave, bid, G); \
            SEAM(p0 + 2); \
        } \
        if (IN(p0 + 3)) { \
            PH_BEGIN(); \
            ret_out_units((const bf16*)(ws + WS_Z), (const f32x2*)(ws + WS_ROPE), args.in[9] + l * NH, args.in[10] + l * NH, (const bf16*)(ws + WS_SST), (bf16*)(ws + WS_YCAT), lds, tid, lane, wave, bid, G); \
            SEAM(p0 + 3); \
        } \
        if (IN(p0 + 4)) { \
            PH_BEGIN(); \
            pg8::Gemm g{(const bf16*)(ws + WS_YCAT), (const bf16*)(ws + WS_WCAT) + (size_t)l * D * YCW, M, D, YCW}; pg8::StaticOrder S; S.init(M, D, G, bid); \
            pg8::EpiMerge E{(const bf16*)(ws + WS_Z) + ZC_GATE, DIN, (bf16*)(ws + WS_MERGED), D}; \
            pg8::gemm_phase<pg8::EpiMerge, pg8::StaticOrder, false, true>(lds, g, S, E, tid); \
            SEAM(p0 + 4); \
        } \
        if (IN(p0 + 5)) { \
            PH_BEGIN(); \
            pg8::Gemm g{(const bf16*)(ws + WS_MERGED), (const bf16*)(ws + WS_WO) + (size_t)l * D * D, M, D, D}; pg8::StaticOrder S; S.init(M, D, G, bid); \
            pg8::EpiF32 E{(float*)(ws + WS_Y), D}; \
            pg8::gemm_phase<pg8::EpiF32, pg8::StaticOrder, false, true>(lds, g, S, E, tid); \
            SEAM(p0 + 5); \
        } \
        if (IN(p0 + 6)) { \
            PH_BEGIN(); const float* modl = (const float*)(ws + WS_MOD) + (size_t)l * 2 * MODW; \
            norm_rows(args.out, args.out, (const float*)(ws + WS_Y), modl + 2 * D, args.in[5] + (size_t)l * D, true, modl + 4 * D, modl + 3 * D, args.in[6] + (size_t)l * D, (bf16*)(ws + WS_H), bid * 8 + wave, G * 8, lane); \
            SEAM(p0 + 6); \
        } \
        if (IN(p0 + 7)) { \
            PH_BEGIN(); \
            pg8::Gemm g{(const bf16*)(ws + WS_H), (const bf16*)(ws + WS_W1) + (size_t)l * DFF * D, M, DFF, D}; pg8::StaticOrder S; S.init(M, DFF, G, bid); \
            pg8::EpiBf16<1> E{(bf16*)(ws + WS_U), DFF, 0}; \
            pg8::gemm_phase<pg8::EpiBf16<1>, pg8::StaticOrder, true, true>(lds, g, S, E, tid); \
            SEAM(p0 + 7); \
        } \
        if (IN(p0 + 8)) { \
            PH_BEGIN(); \
            pg8::Gemm g{(const bf16*)(ws + WS_U), (const bf16*)(ws + WS_W2) + (size_t)l * D * DFF, M, D, DFF}; pg8::StaticOrder S; S.init(M, D, G, bid); \
            pg8::EpiF32 E{(float*)(ws + WS_Y), D}; \
            pg8::gemm_phase<pg8::EpiF32, pg8::StaticOrder, false, true>(lds, g, S, E, tid); \
            SEAM(p0 + 8); \
        } \
        if (IN(p0 + 9)) { \
            PH_BEGIN(); const float* modl = (const float*)(ws + WS_MOD) + (size_t)l * 2 * MODW; \
            const bool nh = (l + 1 < DEPTH); const float* modn = (const float*)(ws + WS_MOD) + (size_t)(nh ? l + 1 : l) * 2 * MODW; \
            norm_rows(args.out, args.out, (const float*)(ws + WS_Y), modl + 5 * D, args.in[7] + (size_t)l * D, nh, modn + 1 * D, modn + 0 * D, args.in[4] + (size_t)(nh ? l + 1 : l) * D, (bf16*)(ws + WS_H), bid * 8 + wave, G * 8, lane); \
            SEAM(p0 + 9); \
        } \
    } while (0)
    LAYER_BODY(0); LAYER_BODY(1); LAYER_BODY(2); LAYER_BODY(3);
#undef IN
#undef SEAM
}

extern "C" void kernel_launch(void* const* d_in, const int* in_sizes, int n_in, void* d_out, int out_size, void* d_ws, size_t ws_size, hipStream_t stream) {
    static int grid = 0;
    if (grid == 0) {
        if (n_in != 23 || out_size != M * D || ws_size < WS_END) { fprintf(stderr, "kernel_launch: unexpected problem (n_in %d, out %d, ws %zu)\n", n_in, out_size, ws_size); grid = -1; return; }
        int dev = 0, cus = 0, per_cu = 0;
        if (hipGetDevice(&dev) != hipSuccess || hipDeviceGetAttribute(&cus, hipDeviceAttributeMultiprocessorCount, dev) != hipSuccess) { grid = -1; return; }
        if (hipFuncSetAttribute((const void*)fwd, hipFuncAttributeMaxDynamicSharedMemorySize, LDS_BYTES) != hipSuccess) { fprintf(stderr, "kernel_launch: hipFuncSetAttribute failed\n"); grid = -1; return; }
        if (hipOccupancyMaxActiveBlocksPerMultiprocessor(&per_cu, (const void*)fwd, 512, LDS_BYTES) != hipSuccess || per_cu < 1) fprintf(stderr, "kernel_launch: occupancy query says %d\n", per_cu);
        (void)hipGetLastError();
        grid = cus;
    }
    if (grid < 0) return;
    (void)hipMemsetAsync((char*)d_ws + WS_CTL, 0, CTL_ZERO_BYTES, stream);
    Args a{};
    for (int i = 0; i < 23; ++i) a.in[i] = (const float*)d_in[i];
    a.out = (float*)d_out; a.ws = (unsigned char*)d_ws;
#if MK_SINGLE_LAUNCH
    a.ph_lo = 0; a.ph_hi = N_PHASES;
    hipLaunchKernelGGL(fwd, dim3(grid), dim3(512), LDS_BYTES, stream, a);
#else
    for (int p = 0; p < N_PHASES; ++p) { a.ph_lo = p; a.ph_hi = p + 1; hipLaunchKernelGGL(fwd, dim3(grid), dim3(512), LDS_BYTES, stream, a); }
#endif
}
```

```cpp
#include <hip/hip_runtime.h>
#include <cstdio>
#include <cstdint>

#define LAS __attribute__((address_space(3)))
#define GAS __attribute__((address_space(1)))
#ifndef MK_SINGLE_LAUNCH
#define MK_SINGLE_LAUNCH 1
#endif

typedef unsigned short bf16;
typedef short bf16x8 __attribute__((ext_vector_type(8)));
typedef float f32x4 __attribute__((ext_vector_type(4)));
typedef float f32x2 __attribute__((ext_vector_type(2)));
typedef unsigned u32x4 __attribute__((ext_vector_type(4)));
typedef unsigned u32x2 __attribute__((ext_vector_type(2)));

__device__ __forceinline__ unsigned pk_bf16(float lo, float hi) { unsigned r; asm("v_cvt_pk_bf16_f32 %0, %1, %2" : "=v"(r) : "v"(lo), "v"(hi)); return r; }
__device__ __forceinline__ float bf_lo(unsigned w) { return __uint_as_float(w << 16); }
__device__ __forceinline__ float bf_hi(unsigned w) { return __uint_as_float(w & 0xffff0000u); }
__device__ __forceinline__ float fsigmoid(float x) { return __builtin_amdgcn_rcpf(1.0f + __expf(-x)); }
__device__ __forceinline__ float wave_sum(float v) {
#pragma unroll
    for (int o = 1; o < 64; o <<= 1) v += __shfl_xor(v, o);
    return v;
}
#define MFMA16(a, b, c) __builtin_amdgcn_mfma_f32_16x16x32_bf16((a), (b), (c), 0, 0, 0)
#define LDS_WAIT() asm volatile("s_waitcnt lgkmcnt(0)" ::: "memory")
#define VM_WAIT() asm volatile("s_waitcnt vmcnt(0)" ::: "memory")

namespace pg8 {
#define PG8_LAS __attribute__((address_space(3)))
typedef unsigned short bf16_t;
constexpr int BM = 256, BK = 64, HALF = 128, HTB = HALF * BK * 2, STAGE_BYTES = 8 * HTB, NXCD = 8, WGM = 8;

__host__ __device__ __forceinline__ int lds_byte(int r, int c) { const int st = (r >> 4) * 2 + (c >> 5), rr = r & 15, cc = c & 31, ob = rr * 64 + cc * 2; return st * 1024 + (ob ^ (((ob >> 9) & 1) << 5)); }
__host__ __device__ __forceinline__ void stage_rc(int b, int& R, int& C) { const int st = b / 1024, sb = b % 1024, swz = sb ^ (((sb >> 9) & 1) << 5); R = (st >> 1) * 16 + swz / 64; C = (st & 1) * 32 + (swz % 64) / 2; }
__host__ __device__ __forceinline__ int perm32(int rho) { const int n = rho >> 4, i = rho & 15; return 8 * (i >> 2) + 4 * n + (i & 3); }

struct Unit { int pm, pn; };
struct Gemm { const bf16_t* A; const bf16_t* Bt; int M, N, K; };

struct StaticOrder {
    int nM, nN, nwg, G, c;
    __host__ __device__ void init(int M, int N, int G_, int c_) { nM = M / BM; nN = N / BM; nwg = nM * nN; G = G_; c = c_; }
    __host__ __device__ bool next(int i, Unit& u) const {
        const long L = (long)i * G + c; if (L >= nwg) return false;
        int wgid = (int)L; { const int q = nwg / NXCD, r = nwg % NXCD, xcd = wgid % NXCD, off = wgid / NXCD; wgid = (xcd < r ? xcd * (q + 1) : r * (q + 1) + (xcd - r) * q) + off; }
        const int nig = WGM * nN, gid = wgid / nig, fm = gid * WGM, gsz = (nM - fm) < WGM ? (nM - fm) : WGM;
        u.pm = fm + ((wgid % nig) % gsz); u.pn = (wgid % nig) / gsz; return true;
    }
    __device__ __forceinline__ void a_ready(const Unit&) const {}
    __device__ __forceinline__ void done(const Unit&) const {}
};

struct EpiF32 {
    static constexpr bool PERM = false, AFTER_DRAIN = false, KHOOK = false;
    float* C; int ldc;
    __device__ __forceinline__ void operator()(const f32x4 (&acc)[2][2][4][2], const Unit& u, int wr, int wc, int fr, int fq) const {
        const int row0 = u.pm * BM + wr * 64 + fr, col0 = u.pn * BM + wc * 32 + 4 * fq;
#pragma unroll
        for (int ai = 0; ai < 2; ++ai)
#pragma unroll
            for (int m = 0; m < 4; ++m) { float* rowp = C + (size_t)(row0 + ai * HALF + m * 16) * ldc + col0;
#pragma unroll
                for (int bj = 0; bj < 2; ++bj)
#pragma unroll
                    for (int n = 0; n < 2; ++n) *(f32x4*)(rowp + bj * HALF + n * 16) = acc[ai][bj][m][n]; }
    }
    __device__ __forceinline__ void khook(f32x4 (&)[2][2][4][2], const Unit&, int, int, int, int, int) const {}
};
template <int ACT> struct EpiBf16 {
    static constexpr bool PERM = true, AFTER_DRAIN = false, KHOOK = false;
    bf16_t* O; int ldc; int sig_pn0;
    __device__ __forceinline__ void operator()(const f32x4 (&acc)[2][2][4][2], const Unit& u, int wr, int wc, int fr, int fq) const {
        const int row0 = u.pm * BM + wr * 64 + fr; const int col0 = u.pn * BM + wc * 32 + 8 * fq;
        const bool sig = (ACT == 2) && (u.pn >= sig_pn0);
#pragma unroll
        for (int ai = 0; ai < 2; ++ai)
#pragma unroll
            for (int m = 0; m < 4; ++m) { bf16_t* rowp = O + (size_t)(row0 + ai * HALF + m * 16) * ldc + col0;
#pragma unroll
                for (int bj = 0; bj < 2; ++bj) { f32x4 v0 = acc[ai][bj][m][0], v1 = acc[ai][bj][m][1];
                    if (ACT == 1) {
#pragma unroll
                        for (int j = 0; j < 4; ++j) { const float a = fmaxf(v0[j], 0.f), b = fmaxf(v1[j], 0.f); v0[j] = a * a; v1[j] = b * b; } }
                    if (ACT == 2) { if (sig) {
#pragma unroll
                        for (int j = 0; j < 4; ++j) { v0[j] = fmaxf(fsigmoid(v0[j]), 1e-20f); v1[j] = fmaxf(fsigmoid(v1[j]), 1e-20f); } } }
                    u32x4 w; w.x = pk_bf16(v0[0], v0[1]); w.y = pk_bf16(v0[2], v0[3]); w.z = pk_bf16(v1[0], v1[1]); w.w = pk_bf16(v1[2], v1[3]);
                    *(u32x4*)(rowp + bj * HALF) = w; } }
    }
    __device__ __forceinline__ void khook(f32x4 (&)[2][2][4][2], const Unit&, int, int, int, int, int) const {}
};
struct EpiMerge {
    static constexpr bool PERM = true, AFTER_DRAIN = false, KHOOK = true;
    const bf16_t* G; int ldg;
    bf16_t* O; int ldc;
    __device__ __forceinline__ void khook(f32x4 (&acc)[2][2][4][2], const Unit& u, int b, int wr, int wc, int fr, int fq) const {
        const int row0 = u.pm * BM + wr * 64 + fr; const int col0 = u.pn * BM + wc * 32 + 8 * fq;
#pragma unroll
        for (int ai = 0; ai < 2; ++ai) {
#pragma unroll
            for (int m = 0; m < 4; ++m) { const bf16_t* gp = G + (size_t)(row0 + ai * HALF + m * 16) * ldg + col0;
#pragma unroll
                for (int bj = 0; bj < 2; ++bj) { const u32x4 ga = *(const u32x4*)(gp + (b - 1) * 2048 + bj * HALF), gb = *(const u32x4*)(gp + b * 2048 + bj * HALF);
                    f32x4 r0, r1;
                    r0[0] = bf_lo(ga.x) * __builtin_amdgcn_rcpf(bf_lo(gb.x)); r0[1] = bf_hi(ga.x) * __builtin_amdgcn_rcpf(bf_hi(gb.x));
                    r0[2] = bf_lo(ga.y) * __builtin_amdgcn_rcpf(bf_lo(gb.y)); r0[3] = bf_hi(ga.y) * __builtin_amdgcn_rcpf(bf_hi(gb.y));
                    r1[0] = bf_lo(ga.z) * __builtin_amdgcn_rcpf(bf_lo(gb.z)); r1[1] = bf_hi(ga.z) * __builtin_amdgcn_rcpf(bf_hi(gb.z));
                    r1[2] = bf_lo(ga.w) * __builtin_amdgcn_rcpf(bf_lo(gb.w)); r1[3] = bf_hi(ga.w) * __builtin_amdgcn_rcpf(bf_hi(gb.w));
                    acc[ai][bj][m][0] *= r0; acc[ai][bj][m][1] *= r1; }
                if (m & 1) asm volatile("" ::: "memory"); } }
    }
    __device__ __forceinline__ void operator()(const f32x4 (&acc)[2][2][4][2], const Unit& u, int wr, int wc, int fr, int fq) const {
        const int row0 = u.pm * BM + wr * 64 + fr; const int col0 = u.pn * BM + wc * 32 + 8 * fq;
#pragma unroll
        for (int ai = 0; ai < 2; ++ai)
#pragma unroll
            for (int m = 0; m < 4; ++m) { const size_t r = (size_t)(row0 + ai * HALF + m * 16);
#pragma unroll
                for (int bj = 0; bj < 2; ++bj) { const u32x4 g = *(const u32x4*)(G + r * ldg + col0 + 3 * 2048 + bj * HALF);
                    f32x4 v0 = acc[ai][bj][m][0], v1 = acc[ai][bj][m][1];
                    v0[0] *= bf_lo(g.x); v0[1] *= bf_hi(g.x); v0[2] *= bf_lo(g.y); v0[3] *= bf_hi(g.y);
                    v1[0] *= bf_lo(g.z); v1[1] *= bf_hi(g.z); v1[2] *= bf_lo(g.w); v1[3] *= bf_hi(g.w);
                    u32x4 w; w.x = pk_bf16(v0[0], v0[1]); w.y = pk_bf16(v0[2], v0[3]); w.z = pk_bf16(v1[0], v1[1]); w.w = pk_bf16(v1[2], v1[3]);
                    *(u32x4*)(O + r * ldc + col0 + bj * HALF) = w; } }
    }
};

template <class Epi, class Sched, bool ALIGN_EPI = false, bool SP2 = false>
__device__ __forceinline__ void gemm_phase(PG8_LAS unsigned char* lds, const Gemm g, const Sched& S, const Epi& E, const int tid) {
    const int wid = __builtin_amdgcn_readfirstlane(tid >> 6), lane = tid & 63, wr = wid >> 2, wc = wid & 3, fr = lane & 15, fq = lane >> 4;
    const int K = g.K, nt = K / BK;
    unsigned voffA[2], voffB[2];
#pragma unroll
    for (int i = 0; i < 2; ++i) { int R, C; stage_rc(tid * 16 + i * 8192, R, C); const int Rb = Epi::PERM ? ((R & ~31) + perm32(R & 31)) : R;
        voffA[i] = (unsigned)(R * K + C) * 2u; voffB[i] = (unsigned)(Rb * K + C) * 2u; }
    const size_t kstep = (size_t)(BK * 2);
    const size_t hstep = (size_t)HALF * K * 2;
    const size_t tstep = 2 * hstep;
    const unsigned ldsw = (unsigned)wid * 1024u;
    const int aoff = lds_byte(wr * 64 + fr, fq * 8), boff = lds_byte(wc * 32 + fr, fq * 8);
#define PG8_SA(b, h) (((b) * 2 + (h)) * HTB)
#define PG8_SB(b, h) ((4 + (b) * 2 + (h)) * HTB)
#define PG8_STAGE(bufoff, gbase, voff) do { _Pragma("unroll") for (int _i = 0; _i < 2; ++_i) \
        __builtin_amdgcn_global_load_lds((const unsigned*)((const char*)(gbase) + (voff)[_i]), (PG8_LAS unsigned*)(lds + (bufoff) + ldsw + _i * 8192), 16, 0, 0); } while (0)
#define PG8_LDA(dst, b, h) do { _Pragma("unroll") for (int m = 0; m < 4; ++m) _Pragma("unroll") for (int k = 0; k < 2; ++k) dst[m][k] = *(const PG8_LAS bf16x8*)(lds + PG8_SA(b, h) + aoff + m * 2048 + k * 1024); } while (0)
#define PG8_LDB(dst, b, h) do { _Pragma("unroll") for (int n = 0; n < 2; ++n) _Pragma("unroll") for (int k = 0; k < 2; ++k) dst[n][k] = *(const PG8_LAS bf16x8*)(lds + PG8_SB(b, h) + boff + n * 2048 + k * 1024); } while (0)
#define PG8_MMA(ai, bj, At, Bt) do { __builtin_amdgcn_s_setprio(1); _Pragma("unroll") for (int m = 0; m < 4; ++m) _Pragma("unroll") for (int n = 0; n < 2; ++n) _Pragma("unroll") for (int k = 0; k < 2; ++k) \
        acc[ai][bj][m][n] = __builtin_amdgcn_mfma_f32_16x16x32_bf16(Bt[n][k], At[m][k], acc[ai][bj][m][n], 0, 0, 0); __builtin_amdgcn_s_setprio(0); } while (0)
#define PG8_WAIT_V(n) asm volatile("s_waitcnt vmcnt(" #n ")" ::: "memory")
#define PG8_WAIT_L(n) asm volatile("s_waitcnt lgkmcnt(" #n ")" ::: "memory")
#define PG8_BAR __builtin_amdgcn_s_barrier()
#define PG8_SCHED __builtin_amdgcn_sched_barrier(0)
    Unit cur, nxt; int ui = 0;
    if (!S.next(0, cur)) return;
    f32x4 acc[2][2][4][2];
#pragma unroll
    for (int a = 0; a < 2; ++a)
#pragma unroll
        for (int b = 0; b < 2; ++b)
#pragma unroll
            for (int m = 0; m < 4; ++m)
#pragma unroll
                for (int n = 0; n < 2; ++n) acc[a][b][m][n] = (f32x4){0.f, 0.f, 0.f, 0.f};
    bf16x8 At[4][2], B0[2][2], B1[2][2];
    const char* cA = (const char*)g.A + (size_t)cur.pm * tstep; const char* cB = (const char*)g.Bt + (size_t)cur.pn * tstep;
    S.a_ready(cur);
    if constexpr (SP2) {
        PG8_STAGE(PG8_SB(0, 0), cB, voffB); PG8_STAGE(PG8_SB(0, 1), cB + hstep, voffB); PG8_STAGE(PG8_SA(0, 0), cA, voffA); PG8_STAGE(PG8_SA(0, 1), cA + hstep, voffA);
        if (wr == 1) PG8_BAR;
        PG8_WAIT_V(2); PG8_BAR;
        PG8_STAGE(PG8_SB(1, 0), cB + kstep, voffB); PG8_STAGE(PG8_SA(1, 0), cA + kstep, voffA); PG8_STAGE(PG8_SB(1, 1), cB + hstep + kstep, voffB);
        PG8_WAIT_V(6); PG8_BAR;
    } else {
        PG8_STAGE(PG8_SB(0, 0), cB, voffB); PG8_STAGE(PG8_SA(0, 0), cA, voffA); PG8_STAGE(PG8_SB(0, 1), cB + hstep, voffB); PG8_STAGE(PG8_SA(0, 1), cA + hstep, voffA);
        if (wr == 1) PG8_BAR;
        PG8_WAIT_V(4); PG8_BAR;
        PG8_STAGE(PG8_SB(1, 0), cB + kstep, voffB); PG8_STAGE(PG8_SA(1, 0), cA + kstep, voffA); PG8_STAGE(PG8_SB(1, 1), cB + hstep + kstep, voffB);
        PG8_WAIT_V(6); PG8_BAR;
    }
    for (;;) {
        const bool has_next = S.next(ui + 1, nxt);
        const char* nA = has_next ? (const char*)g.A + (size_t)nxt.pm * tstep : cA; const char* nB = has_next ? (const char*)g.Bt + (size_t)nxt.pn * tstep : cB;
        for (int t = 0; t < nt; t += 2) {
            const bool last = (t == nt - 2);
            const char* a1 = cA + (size_t)(t + 1) * kstep;
            const char* a2 = last ? nA : cA + (size_t)(t + 2) * kstep; const char* b2 = last ? nB : cB + (size_t)(t + 2) * kstep;
            const char* a3 = a2 + kstep; const char* b3 = b2 + kstep;
            if (last && has_next) S.a_ready(nxt);
            if constexpr (Epi::KHOOK) { if (t != 0 && (t & 15) == 0) E.khook(acc, cur, t >> 4, wr, wc, fr, fq); }
            if constexpr (SP2) {
            PG8_LDB(B0, 0, 0); PG8_LDB(B1, 0, 1); PG8_SCHED; PG8_LDA(At, 0, 0); PG8_STAGE(PG8_SA(1, 1), a1 + hstep, voffA);
            PG8_WAIT_V(8); PG8_WAIT_L(0); PG8_BAR; PG8_MMA(0, 0, At, B0); PG8_MMA(0, 1, At, B1); PG8_BAR; PG8_SCHED;
            PG8_LDA(At, 0, 1); PG8_STAGE(PG8_SB(0, 0), b2, voffB); PG8_STAGE(PG8_SB(0, 1), b2 + hstep, voffB); PG8_STAGE(PG8_SA(0, 0), a2, voffA);
            PG8_WAIT_V(8); PG8_WAIT_L(0); PG8_BAR; PG8_MMA(1, 0, At, B0); PG8_MMA(1, 1, At, B1); PG8_BAR; PG8_SCHED;
            PG8_LDB(B0, 1, 0); PG8_LDB(B1, 1, 1); PG8_SCHED; PG8_LDA(At, 1, 0); PG8_STAGE(PG8_SA(0, 1), a2 + hstep, voffA);
            PG8_WAIT_V(8); PG8_WAIT_L(0); PG8_BAR; PG8_MMA(0, 0, At, B0); PG8_MMA(0, 1, At, B1); PG8_BAR; PG8_SCHED;
            PG8_LDA(At, 1, 1); PG8_STAGE(PG8_SB(1, 0), b3, voffB); PG8_STAGE(PG8_SB(1, 1), b3 + hstep, voffB); PG8_STAGE(PG8_SA(1, 0), a3, voffA);
            PG8_WAIT_V(8); PG8_WAIT_L(0); PG8_BAR; PG8_MMA(1, 0, At, B0); PG8_MMA(1, 1, At, B1); PG8_BAR; PG8_SCHED;
            } else {
            PG8_LDB(B0, 0, 0); PG8_SCHED; PG8_LDA(At, 0, 0); PG8_STAGE(PG8_SA(1, 1), a1 + hstep, voffA);
            PG8_WAIT_L(8); PG8_BAR; PG8_WAIT_L(0); PG8_MMA(0, 0, At, B0); PG8_BAR; PG8_SCHED;
            PG8_LDB(B1, 0, 1); PG8_STAGE(PG8_SB(0, 0), b2, voffB);
            PG8_BAR; PG8_WAIT_L(0); PG8_MMA(0, 1, At, B1); PG8_BAR;
            PG8_LDA(At, 0, 1); PG8_STAGE(PG8_SA(0, 0), a2, voffA);
            PG8_BAR; PG8_WAIT_L(0); PG8_MMA(1, 0, At, B0); PG8_BAR; PG8_SCHED;
            PG8_STAGE(PG8_SB(0, 1), b2 + hstep, voffB);
            PG8_WAIT_V(6); PG8_BAR; PG8_MMA(1, 1, At, B1); PG8_BAR;
            PG8_LDB(B0, 1, 0); PG8_SCHED; PG8_LDA(At, 1, 0); PG8_STAGE(PG8_SA(0, 1), a2 + hstep, voffA);
            PG8_WAIT_L(8); PG8_BAR; PG8_WAIT_L(0); PG8_MMA(0, 0, At, B0); PG8_BAR; PG8_SCHED;
            PG8_LDB(B1, 1, 1); PG8_STAGE(PG8_SB(1, 0), b3, voffB);
            PG8_BAR; PG8_WAIT_L(0); PG8_MMA(0, 1, At, B1); PG8_BAR;
            PG8_LDA(At, 1, 1); PG8_STAGE(PG8_SA(1, 0), a3, voffA);
            PG8_BAR; PG8_WAIT_L(0); PG8_MMA(1, 0, At, B0); PG8_BAR; PG8_SCHED;
            PG8_STAGE(PG8_SB(1, 1), b3 + hstep, voffB);
            PG8_WAIT_V(6); PG8_BAR; PG8_MMA(1, 1, At, B1); PG8_BAR;
            }
        }
        if constexpr (ALIGN_EPI) { if (wr == 0) PG8_BAR; }
        if constexpr (!Epi::AFTER_DRAIN) { E(acc, cur, wr, wc, fr, fq); S.done(cur); }
        if (!has_next) break;
#pragma unroll
        for (int a = 0; a < 2; ++a)
#pragma unroll
            for (int b = 0; b < 2; ++b)
#pragma unroll
                for (int m = 0; m < 4; ++m)
#pragma unroll
                    for (int n = 0; n < 2; ++n) acc[a][b][m][n] = (f32x4){0.f, 0.f, 0.f, 0.f};
        cur = nxt; cA = nA; cB = nB; ++ui;
        if constexpr (ALIGN_EPI) { if (wr == 1) PG8_BAR; }
    }
    PG8_WAIT_V(0);
    if constexpr (!ALIGN_EPI) { if (wr == 0) PG8_BAR; }
    PG8_BAR;
#undef PG8_SA
#undef PG8_SB
#undef PG8_STAGE
#undef PG8_LDA
#undef PG8_LDB
#undef PG8_MMA
#undef PG8_WAIT_V
#undef PG8_WAIT_L
#undef PG8_BAR
#undef PG8_SCHED
}
}

#define XB_TMO      128
#define XB_XCNT(j)  (256  + 64 * (j))
#define XB_XSUB(j)  (1280 + 64 * (j))
#define XB_XGEN(j)  (2304 + 64 * (j))
#define XB_TOP      3328
#define XB_TOPGEN   3392
#define XCD_BAR_WORDS 3456
#define XB_SPIN_CAP (1u << 18)

__device__ __forceinline__ unsigned xb_ld(unsigned* p)              { return __hip_atomic_load(p, __ATOMIC_RELAXED, __HIP_MEMORY_SCOPE_AGENT); }
__device__ __forceinline__ unsigned xb_add(unsigned* p, unsigned v) { return __hip_atomic_fetch_add(p, v, __ATOMIC_RELAXED, __HIP_MEMORY_SCOPE_AGENT); }
__device__ __forceinline__ unsigned xb_xcc_id() { return (unsigned)__builtin_amdgcn_s_getreg((3 << 11) | 20) & 0xFu; }
#define XB_SPIN(cond, bar) do { unsigned _sp = 0; while (cond) { __builtin_amdgcn_s_sleep(1); \
    if ((++_sp & 255u) == 0u) { if (xb_ld(&(bar)[XB_TMO])) break; if (_sp > XB_SPIN_CAP) { atomicAdd(&(bar)[XB_TMO], 1u); break; } } } } while (0)

struct XcdBarrier {
    unsigned* bar; unsigned x;
    volatile LAS unsigned* st;
    int wave;
};
__device__ __forceinline__ int lane_id() { int l; asm volatile("v_mbcnt_lo_u32_b32 %0, -1, 0\n\tv_mbcnt_hi_u32_b32 %0, -1, %0" : "=v"(l)); return l; }
__device__ __forceinline__ XcdBarrier xcd_barrier_post(unsigned* bar, volatile LAS unsigned* st, int wave) {
    XcdBarrier b; b.bar = bar; b.x = xb_xcc_id(); b.st = st; b.wave = wave;
    if (wave == 0 && lane_id() == 0) (void)xb_add(&bar[XB_XCNT(b.x)], 1u);
    return b;
}
__device__ __forceinline__ void xcd_barrier_complete(unsigned* bar, unsigned x, unsigned& nloc, unsigned& nx) {
    const unsigned G = gridDim.x * gridDim.y * gridDim.z;
    unsigned sum, cnt, mine, sp = 0u;
    for (;;) {
        sum = 0u; cnt = 0u; mine = 0u;
#pragma unroll
        for (unsigned j = 0; j < 16; ++j) { const unsigned c = xb_ld(&bar[XB_XCNT(j)]); sum += c; cnt += (c > 0u) ? 1u : 0u; mine = (j == x) ? c : mine; }
        if (sum == G) break;
        __builtin_amdgcn_s_sleep(1);
        if ((++sp & 255u) == 0u) { if (xb_ld(&bar[XB_TMO])) break; if (sp > XB_SPIN_CAP) { atomicAdd(&bar[XB_TMO], 1u); break; } }
    }
    nloc = mine > 0u ? mine : 1u; nx = cnt > 0u ? cnt : 1u;
}
__device__ __forceinline__ void xcd_barrier(const XcdBarrier& b) {
    asm volatile("s_waitcnt vmcnt(0)" ::: "memory");
    __syncthreads();
    if (b.wave == 0 && lane_id() == 0) {
        unsigned* bar = b.bar;
        __builtin_amdgcn_s_waitcnt(0);
        unsigned nloc = b.st[0], nx = b.st[1];
        if (nloc == 0u) { xcd_barrier_complete(bar, b.x, nloc, nx); b.st[0] = nloc; b.st[1] = nx; }
        const unsigned old = xb_add(&bar[XB_XSUB(b.x)], 1u);
        const unsigned gen = old / nloc;
        if (old + 1u == (gen + 1u) * nloc) {
            __builtin_amdgcn_fence(__ATOMIC_RELEASE, "agent");
            asm volatile("s_waitcnt vmcnt(0)" ::: "memory");
            const unsigned og = xb_add(&bar[XB_TOP], 1u);
            const unsigned tg = og / nx;
            if (og + 1u == (tg + 1u) * nx) xb_add(&bar[XB_TOPGEN], 1u);
            else XB_SPIN(xb_ld(&bar[XB_TOPGEN]) == tg, bar);
            __builtin_amdgcn_fence(__ATOMIC_ACQUIRE, "agent");
            xb_add(&bar[XB_XGEN(b.x)], 1u);
            asm volatile("s_waitcnt vmcnt(0)" ::: "memory");
        } else {
            XB_SPIN(xb_ld(&bar[XB_XGEN(b.x)]) == gen, bar);
            __builtin_amdgcn_fence(__ATOMIC_ACQUIRE, "agent");
            asm volatile("s_waitcnt vmcnt(0)" ::: "memory");
        }
    }
    __syncthreads();
}

constexpr int BATCH = 2, T = 4096, D = 2048, DEPTH = 4, M = BATCH * T;
constexpr int DIN = 20480, DFF = 8192, NH = 8, NCH = 32;
constexpr float EPS = 1e-6f;
constexpr int ZC_RQ = 0, ZC_RK = 1024, ZC_RV = 2048, ZC_RG = 3072, ZC_NQ = 4096, ZC_NK = 5120, ZC_NV = 6144, ZC_SB = 7168, ZC_SC = 8192, ZC_SX = 9216, ZC_CA = 10240, ZC_CG = 11264, ZC_GATE = 12288;
constexpr int YC_RET = 0, YC_NA = 1024, YC_SC = 2048, YC_CF = 3072, YCW = 4096;
constexpr int MODW = 6 * D;

constexpr size_t MiB = (size_t)1 << 20;
constexpr size_t WS_CTL = 0, CTL_ZERO_BYTES = 1 * MiB;
constexpr size_t WS_MOD = 1 * MiB;
constexpr size_t WS_ROPE = 2 * MiB;
constexpr size_t WS_WIN = 4 * MiB;
constexpr size_t WS_WCAT = 324 * MiB;
constexpr size_t WS_WO = 388 * MiB;
constexpr size_t WS_W1 = 420 * MiB;
constexpr size_t WS_W2 = 548 * MiB;
constexpr size_t WS_H = 676 * MiB;
constexpr size_t WS_Z = 708 * MiB;
constexpr size_t WS_LST = 1028 * MiB;
constexpr size_t WS_SST = 1092 * MiB;
constexpr size_t WS_YCAT = 1124 * MiB;
constexpr size_t WS_MERGED = 1188 * MiB;
constexpr size_t WS_Y = 1220 * MiB;
constexpr size_t WS_U = 1284 * MiB;
constexpr size_t WS_END = 1412 * MiB;
constexpr int CW_BAR = 4096;

constexpr int RING_BYTES = 131072;
constexpr int LDSCTL_OFF = RING_BYTES, MISC_OFF = LDSCTL_OFF + 320;
constexpr int LDS_BYTES = 147456;

constexpr int N_PHASES = 2 + 10 * DEPTH;

struct Args { const float* in[23]; float* out; unsigned char* ws; int ph_lo, ph_hi; };

__device__ __forceinline__ void transpose_item(const float* W, int N, bf16* WT, int ldk, int koff, LAS float* scr, int kb, int nb, int lane) {
    const int k0 = 64 * kb, n0 = 32 * nb;
#pragma unroll 8
    for (int i = 0; i < 32; ++i) { const int kk = 2 * i + (lane >> 5); scr[kk * 33 + (lane & 31)] = W[(size_t)(k0 + kk) * N + n0 + (lane & 31)]; }
    LDS_WAIT(); asm volatile("" ::: "memory");
    const int c = lane & 7;
#pragma unroll
    for (int j = 0; j < 4; ++j) { const int n = (lane >> 3) + 8 * j; const LAS float* s = scr + (8 * c) * 33 + n;
        u32x4 o; o.x = pk_bf16(s[0 * 33], s[1 * 33]); o.y = pk_bf16(s[2 * 33], s[3 * 33]); o.z = pk_bf16(s[4 * 33], s[5 * 33]); o.w = pk_bf16(s[6 * 33], s[7 * 33]);
        *(u32x4*)(WT + (size_t)(n0 + n) * ldk + koff + k0 + 8 * c) = o; }
    LDS_WAIT(); asm volatile("" ::: "memory");
}

__device__ __forceinline__ void phase_prologue(const Args& a, LAS unsigned char* lds, int tid, int lane, int wave, int bid, int G) {
    unsigned char* ws = a.ws;
    {
        LAS float* scr = (LAS float*)(lds + wave * 16384);
        const int gw = bid * 8 + wave, NGW = G * 8;
        constexpr int I_IN = 32 * 640, I_BR = 16 * 64, I_O = 32 * 64, I_1 = 32 * 256, I_2 = 128 * 64, I_L = I_IN + 4 * I_BR + I_O + I_1 + I_2;
        for (int it = gw; it < DEPTH * I_L; it += NGW) {
            const int l = it / I_L; int r = it - l * I_L;
            if (r < I_IN) { transpose_item(a.in[8] + (size_t)l * D * DIN, DIN, (bf16*)(ws + WS_WIN) + (size_t)l * DIN * D, D, 0, scr, r / 640, r % 640, lane); continue; } r -= I_IN;
            if (r < 4 * I_BR) { const int br = r / I_BR, rr = r % I_BR;
                transpose_item(a.in[16 + br] + (size_t)l * 1024 * D, D, (bf16*)(ws + WS_WCAT) + (size_t)l * D * YCW, YCW, 1024 * br, scr, rr / 64, rr % 64, lane); continue; } r -= 4 * I_BR;
            if (r < I_O) { transpose_item(a.in[20] + (size_t)l * D * D, D, (bf16*)(ws + WS_WO) + (size_t)l * D * D, D, 0, scr, r / 64, r % 64, lane); continue; } r -= I_O;
            if (r < I_1) { transpose_item(a.in[21] + (size_t)l * D * DFF, DFF, (bf16*)(ws + WS_W1) + (size_t)l * DFF * D, D, 0, scr, r / 256, r % 256, lane); continue; } r -= I_1;
            transpose_item(a.in[22] + (size_t)l * DFF * D, D, (bf16*)(ws + WS_W2) + (size_t)l * D * DFF, DFF, 0, scr, r / 64, r % 64, lane);
        }
    }
    __syncthreads();
    {
        LAS float* cact = (LAS float*)lds;
        LAS float* red = (LAS float*)(lds + 16384);
        const float* c = a.in[1];
        for (int i = tid; i < 2 * D; i += 512) { const float v = c[i]; cact[i] = v * fsigmoid(v) ; }
        __syncthreads();
        for (int it = bid; it < DEPTH * 48; it += G) {
            const int l = it / 48, cb = it % 48;
            const float* W = a.in[2] + (size_t)l * D * MODW + cb * 256 + 4 * lane;
            f32x4 a0 = {0.f, 0.f, 0.f, 0.f}, a1 = {0.f, 0.f, 0.f, 0.f};
            const int kb = wave * 256;
#pragma unroll 8
            for (int k = 0; k < 256; ++k) { const f32x4 w = *(const f32x4*)(W + (size_t)(kb + k) * MODW); a0 += w * cact[kb + k]; a1 += w * cact[D + kb + k]; }
            *(LAS f32x4*)(red + (wave * 2 + 0) * 256 + 4 * lane) = a0;
            *(LAS f32x4*)(red + (wave * 2 + 1) * 256 + 4 * lane) = a1;
            __syncthreads();
            { const int b = tid >> 8, col = tid & 255; float s = a.in[3][(size_t)l * MODW + cb * 256 + col];
#pragma unroll
              for (int w = 0; w < 8; ++w) s += red[(w * 2 + b) * 256 + col];
              ((float*)(ws + WS_MOD))[((size_t)l * 2 + b) * MODW + cb * 256 + col] = s; }
            __syncthreads();
        }
    }
    {
        f32x2* tab = (f32x2*)(ws + WS_ROPE);
        for (int e = bid * 512 + tid; e < T * 64; e += G * 512) {
            const int pos = e >> 6, i = e & 63;
            double inv = 1.0; const double rr = 0.8659643233600653;
            for (int k = 0; k < i; ++k) inv *= rr;
            const double ang = (double)pos * inv;
            const double n = __builtin_rint(ang * 0.6366197723675814);
            double r = __builtin_fma(-n, 1.5707963267948966, ang); r = __builtin_fma(-n, 6.123233995736766e-17, r);
            const double r2 = r * r;
            const double sn = r * (1.0 + r2 * (-1.0 / 6 + r2 * (1.0 / 120 + r2 * (-1.0 / 5040 + r2 * (1.0 / 362880 + r2 * (-1.0 / 39916800 + r2 * (1.0 / 6227020800.0)))))));
            const double cs = 1.0 + r2 * (-0.5 + r2 * (1.0 / 24 + r2 * (-1.0 / 720 + r2 * (1.0 / 40320 + r2 * (-1.0 / 3628800 + r2 * (1.0 / 479001600 + r2 * (-1.0 / 87178291200.0)))))));
            const int q = (int)((long long)n & 3);
            double co, si;
            if (q == 0) { co = cs; si = sn; } else if (q == 1) { co = -sn; si = cs; } else if (q == 2) { co = -cs; si = -sn; } else { co = sn; si = -cs; }
            tab[e] = (f32x2){(float)co, (float)si};
        }
    }
}

__device__ __forceinline__ void norm_rows(const float* xsrc, float* xdst, const float* y, const float* ga  , const float* gpost,
                                          bool do_h, const float* sc, const float* sh, const float* gpre, bf16* hout, int gw, int NGW, int lane) {
    for (int row = gw; row < M; row += NGW) {
        const int b = row >> 12;
        const f32x4* xr = (const f32x4*)(xsrc + (size_t)row * D) + lane;
        f32x4 xv[8];
#pragma unroll
        for (int j = 0; j < 8; ++j) xv[j] = xr[64 * j];
        if (y) {
            const f32x4* yr = (const f32x4*)(y + (size_t)row * D) + lane;
            f32x4 yv[8]; float ss = 0.f;
#pragma unroll
            for (int j = 0; j < 8; ++j) { yv[j] = yr[64 * j]; ss += (yv[j].x * yv[j].x + yv[j].y * yv[j].y) + (yv[j].z * yv[j].z + yv[j].w * yv[j].w); }
            ss = wave_sum(ss);
            const float r = 1.0f / sqrtf(ss * (1.0f / D) + EPS);
            const f32x4* gar = (const f32x4*)(ga + (size_t)b * MODW) + lane; const f32x4* gp = (const f32x4*)gpost + lane;
#pragma unroll
            for (int j = 0; j < 8; ++j) xv[j] += gar[64 * j] * ((yv[j] * r) * gp[64 * j]);
        }
        f32x4* xw = (f32x4*)(xdst + (size_t)row * D) + lane;
#pragma unroll
        for (int j = 0; j < 8; ++j) xw[64 * j] = xv[j];
        if (do_h) {
            float ss = 0.f;
#pragma unroll
            for (int j = 0; j < 8; ++j) ss += (xv[j].x * xv[j].x + xv[j].y * xv[j].y) + (xv[j].z * xv[j].z + xv[j].w * xv[j].w);
            ss = wave_sum(ss);
            const float r = 1.0f / sqrtf(ss * (1.0f / D) + EPS);
            const f32x4* scr = (const f32x4*)(sc + (size_t)b * MODW) + lane; const f32x4* shr = (const f32x4*)(sh + (size_t)b * MODW) + lane; const f32x4* gp = (const f32x4*)gpre + lane;
            u32x2* ho = (u32x2*)(hout + (size_t)row * D) + lane;
#pragma unroll
            for (int j = 0; j < 8; ++j) { const f32x4 hv = ((xv[j] * r) * gp[64 * j]) * (scr[64 * j] + 1.0f) + shr[64 * j];
                u32x2 w; w.x = pk_bf16(hv.x, hv.y); w.y = pk_bf16(hv.z, hv.w); ho[64 * j] = w; }
        }
    }
}

constexpr int CT = 16;
__device__ __forceinline__ void conv_units(const bf16* Z, bf16* YC, const float* scw, const float* cfw, const float* cfg, const float* cfb,
                                           LAS unsigned char* lds, int tid, int lane, int wave, int bid, int G) {
    const unsigned c00 = 2u * (unsigned)tid;
    LAS unsigned char* U = lds;
    LAS float* red = (LAS float*)(lds + (CT + 30) * 2048);
    LAS float* tot = red + 8 * 2 * CT;
    for (int u = bid; u < M / CT; u += G) {
        const int row0 = CT * u, b = row0 >> 12, ts = row0 & 4095;
        unsigned c0 = c00; asm volatile("" : "+v"(c0));
        const bf16* Zb = Z + (size_t)b * T * DIN;
        for (int it = tid; it < (CT + 30) * 128; it += 512) {
            const int row = it >> 7, ch = it & 127, tok = ts - 15 + row;
            u32x4 o = {0u, 0u, 0u, 0u};
            if (tok >= 0 && tok < T) {
                const u32x4 av = *(const u32x4*)(Zb + (size_t)tok * DIN + ZC_CA + 8 * ch), gv = *(const u32x4*)(Zb + (size_t)tok * DIN + ZC_CG + 8 * ch);
                o.x = pk_bf16(bf_lo(av.x) * fsigmoid(bf_lo(gv.x)), bf_hi(av.x) * fsigmoid(bf_hi(gv.x)));
                o.y = pk_bf16(bf_lo(av.y) * fsigmoid(bf_lo(gv.y)), bf_hi(av.y) * fsigmoid(bf_hi(gv.y)));
                o.z = pk_bf16(bf_lo(av.z) * fsigmoid(bf_lo(gv.z)), bf_hi(av.z) * fsigmoid(bf_hi(gv.z)));
                o.w = pk_bf16(bf_lo(av.w) * fsigmoid(bf_lo(gv.w)), bf_hi(av.w) * fsigmoid(bf_hi(gv.w)));
            }
            *(LAS u32x4*)(U + row * 2048 + ch * 16) = o;
        }
        __syncthreads();
        float w[31][2];
#pragma unroll
        for (int k = 0; k < 31; ++k) { const f32x2 t = *(const f32x2*)((cfw + k * 1024) + c0); w[k][0] = t.x; w[k][1] = t.y; }
        float acc[CT][2];
#pragma unroll
        for (int t = 0; t < CT; ++t) { acc[t][0] = 0.f; acc[t][1] = 0.f; }
#pragma unroll
        for (int j = 0; j < CT + 30; ++j) {
            const unsigned uv = *(const LAS unsigned*)(U + (j * 2048u + c0 * 2u));
            const float u0 = bf_lo(uv), u1 = bf_hi(uv);
#pragma unroll
            for (int t = 0; t < CT; ++t) { const int k = j - t; if (k >= 0 && k <= 30) { acc[t][0] += w[k][0] * u0; acc[t][1] += w[k][1] * u1; } }
            if ((j & 7) == 7) asm volatile("" ::: "memory");
        }
        const f32x2 lg = *(const f32x2*)(cfg + c0), lb = *(const f32x2*)(cfb + c0);
        float st[2 * CT];
#pragma unroll
        for (int t = 0; t < CT; ++t) { st[t] = wave_sum(acc[t][0] + acc[t][1]); st[CT + t] = wave_sum(acc[t][0] * acc[t][0] + acc[t][1] * acc[t][1]); }
        if (lane == 0) {
#pragma unroll
            for (int i = 0; i < 2 * CT; ++i) red[wave * 2 * CT + i] = st[i]; }
        __syncthreads();
        if (tid < 2 * CT) { float s = 0.f;
#pragma unroll
            for (int wv = 0; wv < 8; ++wv) s += red[wv * 2 * CT + tid];
            tot[tid] = s; }
        __syncthreads();
#pragma unroll
        for (int t = 0; t < CT; ++t) {
            const float mu = tot[t] * (1.0f / 1024), var = fmaxf(tot[CT + t] * (1.0f / 1024) - mu * mu, 0.f), rs = 1.0f / sqrtf(var + EPS);
            float y0 = (acc[t][0] - mu) * rs * lg.x + lb.x, y1 = (acc[t][1] - mu) * rs * lg.y + lb.y;
            y0 *= fsigmoid(y0); y1 *= fsigmoid(y1);
            *(unsigned*)(YC + (size_t)(row0 + t) * YCW + YC_CF + c0) = pk_bf16(y0, y1);
        }
        LAS float* P = (LAS float*)U;
        for (int it = tid; it < (CT + 2) * 128; it += 512) {
            const int row = it >> 7, ch = it & 127, tok = ts - 1 + row;
            f32x4 p0 = {0.f, 0.f, 0.f, 0.f}, p1 = {0.f, 0.f, 0.f, 0.f};
            if (tok >= 0 && tok < T) {
                const u32x4 cv = *(const u32x4*)(Zb + (size_t)tok * DIN + ZC_SC + 8 * ch), xv = *(const u32x4*)(Zb + (size_t)tok * DIN + ZC_SX + 8 * ch);
                p0 = (f32x4){bf_lo(cv.x) * bf_lo(xv.x), bf_hi(cv.x) * bf_hi(xv.x), bf_lo(cv.y) * bf_lo(xv.y), bf_hi(cv.y) * bf_hi(xv.y)};
                p1 = (f32x4){bf_lo(cv.z) * bf_lo(xv.z), bf_hi(cv.z) * bf_hi(xv.z), bf_lo(cv.w) * bf_lo(xv.w), bf_hi(cv.w) * bf_hi(xv.w)};
            }
            *(LAS f32x4*)(P + row * 1024 + ch * 8) = p0; *(LAS f32x4*)(P + row * 1024 + ch * 8 + 4) = p1;
        }
        __syncthreads();
        {
            float w3[3][2];
#pragma unroll
            for (int k = 0; k < 3; ++k) { const f32x2 t = *(const f32x2*)((scw + k * 1024) + c0); w3[k][0] = t.x; w3[k][1] = t.y; }
            f32x2 pa = *(const LAS f32x2*)(P + 0 * 1024 + c0), pb = *(const LAS f32x2*)(P + 1 * 1024 + c0);
            for (int t = 0; t < CT; ++t) {
                const f32x2 pc = *(const LAS f32x2*)(P + (t + 2) * 1024 + c0);
                const unsigned sb2 = *(const unsigned*)(Zb + (size_t)(ts + t) * DIN + ZC_SB + c0);
                const float o0 = w3[0][0] * pa.x + w3[1][0] * pb.x + w3[2][0] * pc.x;
                const float o1 = w3[0][1] * pa.y + w3[1][1] * pb.y + w3[2][1] * pc.y;
                *(unsigned*)(YC + (size_t)(row0 + t) * YCW + YC_SC + c0) = pk_bf16(bf_lo(sb2) * o0, bf_hi(sb2) * o1);
                pa = pb; pb = pc;
            }
        }
        __syncthreads();
    }
}

__device__ __forceinline__ float log2_sigmoid(float x) { return -log1pf(expf(-x)) * 1.4426950408889634f; }
constexpr int RP = 136 * 2;

__device__ __forceinline__ void ret_local_units(const bf16* Z, const f32x2* rope, const float* dec_f, const float* dec_b, float* LST,
                                                LAS unsigned char* lds, int tid, int lane, int wave, int bid, int G) {
    LAS unsigned char* Ktf = lds; LAS unsigned char* Ktb = lds + 128 * RP; LAS unsigned char* Vt = lds + 2 * 128 * RP;
    const int fr = lane & 15, g = lane >> 4;
    for (int u = bid; u < 16 * NCH; u += G) {
        const int chunk = u & 31, bh = u >> 5, b = bh >> 3, h = bh & 7;
        const float lf2 = log2_sigmoid(dec_f[h]), lb2 = log2_sigmoid(dec_b[h]);
        const size_t rowb = (size_t)b * T + chunk * 128;
#pragma unroll
        for (int rep = 0; rep < 2; ++rep) {
            const int it = tid + 512 * rep, j = it & 127, c = it >> 7;
            const bf16* zr = Z + (rowb + j) * DIN + ZC_RK + h * 128 + 8 * c;
            const u32x4 k1 = *(const u32x4*)zr, k2 = *(const u32x4*)(zr + 64);
            const f32x4* cs = (const f32x4*)(rope + (size_t)(chunk * 128 + j) * 64 + 8 * c);
            const f32x4 cs0 = cs[0], cs1 = cs[1], cs2 = cs[2], cs3 = cs[3];
            const float cosv[8] = {cs0.x, cs0.z, cs1.x, cs1.z, cs2.x, cs2.z, cs3.x, cs3.z}, sinv[8] = {cs0.y, cs0.w, cs1.y, cs1.w, cs2.y, cs2.w, cs3.y, cs3.w};
            const unsigned k1w[4] = {k1.x, k1.y, k1.z, k1.w}, k2w[4] = {k2.x, k2.y, k2.z, k2.w};
            const float df = exp2f(lf2 * (float)(127 - j)) * 0.08838834764831845f, db = exp2f(lb2 * (float)j) * 0.08838834764831845f;
#pragma unroll
            for (int e = 0; e < 8; ++e) {
                const float x1 = (e & 1) ? bf_hi(k1w[e >> 1]) : bf_lo(k1w[e >> 1]), x2 = (e & 1) ? bf_hi(k2w[e >> 1]) : bf_lo(k2w[e >> 1]);
                const float o1 = x1 * cosv[e] - x2 * sinv[e], o2 = x1 * sinv[e] + x2 * cosv[e];
                const unsigned pf = pk_bf16(o1 * df, o2 * df), pb = pk_bf16(o1 * db, o2 * db);
                *(LAS bf16*)(Ktf + (8 * c + e) * RP + 2 * j) = (bf16)(pf & 0xffffu); *(LAS bf16*)(Ktf + (64 + 8 * c + e) * RP + 2 * j) = (bf16)(pf >> 16);
                *(LAS bf16*)(Ktb + (8 * c + e) * RP + 2 * j) = (bf16)(pb & 0xffffu); *(LAS bf16*)(Ktb + (64 + 8 * c + e) * RP + 2 * j) = (bf16)(pb >> 16);
            }
        }
#pragma unroll
        for (int rep = 0; rep < 4; ++rep) {
            const int it = tid + 512 * rep, j = it & 127, c = it >> 7;
            const u32x4 v = *(const u32x4*)(Z + (rowb + j) * DIN + ZC_RV + h * 128 + 8 * c);
            const unsigned vw[4] = {v.x, v.y, v.z, v.w};
#pragma unroll
            for (int e = 0; e < 8; ++e) *(LAS bf16*)(Vt + (8 * c + e) * RP + 2 * j) = (bf16)((e & 1) ? (vw[e >> 1] >> 16) : (vw[e >> 1] & 0xffffu));
        }
        __syncthreads();
        f32x4 acc[2][8];
#pragma unroll
        for (int d = 0; d < 2; ++d)
#pragma unroll
            for (int i = 0; i < 8; ++i) acc[d][i] = (f32x4){0.f, 0.f, 0.f, 0.f};
#pragma unroll
        for (int ks = 0; ks < 4; ++ks) {
            const bf16x8 bv = *(const LAS bf16x8*)(Vt + (16 * wave + fr) * RP + (32 * ks + 8 * g) * 2);
#pragma unroll
            for (int i = 0; i < 8; ++i) {
                const bf16x8 af = *(const LAS bf16x8*)(Ktf + (16 * i + fr) * RP + (32 * ks + 8 * g) * 2);
                const bf16x8 ab = *(const LAS bf16x8*)(Ktb + (16 * i + fr) * RP + (32 * ks + 8 * g) * 2);
                acc[0][i] = MFMA16(af, bv, acc[0][i]); acc[1][i] = MFMA16(ab, bv, acc[1][i]);
            }
        }
#pragma unroll
        for (int d = 0; d < 2; ++d) { float* Lb = LST + ((size_t)((d * 16 + bh) * NCH + chunk)) * 16384 + (size_t)(16 * wave + fr) * 128 + 4 * g;
#pragma unroll
            for (int i = 0; i < 8; ++i) *(f32x4*)(Lb + 16 * i) = acc[d][i]; }
        __syncthreads();
    }
}

__device__ __forceinline__ void ret_scan(const float* LST, bf16* SST, const float* dec_f, const float* dec_b, int tid, int bid, int G) {
    for (int e = bid * 512 + tid; e < 2 * 16 * 4096; e += G * 512) {
        const int dir = e >> 16, rem = e & 65535, bh = rem >> 12, q4 = rem & 4095, h = bh & 7;
        const float dec = exp2f(log2_sigmoid(dir ? dec_b[h] : dec_f[h]) * 128.0f);
        const size_t base = (size_t)((dir * 16 + bh) * NCH) * 16384 + 4 * (size_t)q4;
        f32x4 s = {0.f, 0.f, 0.f, 0.f};
        if (dir == 0) {
#pragma unroll 8
            for (int i = 0; i < NCH; ++i) { u32x2 w; w.x = pk_bf16(s.x, s.y); w.y = pk_bf16(s.z, s.w); *(u32x2*)(SST + base + (size_t)i * 16384) = w;
                s = *(const f32x4*)(LST + base + (size_t)i * 16384) + s * dec; }
        } else {
#pragma unroll 8
            for (int i = NCH - 1; i >= 0; --i) { u32x2 w; w.x = pk_bf16(s.x, s.y); w.y = pk_bf16(s.z, s.w); *(u32x2*)(SST + base + (size_t)i * 16384) = w;
                s = *(const f32x4*)(LST + base + (size_t)i * 16384) + s * dec; }
        }
    }
}

__device__ __forceinline__ void ret_out_units(const bf16* Z, const f32x2* rope, const float* dec_f, const float* dec_b, const bf16* SST, bf16* YC,
                                              LAS unsigned char* lds, int tid, int lane, int wave, int bid, int G) {
    LAS unsigned char* Kl = lds; LAS unsigned char* Vt = lds + 128 * RP; LAS unsigned char* Pl = lds + 2 * 128 * RP + wave * 16 * RP;
    const int fr = lane & 15, g = lane >> 4;
    for (int u = bid; u < 16 * NCH; u += G) {
        const int chunk = u & 31, bh = u >> 5, b = bh >> 3, h = bh & 7;
        const float lf2 = log2_sigmoid(dec_f[h]), lb2 = log2_sigmoid(dec_b[h]);
        const size_t rowb = (size_t)b * T + chunk * 128;
#pragma unroll
        for (int rep = 0; rep < 2; ++rep) {
            const int it = tid + 512 * rep, j = it >> 3, c = it & 7;
            const bf16* zr = Z + (rowb + j) * DIN + ZC_RK + h * 128 + 8 * c;
            const u32x4 k1 = *(const u32x4*)zr, k2 = *(const u32x4*)(zr + 64);
            const f32x4* cs = (const f32x4*)(rope + (size_t)(chunk * 128 + j) * 64 + 8 * c);
            const f32x4 cs0 = cs[0], cs1 = cs[1], cs2 = cs[2], cs3 = cs[3];
            const float cosv[8] = {cs0.x, cs0.z, cs1.x, cs1.z, cs2.x, cs2.z, cs3.x, cs3.z}, sinv[8] = {cs0.y, cs0.w, cs1.y, cs1.w, cs2.y, cs2.w, cs3.y, cs3.w};
            const unsigned k1w[4] = {k1.x, k1.y, k1.z, k1.w}, k2w[4] = {k2.x, k2.y, k2.z, k2.w};
            float o1[8], o2[8];
#pragma unroll
            for (int e = 0; e < 8; ++e) {
                const float x1 = (e & 1) ? bf_hi(k1w[e >> 1]) : bf_lo(k1w[e >> 1]), x2 = (e & 1) ? bf_hi(k2w[e >> 1]) : bf_lo(k2w[e >> 1]);
                o1[e] = (x1 * cosv[e] - x2 * sinv[e]) * 0.08838834764831845f; o2[e] = (x1 * sinv[e] + x2 * cosv[e]) * 0.08838834764831845f;
            }
            u32x4 w1, w2; w1.x = pk_bf16(o1[0], o1[1]); w1.y = pk_bf16(o1[2], o1[3]); w1.z = pk_bf16(o1[4], o1[5]); w1.w = pk_bf16(o1[6], o1[7]);
            w2.x = pk_bf16(o2[0], o2[1]); w2.y = pk_bf16(o2[2], o2[3]); w2.z = pk_bf16(o2[4], o2[5]); w2.w = pk_bf16(o2[6], o2[7]);
            *(LAS u32x4*)(Kl + j * RP + 16 * c) = w1; *(LAS u32x4*)(Kl + j * RP + 128 + 16 * c) = w2;
        }
#pragma unroll
        for (int rep = 0; rep < 4; ++rep) {
            const int it = tid + 512 * rep, j = it & 127, c = it >> 7;
            const u32x4 v = *(const u32x4*)(Z + (rowb + j) * DIN + ZC_RV + h * 128 + 8 * c);
            const unsigned vw[4] = {v.x, v.y, v.z, v.w};
#pragma unroll
            for (int e = 0; e < 8; ++e) *(LAS bf16*)(Vt + (8 * c + e) * RP + 2 * j) = (bf16)((e & 1) ? (vw[e >> 1] >> 16) : (vw[e >> 1] & 0xffffu));
        }
        const int q = 16 * wave + fr;
        bf16x8 qf[4];
        {
            const bf16* zr = Z + (rowb + q) * DIN + ZC_RQ + h * 128 + 8 * g;
#pragma unroll
            for (int ks = 0; ks < 2; ++ks) {
                const u32x4 x1v = *(const u32x4*)(zr + 32 * ks), x2v = *(const u32x4*)(zr + 32 * ks + 64);
                const f32x4* cs = (const f32x4*)(rope + (size_t)(chunk * 128 + q) * 64 + 32 * ks + 8 * g);
                const f32x4 cs0 = cs[0], cs1 = cs[1], cs2 = cs[2], cs3 = cs[3];
                const float cosv[8] = {cs0.x, cs0.z, cs1.x, cs1.z, cs2.x, cs2.z, cs3.x, cs3.z}, sinv[8] = {cs0.y, cs0.w, cs1.y, cs1.w, cs2.y, cs2.w, cs3.y, cs3.w};
                const unsigned x1w[4] = {x1v.x, x1v.y, x1v.z, x1v.w}, x2w[4] = {x2v.x, x2v.y, x2v.z, x2v.w};
                float o1[8], o2[8];
#pragma unroll
                for (int e = 0; e < 8; ++e) {
                    const float x1 = (e & 1) ? bf_hi(x1w[e >> 1]) : bf_lo(x1w[e >> 1]), x2 = (e & 1) ? bf_hi(x2w[e >> 1]) : bf_lo(x2w[e >> 1]);
                    o1[e] = x1 * cosv[e] - x2 * sinv[e]; o2[e] = x1 * sinv[e] + x2 * cosv[e];
                }
                u32x4 w1, w2; w1.x = pk_bf16(o1[0], o1[1]); w1.y = pk_bf16(o1[2], o1[3]); w1.z = pk_bf16(o1[4], o1[5]); w1.w = pk_bf16(o1[6], o1[7]);
                w2.x = pk_bf16(o2[0], o2[1]); w2.y = pk_bf16(o2[2], o2[3]); w2.z = pk_bf16(o2[4], o2[5]); w2.w = pk_bf16(o2[6], o2[7]);
                qf[ks] = __builtin_bit_cast(bf16x8, w1); qf[ks + 2] = __builtin_bit_cast(bf16x8, w2);
            }
        }
        __syncthreads();
#pragma unroll
        for (int kt = 0; kt < 8; ++kt) {
            f32x4 s = {0.f, 0.f, 0.f, 0.f};
#pragma unroll
            for (int ks = 0; ks < 4; ++ks) { const bf16x8 a = *(const LAS bf16x8*)(Kl + (16 * kt + fr) * RP + (32 * ks + 8 * g) * 2); s = MFMA16(a, qf[ks], s); }
            float pv[4];
#pragma unroll
            for (int r = 0; r < 4; ++r) { const int m = 16 * kt + 4 * g + r, diff = q - m;
                const float dc = diff >= 0 ? exp2f(lf2 * (float)diff) : exp2f(lb2 * (float)(-diff)); pv[r] = s[r] * dc; }
            u32x2 w; w.x = pk_bf16(pv[0], pv[1]); w.y = pk_bf16(pv[2], pv[3]);
            *(LAS u32x2*)(Pl + fr * RP + (16 * kt + 4 * g) * 2) = w;
        }
        LDS_WAIT();
        f32x4 o[8];
#pragma unroll
        for (int i = 0; i < 8; ++i) o[i] = (f32x4){0.f, 0.f, 0.f, 0.f};
#pragma unroll
        for (int ks = 0; ks < 4; ++ks) {
            const bf16x8 pb = *(const LAS bf16x8*)(Pl + fr * RP + (32 * ks + 8 * g) * 2);
#pragma unroll
            for (int i = 0; i < 8; ++i) { const bf16x8 a = *(const LAS bf16x8*)(Vt + (16 * i + fr) * RP + (32 * ks + 8 * g) * 2); o[i] = MFMA16(a, pb, o[i]); }
        }
#pragma unroll
        for (int d = 0; d < 2; ++d) {
            const float qd = d == 0 ? exp2f(lf2 * (float)(q + 1)) : exp2f(lb2 * (float)(128 - q));
            const bf16* Sb = SST + ((size_t)((d * 16 + bh) * NCH + chunk)) * 16384 + (size_t)fr * 128 + 8 * g;
#pragma unroll
            for (int i = 0; i < 8; ++i) {
                f32x4 c = {0.f, 0.f, 0.f, 0.f};
#pragma unroll
                for (int ks = 0; ks < 4; ++ks) { const bf16x8 a = *(const bf16x8*)(Sb + (size_t)(16 * i) * 128 + 32 * ks); c = MFMA16(a, qf[ks], c); }
                o[i] += c * qd;
            }
        }
        float s1 = 0.f;
#pragma unroll
        for (int i = 0; i < 8; ++i) s1 += (o[i].x + o[i].y) + (o[i].z + o[i].w);
        s1 += __shfl_xor(s1, 16); s1 += __shfl_xor(s1, 32);
        const float mu = s1 * (1.0f / 128);
        float s2 = 0.f;
#pragma unroll
        for (int i = 0; i < 8; ++i) { const f32x4 dd = o[i] - mu; s2 += (dd.x * dd.x + dd.y * dd.y) + (dd.z * dd.z + dd.w * dd.w); }
        s2 += __shfl_xor(s2, 16); s2 += __shfl_xor(s2, 32);
        const float rs = 1.0f / sqrtf(s2 * (1.0f / 128) + EPS);
        const bf16* rgp = Z + (rowb + q) * DIN + ZC_RG + h * 128 + 4 * g;
        bf16* yo = YC + (rowb + q) * YCW + YC_RET + h * 128 + 4 * g;
#pragma unroll
        for (int i = 0; i < 8; ++i) {
            const u32x2 rg = *(const u32x2*)(rgp + 16 * i);
            const float g0 = bf_lo(rg.x), g1 = bf_hi(rg.x), g2 = bf_lo(rg.y), g3 = bf_hi(rg.y);
            u32x2 w; w.x = pk_bf16(g0 * fsigmoid(g0) * ((o[i].x - mu) * rs), g1 * fsigmoid(g1) * ((o[i].y - mu) * rs));
            w.y = pk_bf16(g2 * fsigmoid(g2) * ((o[i].z - mu) * rs), g3 * fsigmoid(g3) * ((o[i].w - mu) * rs));
            *(u32x2*)(yo + 16 * i) = w;
        }
        __syncthreads();
    }
}

constexpr int NP = 72 * 2;
__device__ __forceinline__ void na_units(const bf16* Z, const float* rpb  , bf16* YC, LAS unsigned char* lds, int tid, int lane, int wave, int bid, int G) {
    LAS unsigned char* Kl = lds;
    LAS unsigned char* Vt = lds + 64 * RP;
    LAS unsigned char* Pl = lds + 64 * RP + 128 * NP + wave * 16 * NP;
    LAS float* bias = (LAS float*)(lds + 64 * RP + 128 * NP + 8 * 16 * NP);
    const int fr = lane & 15, g = lane >> 4;
    for (int u = bid; u < 16 * 32; u += G) {
        const int rp = u & 31, bh = u >> 5, b = bh >> 3, h = bh & 7, r0 = 2 * rp;
        for (int i = tid; i < 465; i += 512) bias[i] = rpb[h * 465 + i];
        const int qr = r0 + (wave >> 2), c = 16 * (wave & 3) + fr;
        const size_t rowq = (size_t)b * T + qr * 64 + c;
        bf16x8 qf[4];
#pragma unroll
        for (int ks = 0; ks < 4; ++ks) qf[ks] = *(const bf16x8*)(Z + rowq * DIN + ZC_NQ + h * 128 + 32 * ks + 8 * g);
        const int rs_q = min(max(qr - 4, 0), 56), cs_q = min(max(c - 8, 0), 48);
        const int kr_lo = min(max(r0 - 4, 0), 56), kr_hi = min(max(r0 - 3, 0), 56) + 7;
        float m_run = -INFINITY, l_run = 0.f;
        f32x4 o[8];
#pragma unroll
        for (int i = 0; i < 8; ++i) o[i] = (f32x4){0.f, 0.f, 0.f, 0.f};
        for (int kr = kr_lo; kr <= kr_hi; ++kr) {
            const size_t rowk = (size_t)b * T + kr * 64;
#pragma unroll
            for (int rep = 0; rep < 2; ++rep) { const int it = tid + 512 * rep, kc = it >> 4, ch = it & 15;
                *(LAS u32x4*)(Kl + kc * RP + 16 * ch) = *(const u32x4*)(Z + (rowk + kc) * DIN + ZC_NK + h * 128 + 8 * ch); }
#pragma unroll
            for (int rep = 0; rep < 2; ++rep) { const int it = tid + 512 * rep, kc = it & 63, ch = it >> 6;
                const u32x4 v = *(const u32x4*)(Z + (rowk + kc) * DIN + ZC_NV + h * 128 + 8 * ch);
                const unsigned vw[4] = {v.x, v.y, v.z, v.w};
#pragma unroll
                for (int e = 0; e < 8; ++e) *(LAS bf16*)(Vt + (8 * ch + e) * NP + 2 * kc) = (bf16)((e & 1) ? (vw[e >> 1] >> 16) : (vw[e >> 1] & 0xffffu)); }
            __syncthreads();
            if (kr >= rs_q && kr < rs_q + 8) {
                float s[4][4]; float mx = -INFINITY;
#pragma unroll
                for (int kt = 0; kt < 4; ++kt) {
                    f32x4 a4 = {0.f, 0.f, 0.f, 0.f};
#pragma unroll
                    for (int ks = 0; ks < 4; ++ks) { const bf16x8 a = *(const LAS bf16x8*)(Kl + (16 * kt + fr) * RP + (32 * ks + 8 * g) * 2); a4 = MFMA16(a, qf[ks], a4); }
#pragma unroll
                    for (int r = 0; r < 4; ++r) { const int kc = 16 * kt + 4 * g + r; const bool valid = (kc >= cs_q) && (kc < cs_q + 16);
                        const int bi = valid ? ((kr - qr + 7) * 31 + (kc - c + 15)) : 0;
                        const float sv = valid ? (a4[r] * 0.08838834764831845f + bias[bi]) : -INFINITY; s[kt][r] = sv; mx = fmaxf(mx, sv); }
                }
                mx = fmaxf(mx, __shfl_xor(mx, 16)); mx = fmaxf(mx, __shfl_xor(mx, 32));
                const float m_new = fmaxf(m_run, mx), alpha = __expf(m_run - m_new);
                float ps = 0.f;
#pragma unroll
                for (int kt = 0; kt < 4; ++kt) {
#pragma unroll
                    for (int r = 0; r < 4; ++r) { s[kt][r] = __expf(s[kt][r] - m_new); ps += s[kt][r]; }
                    u32x2 w; w.x = pk_bf16(s[kt][0], s[kt][1]); w.y = pk_bf16(s[kt][2], s[kt][3]);
                    *(LAS u32x2*)(Pl + fr * NP + (16 * kt + 4 * g) * 2) = w;
                }
                ps += __shfl_xor(ps, 16); ps += __shfl_xor(ps, 32);
                l_run = l_run * alpha + ps; m_run = m_new;
#pragma unroll
                for (int i = 0; i < 8; ++i) o[i] *= alpha;
                LDS_WAIT();
#pragma unroll
                for (int ks = 0; ks < 2; ++ks) {
                    const bf16x8 pb = *(const LAS bf16x8*)(Pl + fr * NP + (32 * ks + 8 * g) * 2);
#pragma unroll
                    for (int i = 0; i < 8; ++i) { const bf16x8 a = *(const LAS bf16x8*)(Vt + (16 * i + fr) * NP + (32 * ks + 8 * g) * 2); o[i] = MFMA16(a, pb, o[i]); }
                }
            }
            __syncthreads();
        }
        const float inv = 1.0f / l_run;
        bf16* yo = YC + rowq * YCW + YC_NA + h * 128 + 4 * g;
#pragma unroll
        for (int i = 0; i < 8; ++i) { u32x2 w; w.x = pk_bf16(o[i].x * inv, o[i].y * inv); w.y = pk_bf16(o[i].z * inv, o[i].w * inv); *(u32x2*)(yo + 16 * i) = w; }
    }
}

#define PH_BEGIN() int wave = wave0; asm volatile("" : "+s"(wave)); const int lane = lane_id(); const int tid = wave * 64 + lane; \
    int G = G0, bid = bid0; asm volatile("" : "+s"(G), "+s"(bid)); unsigned char* ws = args.ws; asm volatile("" : "+s"(ws)); \
    LAS unsigned char* lds = lds0; asm volatile("" : "+s"(lds)); (void)lane; (void)wave; (void)G; (void)bid; (void)ws; (void)lds
__global__ void __launch_bounds__(512, 2) fwd(Args args) {
    extern __shared__ __attribute__((aligned(16))) unsigned char lds_raw[];
    LAS unsigned char* lds0 = (LAS unsigned char*)lds_raw;
    const int wave0 = __builtin_amdgcn_readfirstlane(threadIdx.x >> 6);
    const int G0 = gridDim.x, bid0 = blockIdx.x;
    volatile LAS unsigned* MISC = (volatile LAS unsigned*)(lds0 + MISC_OFF);
    for (int u = wave0 * 64 + lane_id(); u < (LDS_BYTES - LDSCTL_OFF) / 4; u += 512) ((LAS unsigned*)(lds0 + LDSCTL_OFF))[u] = 0u;
    __syncthreads();
    const int lo = args.ph_lo, hi = args.ph_hi;
    XcdBarrier bar; bar.bar = (unsigned*)(args.ws + WS_CTL) + CW_BAR; bar.x = 0; bar.st = nullptr; bar.wave = wave0;
    if (hi - lo > 1) bar = xcd_barrier_post((unsigned*)(args.ws + WS_CTL) + CW_BAR, MISC + 8, wave0);
#define IN(k) (lo <= (k) && (k) < hi)
#define SEAM(k) do { if (IN((k) + 1)) { XcdBarrier bb_ = bar; asm volatile("" : "+s"(bb_.bar), "+s"(bb_.x), "+s"(bb_.wave)); xcd_barrier(bb_); } } while (0)

    if (IN(0)) { PH_BEGIN(); phase_prologue(args, lds, tid, lane, wave, bid, G); SEAM(0); }
    if (IN(1)) {
        PH_BEGIN(); const float* MOD = (const float*)(ws + WS_MOD);
        norm_rows(args.in[0], args.out, nullptr, nullptr, nullptr, true, MOD + 1 * D, MOD + 0 * D, args.in[4], (bf16*)(ws + WS_H), bid * 8 + wave, G * 8, lane);
        SEAM(1);
    }
#define LAYER_BODY(l) do { \
        const int p0 = 2 + 10 * l; \
        if (IN(p0 + 0)) { \
            PH_BEGIN(); \
            pg8::Gemm g{(const bf16*)(ws + WS_H), (const bf16*)(ws + WS_WIN) + (size_t)l * DIN * D, M, DIN, D}; pg8::StaticOrder S; S.init(M, DIN, G, bid); \
            pg8::EpiBf16<2> E{(bf16*)(ws + WS_Z), DIN, ZC_GATE / 256}; \
            pg8::gemm_phase<pg8::EpiBf16<2>, pg8::StaticOrder, true, true>(lds, g, S, E, tid); \
            SEAM(p0 + 0); \
        } \
        if (IN(p0 + 1)) { \
            PH_BEGIN(); \
            ret_local_units((const bf16*)(ws + WS_Z), (const f32x2*)(ws + WS_ROPE), args.in[9] + l * NH, args.in[10] + l * NH, (float*)(ws + WS_LST), lds, tid, lane, wave, bid, G); \
            conv_units((const bf16*)(ws + WS_Z), (bf16*)(ws + WS_YCAT), args.in[12] + (size_t)l * 3 * 1024, args.in[13] + (size_t)l * 31 * 1024, args.in[14] + (size_t)l * 1024, args.in[15] + (size_t)l * 1024, lds, tid, lane, wave, bid, G); \
            SEAM(p0 + 1); \
        } \
        if (IN(p0 + 2)) { \
            PH_BEGIN(); \
            ret_scan((const float*)(ws + WS_LST), (bf16*)(ws + WS_SST), args.in[9] + l * NH, args.in[10] + l * NH, tid, bid, G); \
            na_units((const bf16*)(ws + WS_Z), args.in[11] + (size_t)l * NH * 465, (bf16*)(ws + WS_YCAT), lds, tid, lane, wave, bid, G); \
            SEAM(p0 + 2); \
        } \
        if (IN(p0 + 3)) { \
            PH_BEGIN(); \
            ret_out_units((const bf16*)(ws + WS_Z), (const f32x2*)(ws + WS_ROPE), args.in[9] + l * NH, args.in[10] + l * NH, (const bf16*)(ws + WS_SST), (bf16*)(ws + WS_YCAT), lds, tid, lane, wave, bid, G); \
            SEAM(p0 + 3); \
        } \
        if (IN(p0 + 4)) { \
            PH_BEGIN(); \
            pg8::Gemm g{(const bf16*)(ws + WS_YCAT), (const bf16*)(ws + WS_WCAT) + (size_t)l * D * YCW, M, D, YCW}; pg8::StaticOrder S; S.init(M, D, G, bid); \
            pg8::EpiMerge E{(const bf16*)(ws + WS_Z) + ZC_GATE, DIN, (bf16*)(ws + WS_MERGED), D}; \
            pg8::gemm_phase<pg8::EpiMerge, pg8::StaticOrder, false, true>(lds, g, S, E, tid); \
            SEAM(p0 + 4); \
        } \
        if (IN(p0 + 5)) { \
            PH_BEGIN(); \
            pg8::Gemm g{(const bf16*)(ws + WS_MERGED), (const bf16*)(ws + WS_WO) + (size_t)l * D * D, M, D, D}; pg8::StaticOrder S; S.init(M, D, G, bid); \
            pg8::EpiF32 E{(float*)(ws + WS_Y), D}; \
            pg8::gemm_phase<pg8::EpiF32, pg8::StaticOrder, false, true>(lds, g, S, E, tid); \
            SEAM(p0 + 5); \
        } \
        if (IN(p0 + 6)) { \
            PH_BEGIN(); const float* modl = (const float*)(ws + WS_MOD) + (size_t)l * 2 * MODW; \
            norm_rows(args.out, args.out, (const float*)(ws + WS_Y), modl + 2 * D, args.in[5] + (size_t)l * D, true, modl + 4 * D, modl + 3 * D, args.in[6] + (size_t)l * D, (bf16*)(ws + WS_H), bid * 8 + wave, G * 8, lane); \
            SEAM(p0 + 6); \
        } \
        if (IN(p0 + 7)) { \
            PH_BEGIN(); \
            pg8::Gemm g{(const bf16*)(ws + WS_H), (const bf16*)(ws + WS_W1) + (size_t)l * DFF * D, M, DFF, D}; pg8::StaticOrder S; S.init(M, DFF, G, bid); \
            pg8::EpiBf16<1> E{(bf16*)(ws + WS_U), DFF, 0}; \
            pg8::gemm_phase<pg8::EpiBf16<1>, pg8::StaticOrder, true, true>(lds, g, S, E, tid); \
            SEAM(p0 + 7); \
        } \
        if (IN(p0 + 8)) { \
            PH_BEGIN(); \
            pg8::Gemm g{(const bf16*)(ws + WS_U), (const bf16*)(ws + WS_W2) + (size_t)l * D * DFF, M, D, DFF}; pg8::StaticOrder S; S.init(M, D, G, bid); \
            pg8::EpiF32 E{(float*)(ws + WS_Y), D}; \
            pg8::gemm_phase<pg8::EpiF32, pg8::StaticOrder, false, true>(lds, g, S, E, tid); \
            SEAM(p0 + 8); \
        } \
        if (IN(p0 + 9)) { \
            PH_BEGIN(); const float* modl = (const float*)(ws + WS_MOD) + (size_t)l * 2 * MODW; \
            const bool nh = (l + 1 < DEPTH); const float* modn = (const float*)(ws + WS_MOD) + (size_t)(nh ? l + 1 : l) * 2 * MODW; \
            norm_rows(args.out, args.out, (const float*)(ws + WS_Y), modl + 5 * D, args.in[7] + (size_t)l * D, nh, modn + 1 * D, modn + 0 * D, args.in[4] + (size_t)(nh ? l + 1 : l) * D, (bf16*)(ws + WS_H), bid * 8 + wave, G * 8, lane); \
            SEAM(p0 + 9); \
        } \
    } while (0)
    LAYER_BODY(0); LAYER_BODY(1); LAYER_BODY(2); LAYER_BODY(3);
#undef IN
#undef SEAM
}

extern "C" void kernel_launch(void* const* d_in, const int* in_sizes, int n_in, void* d_out, int out_size, void* d_ws, size_t ws_size, hipStream_t stream) {
    static int grid = 0;
    if (grid == 0) {
        if (n_in != 23 || out_size != M * D || ws_size < WS_END) { fprintf(stderr, "kernel_launch: unexpected problem (n_in %d, out %d, ws %zu)\n", n_in, out_size, ws_size); grid = -1; return; }
        int dev = 0, cus = 0, per_cu = 0;
        if (hipGetDevice(&dev) != hipSuccess || hipDeviceGetAttribute(&cus, hipDeviceAttributeMultiprocessorCount, dev) != hipSuccess) { grid = -1; return; }
        if (hipFuncSetAttribute((const void*)fwd, hipFuncAttributeMaxDynamicSharedMemorySize, LDS_BYTES) != hipSuccess) { fprintf(stderr, "kernel_launch: hipFuncSetAttribute failed\n"); grid = -1; return; }
        if (hipOccupancyMaxActiveBlocksPerMultiprocessor(&per_cu, (const void*)fwd, 512, LDS_BYTES) != hipSuccess || per_cu < 1) fprintf(stderr, "kernel_launch: occupancy query says %d\n", per_cu);
        (void)hipGetLastError();
        grid = cus;
    }
    if (grid < 0) return;
    (void)hipMemsetAsync((char*)d_ws + WS_CTL, 0, CTL_ZERO_BYTES, stream);
    Args a{};
    for (int i = 0; i < 23; ++i) a.in[i] = (const float*)d_in[i];
    a.out = (float*)d_out; a.ws = (unsigned char*)d_ws;
#if MK_SINGLE_LAUNCH
    a.ph_lo = 0; a.ph_hi = N_PHASES;
    hipLaunchKernelGGL(fwd, dim3(grid), dim3(512), LDS_BYTES, stream, a);
#else
    for (int p = 0; p < N_PHASES; ++p) { a.ph_lo = p; a.ph_hi = p + 1; hipLaunchKernelGGL(fwd, dim3(grid), dim3(512), LDS_BYTES, stream, a); }
#endif
}
```

```cpp
#include <hip/hip_runtime.h>
#include <cstdio>
#include <cstdint>

#define LAS __attribute__((address_space(3)))
#define GAS __attribute__((address_space(1)))
#define REP_G1 1
#define REP_M1 1
#define REP_M2 1
#define REP_M3 1
#define REP_G2 1
#define REP_G3 1
#define REP_G4 1
#define REP_G5 1
#define REP_PRO 1
#ifndef MK_SINGLE_LAUNCH
#define MK_SINGLE_LAUNCH 1
#endif

typedef unsigned short bf16;
typedef short bf16x8 __attribute__((ext_vector_type(8)));
typedef float f32x4 __attribute__((ext_vector_type(4)));
typedef float f32x2 __attribute__((ext_vector_type(2)));
typedef unsigned u32x4 __attribute__((ext_vector_type(4)));
typedef unsigned u32x2 __attribute__((ext_vector_type(2)));

__device__ __forceinline__ unsigned pk_bf16(float lo, float hi) { unsigned r; asm("v_cvt_pk_bf16_f32 %0, %1, %2" : "=v"(r) : "v"(lo), "v"(hi)); return r; }
__device__ __forceinline__ float bf_lo(unsigned w) { return __uint_as_float(w << 16); }
__device__ __forceinline__ float bf_hi(unsigned w) { return __uint_as_float(w & 0xffff0000u); }
__device__ __forceinline__ float fsigmoid(float x) { return __builtin_amdgcn_rcpf(1.0f + __expf(-x)); }
__device__ __forceinline__ float wave_sum(float v) {
#pragma unroll
    for (int o = 1; o < 64; o <<= 1) v += __shfl_xor(v, o);
    return v;
}
#define MFMA16(a, b, c) __builtin_amdgcn_mfma_f32_16x16x32_bf16((a), (b), (c), 0, 0, 0)
#define LDS_WAIT() asm volatile("s_waitcnt lgkmcnt(0)" ::: "memory")
#define VM_WAIT() asm volatile("s_waitcnt vmcnt(0)" ::: "memory")

namespace pg8 {
#define PG8_LAS __attribute__((address_space(3)))
typedef unsigned short bf16_t;
constexpr int BM = 256, BK = 64, HALF = 128, HTB = HALF * BK * 2, STAGE_BYTES = 8 * HTB, NXCD = 8, WGM = 8;

__host__ __device__ __forceinline__ int lds_byte(int r, int c) { const int st = (r >> 4) * 2 + (c >> 5), rr = r & 15, cc = c & 31, ob = rr * 64 + cc * 2; return st * 1024 + (ob ^ (((ob >> 9) & 1) << 5)); }
__host__ __device__ __forceinline__ void stage_rc(int b, int& R, int& C) { const int st = b / 1024, sb = b % 1024, swz = sb ^ (((sb >> 9) & 1) << 5); R = (st >> 1) * 16 + swz / 64; C = (st & 1) * 32 + (swz % 64) / 2; }
__host__ __device__ __forceinline__ int perm32(int rho) { const int n = rho >> 4, i = rho & 15; return 8 * (i >> 2) + 4 * n + (i & 3); }

struct Unit { int pm, pn; };
struct Gemm { const bf16_t* A; const bf16_t* Bt; int M, N, K; };

struct StaticOrder {
    int nM, nN, nwg, G, c;
    __host__ __device__ void init(int M, int N, int G_, int c_) { nM = M / BM; nN = N / BM; nwg = nM * nN; G = G_; c = c_; }
    __host__ __device__ bool next(int i, Unit& u) const {
        const long L = (long)i * G + c; if (L >= nwg) return false;
        int wgid = (int)L; { const int q = nwg / NXCD, r = nwg % NXCD, xcd = wgid % NXCD, off = wgid / NXCD; wgid = (xcd < r ? xcd * (q + 1) : r * (q + 1) + (xcd - r) * q) + off; }
        const int nig = WGM * nN, gid = wgid / nig, fm = gid * WGM, gsz = (nM - fm) < WGM ? (nM - fm) : WGM;
        u.pm = fm + ((wgid % nig) % gsz); u.pn = (wgid % nig) / gsz; return true;
    }
    __device__ __forceinline__ void a_ready(const Unit&) const {}
    __device__ __forceinline__ void done(const Unit&) const {}
};

struct EpiF32 {
    static constexpr bool PERM = false, AFTER_DRAIN = false, KHOOK = false;
    float* C; int ldc;
    __device__ __forceinline__ void operator()(const f32x4 (&acc)[2][2][4][2], const Unit& u, int wr, int wc, int fr, int fq) const {
        const int row0 = u.pm * BM + wr * 64 + fr, col0 = u.pn * BM + wc * 32 + 4 * fq;
#pragma unroll
        for (int ai = 0; ai < 2; ++ai)
#pragma unroll
            for (int m = 0; m < 4; ++m) { float* rowp = C + (size_t)(row0 + ai * HALF + m * 16) * ldc + col0;
#pragma unroll
                for (int bj = 0; bj < 2; ++bj)
#pragma unroll
                    for (int n = 0; n < 2; ++n) *(f32x4*)(rowp + bj * HALF + n * 16) = acc[ai][bj][m][n]; }
    }
    __device__ __forceinline__ void khook(f32x4 (&)[2][2][4][2], const Unit&, int, int, int, int, int) const {}
};
template <int ACT> struct EpiBf16 {
    static constexpr bool PERM = true, AFTER_DRAIN = false, KHOOK = false;
    bf16_t* O; int ldc; int sig_pn0;
    __device__ __forceinline__ void operator()(const f32x4 (&acc)[2][2][4][2], const Unit& u, int wr, int wc, int fr, int fq) const {
        const int row0 = u.pm * BM + wr * 64 + fr; const int col0 = u.pn * BM + wc * 32 + 8 * fq;
        const bool sig = (ACT == 2) && (u.pn >= sig_pn0);
#pragma unroll
        for (int ai = 0; ai < 2; ++ai)
#pragma unroll
            for (int m = 0; m < 4; ++m) { bf16_t* rowp = O + (size_t)(row0 + ai * HALF + m * 16) * ldc + col0;
#pragma unroll
                for (int bj = 0; bj < 2; ++bj) { f32x4 v0 = acc[ai][bj][m][0], v1 = acc[ai][bj][m][1];
                    if (ACT == 1) {
#pragma unroll
                        for (int j = 0; j < 4; ++j) { const float a = fmaxf(v0[j], 0.f), b = fmaxf(v1[j], 0.f); v0[j] = a * a; v1[j] = b * b; } }
                    if (ACT == 2) { if (sig) {
#pragma unroll
                        for (int j = 0; j < 4; ++j) { v0[j] = fmaxf(fsigmoid(v0[j]), 1e-20f); v1[j] = fmaxf(fsigmoid(v1[j]), 1e-20f); } } }
                    u32x4 w; w.x = pk_bf16(v0[0], v0[1]); w.y = pk_bf16(v0[2], v0[3]); w.z = pk_bf16(v1[0], v1[1]); w.w = pk_bf16(v1[2], v1[3]);
                    *(u32x4*)(rowp + bj * HALF) = w; } }
    }
    __device__ __forceinline__ void khook(f32x4 (&)[2][2][4][2], const Unit&, int, int, int, int, int) const {}
};
struct EpiMerge {
    static constexpr bool PERM = true, AFTER_DRAIN = false, KHOOK = true;
    const bf16_t* G; int ldg;
    bf16_t* O; int ldc;
    __device__ __forceinline__ void khook(f32x4 (&acc)[2][2][4][2], const Unit& u, int b, int wr, int wc, int fr, int fq) const {
        const int row0 = u.pm * BM + wr * 64 + fr; const int col0 = u.pn * BM + wc * 32 + 8 * fq;
#pragma unroll
        for (int ai = 0; ai < 2; ++ai) {
#pragma unroll
            for (int m = 0; m < 4; ++m) { const bf16_t* gp = G + (size_t)(row0 + ai * HALF + m * 16) * ldg + col0;
#pragma unroll
                for (int bj = 0; bj < 2; ++bj) { const u32x4 ga = *(const u32x4*)(gp + (b - 1) * 2048 + bj * HALF), gb = *(const u32x4*)(gp + b * 2048 + bj * HALF);
                    f32x4 r0, r1;
                    r0[0] = bf_lo(ga.x) * __builtin_amdgcn_rcpf(bf_lo(gb.x)); r0[1] = bf_hi(ga.x) * __builtin_amdgcn_rcpf(bf_hi(gb.x));
                    r0[2] = bf_lo(ga.y) * __builtin_amdgcn_rcpf(bf_lo(gb.y)); r0[3] = bf_hi(ga.y) * __builtin_amdgcn_rcpf(bf_hi(gb.y));
                    r1[0] = bf_lo(ga.z) * __builtin_amdgcn_rcpf(bf_lo(gb.z)); r1[1] = bf_hi(ga.z) * __builtin_amdgcn_rcpf(bf_hi(gb.z));
                    r1[2] = bf_lo(ga.w) * __builtin_amdgcn_rcpf(bf_lo(gb.w)); r1[3] = bf_hi(ga.w) * __builtin_amdgcn_rcpf(bf_hi(gb.w));
                    acc[ai][bj][m][0] *= r0; acc[ai][bj][m][1] *= r1; }
                if (m & 1) asm volatile("" ::: "memory"); } }
    }
    __device__ __forceinline__ void operator()(const f32x4 (&acc)[2][2][4][2], const Unit& u, int wr, int wc, int fr, int fq) const {
        const int row0 = u.pm * BM + wr * 64 + fr; const int col0 = u.pn * BM + wc * 32 + 8 * fq;
#pragma unroll
        for (int ai = 0; ai < 2; ++ai)
#pragma unroll
            for (int m = 0; m < 4; ++m) { const size_t r = (size_t)(row0 + ai * HALF + m * 16);
#pragma unroll
                for (int bj = 0; bj < 2; ++bj) { const u32x4 g = *(const u32x4*)(G + r * ldg + col0 + 3 * 2048 + bj * HALF);
                    f32x4 v0 = acc[ai][bj][m][0], v1 = acc[ai][bj][m][1];
                    v0[0] *= bf_lo(g.x); v0[1] *= bf_hi(g.x); v0[2] *= bf_lo(g.y); v0[3] *= bf_hi(g.y);
                    v1[0] *= bf_lo(g.z); v1[1] *= bf_hi(g.z); v1[2] *= bf_lo(g.w); v1[3] *= bf_hi(g.w);
                    u32x4 w; w.x = pk_bf16(v0[0], v0[1]); w.y = pk_bf16(v0[2], v0[3]); w.z = pk_bf16(v1[0], v1[1]); w.w = pk_bf16(v1[2], v1[3]);
                    *(u32x4*)(O + r * ldc + col0 + bj * HALF) = w; } }
    }
};

template <class Epi, class Sched, bool ALIGN_EPI = false, bool SP2 = false>
__device__ __forceinline__ void gemm_phase(PG8_LAS unsigned char* lds, const Gemm g, const Sched& S, const Epi& E, const int tid) {
    const int wid = __builtin_amdgcn_readfirstlane(tid >> 6), lane = tid & 63, wr = wid >> 2, wc = wid & 3, fr = lane & 15, fq = lane >> 4;
    const int K = g.K, nt = K / BK;
    unsigned voffA[2], voffB[2];
#pragma unroll
    for (int i = 0; i < 2; ++i) { int R, C; stage_rc(tid * 16 + i * 8192, R, C); const int Rb = Epi::PERM ? ((R & ~31) + perm32(R & 31)) : R;
        voffA[i] = (unsigned)(R * K + C) * 2u; voffB[i] = (unsigned)(Rb * K + C) * 2u; }
    const size_t kstep = (size_t)(BK * 2);
    const size_t hstep = (size_t)HALF * K * 2;
    const size_t tstep = 2 * hstep;
    const unsigned ldsw = (unsigned)wid * 1024u;
    const int aoff = lds_byte(wr * 64 + fr, fq * 8), boff = lds_byte(wc * 32 + fr, fq * 8);
#define PG8_SA(b, h) (((b) * 2 + (h)) * HTB)
#define PG8_SB(b, h) ((4 + (b) * 2 + (h)) * HTB)
#define PG8_STAGE(bufoff, gbase, voff) do { _Pragma("unroll") for (int _i = 0; _i < 2; ++_i) \
        __builtin_amdgcn_global_load_lds((const unsigned*)((const char*)(gbase) + (voff)[_i]), (PG8_LAS unsigned*)(lds + (bufoff) + ldsw + _i * 8192), 16, 0, 0); } while (0)
#define PG8_LDA(dst, b, h) do { _Pragma("unroll") for (int m = 0; m < 4; ++m) _Pragma("unroll") for (int k = 0; k < 2; ++k) dst[m][k] = *(const PG8_LAS bf16x8*)(lds + PG8_SA(b, h) + aoff + m * 2048 + k * 1024); } while (0)
#define PG8_LDB(dst, b, h) do { _Pragma("unroll") for (int n = 0; n < 2; ++n) _Pragma("unroll") for (int k = 0; k < 2; ++k) dst[n][k] = *(const PG8_LAS bf16x8*)(lds + PG8_SB(b, h) + boff + n * 2048 + k * 1024); } while (0)
#define PG8_MMA(ai, bj, At, Bt) do { __builtin_amdgcn_s_setprio(1); _Pragma("unroll") for (int m = 0; m < 4; ++m) _Pragma("unroll") for (int n = 0; n < 2; ++n) _Pragma("unroll") for (int k = 0; k < 2; ++k) \
        acc[ai][bj][m][n] = __builtin_amdgcn_mfma_f32_16x16x32_bf16(Bt[n][k], At[m][k], acc[ai][bj][m][n], 0, 0, 0); __builtin_amdgcn_s_setprio(0); } while (0)
#define PG8_WAIT_V(n) asm volatile("s_waitcnt vmcnt(" #n ")" ::: "memory")
#define PG8_WAIT_L(n) asm volatile("s_waitcnt lgkmcnt(" #n ")" ::: "memory")
#define PG8_BAR __builtin_amdgcn_s_barrier()
#define PG8_SCHED __builtin_amdgcn_sched_barrier(0)
    Unit cur, nxt; int ui = 0;
    if (!S.next(0, cur)) return;
    f32x4 acc[2][2][4][2];
#pragma unroll
    for (int a = 0; a < 2; ++a)
#pragma unroll
        for (int b = 0; b < 2; ++b)
#pragma unroll
            for (int m = 0; m < 4; ++m)
#pragma unroll
                for (int n = 0; n < 2; ++n) acc[a][b][m][n] = (f32x4){0.f, 0.f, 0.f, 0.f};
    bf16x8 At[4][2], B0[2][2], B1[2][2];
    const char* cA = (const char*)g.A + (size_t)cur.pm * tstep; const char* cB = (const char*)g.Bt + (size_t)cur.pn * tstep;
    S.a_ready(cur);
    if constexpr (SP2) {
        PG8_STAGE(PG8_SB(0, 0), cB, voffB); PG8_STAGE(PG8_SB(0, 1), cB + hstep, voffB); PG8_STAGE(PG8_SA(0, 0), cA, voffA); PG8_STAGE(PG8_SA(0, 1), cA + hstep, voffA);
        if (wr == 1) PG8_BAR;
        PG8_WAIT_V(2); PG8_BAR;
        PG8_STAGE(PG8_SB(1, 0), cB + kstep, voffB); PG8_STAGE(PG8_SA(1, 0), cA + kstep, voffA); PG8_STAGE(PG8_SB(1, 1), cB + hstep + kstep, voffB);
        PG8_WAIT_V(6); PG8_BAR;
    } else {
        PG8_STAGE(PG8_SB(0, 0), cB, voffB); PG8_STAGE(PG8_SA(0, 0), cA, voffA); PG8_STAGE(PG8_SB(0, 1), cB + hstep, voffB); PG8_STAGE(PG8_SA(0, 1), cA + hstep, voffA);
        if (wr == 1) PG8_BAR;
        PG8_WAIT_V(4); PG8_BAR;
        PG8_STAGE(PG8_SB(1, 0), cB + kstep, voffB); PG8_STAGE(PG8_SA(1, 0), cA + kstep, voffA); PG8_STAGE(PG8_SB(1, 1), cB + hstep + kstep, voffB);
        PG8_WAIT_V(6); PG8_BAR;
    }
    for (;;) {
        const bool has_next = S.next(ui + 1, nxt);
        const char* nA = has_next ? (const char*)g.A + (size_t)nxt.pm * tstep : cA; const char* nB = has_next ? (const char*)g.Bt + (size_t)nxt.pn * tstep : cB;
        for (int t = 0; t < nt; t += 2) {
            const bool last = (t == nt - 2);
            const char* a1 = cA + (size_t)(t + 1) * kstep;
            const char* a2 = last ? nA : cA + (size_t)(t + 2) * kstep; const char* b2 = last ? nB : cB + (size_t)(t + 2) * kstep;
            const char* a3 = a2 + kstep; const char* b3 = b2 + kstep;
            if (last && has_next) S.a_ready(nxt);
            if constexpr (Epi::KHOOK) { if (t != 0 && (t & 15) == 0) E.khook(acc, cur, t >> 4, wr, wc, fr, fq); }
            if constexpr (SP2) {
            PG8_LDB(B0, 0, 0); PG8_LDB(B1, 0, 1); PG8_SCHED; PG8_LDA(At, 0, 0); PG8_STAGE(PG8_SA(1, 1), a1 + hstep, voffA);
            PG8_WAIT_V(8); PG8_WAIT_L(0); PG8_BAR; PG8_MMA(0, 0, At, B0); PG8_MMA(0, 1, At, B1); PG8_BAR; PG8_SCHED;
            PG8_LDA(At, 0, 1); PG8_STAGE(PG8_SB(0, 0), b2, voffB); PG8_STAGE(PG8_SB(0, 1), b2 + hstep, voffB); PG8_STAGE(PG8_SA(0, 0), a2, voffA);
            PG8_WAIT_V(8); PG8_WAIT_L(0); PG8_BAR; PG8_MMA(1, 0, At, B0); PG8_MMA(1, 1, At, B1); PG8_BAR; PG8_SCHED;
            PG8_LDB(B0, 1, 0); PG8_LDB(B1, 1, 1); PG8_SCHED; PG8_LDA(At, 1, 0); PG8_STAGE(PG8_SA(0, 1), a2 + hstep, voffA);
            PG8_WAIT_V(8); PG8_WAIT_L(0); PG8_BAR; PG8_MMA(0, 0, At, B0); PG8_MMA(0, 1, At, B1); PG8_BAR; PG8_SCHED;
            PG8_LDA(At, 1, 1); PG8_STAGE(PG8_SB(1, 0), b3, voffB); PG8_STAGE(PG8_SB(1, 1), b3 + hstep, voffB); PG8_STAGE(PG8_SA(1, 0), a3, voffA);
            PG8_WAIT_V(8); PG8_WAIT_L(0); PG8_BAR; PG8_MMA(1, 0, At, B0); PG8_MMA(1, 1, At, B1); PG8_BAR; PG8_SCHED;
            } else {
            PG8_LDB(B0, 0, 0); PG8_SCHED; PG8_LDA(At, 0, 0); PG8_STAGE(PG8_SA(1, 1), a1 + hstep, voffA);
            PG8_WAIT_L(8); PG8_BAR; PG8_WAIT_L(0); PG8_MMA(0, 0, At, B0); PG8_BAR; PG8_SCHED;
            PG8_LDB(B1, 0, 1); PG8_STAGE(PG8_SB(0, 0), b2, voffB);
            PG8_BAR; PG8_WAIT_L(0); PG8_MMA(0, 1, At, B1); PG8_BAR;
            PG8_LDA(At, 0, 1); PG8_STAGE(PG8_SA(0, 0), a2, voffA);
            PG8_BAR; PG8_WAIT_L(0); PG8_MMA(1, 0, At, B0); PG8_BAR; PG8_SCHED;
            PG8_STAGE(PG8_SB(0, 1), b2 + hstep, voffB);
            PG8_WAIT_V(6); PG8_BAR; PG8_MMA(1, 1, At, B1); PG8_BAR;
            PG8_LDB(B0, 1, 0); PG8_SCHED; PG8_LDA(At, 1, 0); PG8_STAGE(PG8_SA(0, 1), a2 + hstep, voffA);
            PG8_WAIT_L(8); PG8_BAR; PG8_WAIT_L(0); PG8_MMA(0, 0, At, B0); PG8_BAR; PG8_SCHED;
            PG8_LDB(B1, 1, 1); PG8_STAGE(PG8_SB(1, 0), b3, voffB);
            PG8_BAR; PG8_WAIT_L(0); PG8_MMA(0, 1, At, B1); PG8_BAR;
            PG8_LDA(At, 1, 1); PG8_STAGE(PG8_SA(1, 0), a3, voffA);
            PG8_BAR; PG8_WAIT_L(0); PG8_MMA(1, 0, At, B0); PG8_BAR; PG8_SCHED;
            PG8_STAGE(PG8_SB(1, 1), b3 + hstep, voffB);
            PG8_WAIT_V(6); PG8_BAR; PG8_MMA(1, 1, At, B1); PG8_BAR;
            }
        }
        if constexpr (ALIGN_EPI) { if (wr == 0) PG8_BAR; }
        if constexpr (!Epi::AFTER_DRAIN) { E(acc, cur, wr, wc, fr, fq); S.done(cur); }
        if (!has_next) break;
#pragma unroll
        for (int a = 0; a < 2; ++a)
#pragma unroll
            for (int b = 0; b < 2; ++b)
#pragma unroll
                for (int m = 0; m < 4; ++m)
#pragma unroll
                    for (int n = 0; n < 2; ++n) acc[a][b][m][n] = (f32x4){0.f, 0.f, 0.f, 0.f};
        cur = nxt; cA = nA; cB = nB; ++ui;
        if constexpr (ALIGN_EPI) { if (wr == 1) PG8_BAR; }
    }
    PG8_WAIT_V(0);
    if constexpr (!ALIGN_EPI) { if (wr == 0) PG8_BAR; }
    PG8_BAR;
#undef PG8_SA
#undef PG8_SB
#undef PG8_STAGE
#undef PG8_LDA
#undef PG8_LDB
#undef PG8_MMA
#undef PG8_WAIT_V
#undef PG8_WAIT_L
#undef PG8_BAR
#undef PG8_SCHED
}
}

#define XB_TMO      128
#define XB_XCNT(j)  (256  + 64 * (j))
#define XB_XSUB(j)  (1280 + 64 * (j))
#define XB_XGEN(j)  (2304 + 64 * (j))
#define XB_TOP      3328
#define XB_TOPGEN   3392
#define XCD_BAR_WORDS 3456
#define XB_SPIN_CAP (1u << 18)

__device__ __forceinline__ unsigned xb_ld(unsigned* p)              { return __hip_atomic_load(p, __ATOMIC_RELAXED, __HIP_MEMORY_SCOPE_AGENT); }
__device__ __forceinline__ unsigned xb_add(unsigned* p, unsigned v) { return __hip_atomic_fetch_add(p, v, __ATOMIC_RELAXED, __HIP_MEMORY_SCOPE_AGENT); }
__device__ __forceinline__ unsigned xb_xcc_id() { return (unsigned)__builtin_amdgcn_s_getreg((3 << 11) | 20) & 0xFu; }
#define XB_SPIN(cond, bar) do { unsigned _sp = 0; while (cond) { __builtin_amdgcn_s_sleep(1); \
    if ((++_sp & 255u) == 0u) { if (xb_ld(&(bar)[XB_TMO])) break; if (_sp > XB_SPIN_CAP) { atomicAdd(&(bar)[XB_TMO], 1u); break; } } } } while (0)

struct XcdBarrier {
    unsigned* bar; unsigned x;
    volatile LAS unsigned* st;
    int wave;
};
__device__ __forceinline__ int lane_id() { int l; asm volatile("v_mbcnt_lo_u32_b32 %0, -1, 0\n\tv_mbcnt_hi_u32_b32 %0, -1, %0" : "=v"(l)); return l; }
__device__ __forceinline__ XcdBarrier xcd_barrier_post(unsigned* bar, volatile LAS unsigned* st, int wave) {
    XcdBarrier b; b.bar = bar; b.x = xb_xcc_id(); b.st = st; b.wave = wave;
    if (wave == 0 && lane_id() == 0) (void)xb_add(&bar[XB_XCNT(b.x)], 1u);
    return b;
}
__device__ __forceinline__ void xcd_barrier_complete(unsigned* bar, unsigned x, unsigned& nloc, unsigned& nx) {
    const unsigned G = gridDim.x * gridDim.y * gridDim.z;
    unsigned sum, cnt, mine, sp = 0u;
    for (;;) {
        sum = 0u; cnt = 0u; mine = 0u;
#pragma unroll
        for (unsigned j = 0; j < 16; ++j) { const unsigned c = xb_ld(&bar[XB_XCNT(j)]); sum += c; cnt += (c > 0u) ? 1u : 0u; mine = (j == x) ? c : mine; }
        if (sum == G) break;
        __builtin_amdgcn_s_sleep(1);
        if ((++sp & 255u) == 0u) { if (xb_ld(&bar[XB_TMO])) break; if (sp > XB_SPIN_CAP) { atomicAdd(&bar[XB_TMO], 1u); break; } }
    }
    nloc = mine > 0u ? mine : 1u; nx = cnt > 0u ? cnt : 1u;
}
__device__ __forceinline__ void xcd_barrier(const XcdBarrier& b) {
    asm volatile("s_waitcnt vmcnt(0)" ::: "memory");
    __syncthreads();
    if (b.wave == 0 && lane_id() == 0) {
        unsigned* bar = b.bar;
        __builtin_amdgcn_s_waitcnt(0);
        unsigned nloc = b.st[0], nx = b.st[1];
        if (nloc == 0u) { xcd_barrier_complete(bar, b.x, nloc, nx); b.st[0] = nloc; b.st[1] = nx; }
        const unsigned old = xb_add(&bar[XB_XSUB(b.x)], 1u);
        const unsigned gen = old / nloc;
        if (old + 1u == (gen + 1u) * nloc) {
            __builtin_amdgcn_fence(__ATOMIC_RELEASE, "agent");
            asm volatile("s_waitcnt vmcnt(0)" ::: "memory");
            const unsigned og = xb_add(&bar[XB_TOP], 1u);
            const unsigned tg = og / nx;
            if (og + 1u == (tg + 1u) * nx) xb_add(&bar[XB_TOPGEN], 1u);
            else XB_SPIN(xb_ld(&bar[XB_TOPGEN]) == tg, bar);
            __builtin_amdgcn_fence(__ATOMIC_ACQUIRE, "agent");
            xb_add(&bar[XB_XGEN(b.x)], 1u);
            asm volatile("s_waitcnt vmcnt(0)" ::: "memory");
        } else {
            XB_SPIN(xb_ld(&bar[XB_XGEN(b.x)]) == gen, bar);
            __builtin_amdgcn_fence(__ATOMIC_ACQUIRE, "agent");
            asm volatile("s_waitcnt vmcnt(0)" ::: "memory");
        }
    }
    __syncthreads();
}

constexpr int BATCH = 2, T = 4096, D = 2048, DEPTH = 4, M = BATCH * T;
constexpr int DIN = 20480, DFF = 8192, NH = 8, NCH = 32;
constexpr float EPS = 1e-6f;
constexpr int ZC_RQ = 0, ZC_RK = 1024, ZC_RV = 2048, ZC_RG = 3072, ZC_NQ = 4096, ZC_NK = 5120, ZC_NV = 6144, ZC_SB = 7168, ZC_SC = 8192, ZC_SX = 9216, ZC_CA = 10240, ZC_CG = 11264, ZC_GATE = 12288;
constexpr int YC_RET = 0, YC_NA = 1024, YC_SC = 2048, YC_CF = 3072, YCW = 4096;
constexpr int MODW = 6 * D;

constexpr size_t MiB = (size_t)1 << 20;
constexpr size_t WS_CTL = 0, CTL_ZERO_BYTES = 1 * MiB;
constexpr size_t WS_MOD = 1 * MiB;
constexpr size_t WS_ROPE = 2 * MiB;
constexpr size_t WS_WIN = 4 * MiB;
constexpr size_t WS_WCAT = 324 * MiB;
constexpr size_t WS_WO = 388 * MiB;
constexpr size_t WS_W1 = 420 * MiB;
constexpr size_t WS_W2 = 548 * MiB;
constexpr size_t WS_H = 676 * MiB;
constexpr size_t WS_Z = 708 * MiB;
constexpr size_t WS_LST = 1028 * MiB;
constexpr size_t WS_SST = 1092 * MiB;
constexpr size_t WS_YCAT = 1124 * MiB;
constexpr size_t WS_MERGED = 1188 * MiB;
constexpr size_t WS_Y = 1220 * MiB;
constexpr size_t WS_U = 1284 * MiB;
constexpr size_t WS_END = 1412 * MiB;
constexpr int CW_BAR = 4096;

constexpr int RING_BYTES = 131072;
constexpr int LDSCTL_OFF = RING_BYTES, MISC_OFF = LDSCTL_OFF + 320;
constexpr int LDS_BYTES = 147456;

constexpr int N_PHASES = 2 + 10 * DEPTH;

struct Args { const float* in[23]; float* out; unsigned char* ws; int ph_lo, ph_hi; };

__device__ __forceinline__ void transpose_item(const float* W, int N, bf16* WT, int ldk, int koff, LAS float* scr, int kb, int nb, int lane) {
    const int k0 = 64 * kb, n0 = 32 * nb;
#pragma unroll 8
    for (int i = 0; i < 32; ++i) { const int kk = 2 * i + (lane >> 5); scr[kk * 33 + (lane & 31)] = W[(size_t)(k0 + kk) * N + n0 + (lane & 31)]; }
    LDS_WAIT(); asm volatile("" ::: "memory");
    const int c = lane & 7;
#pragma unroll
    for (int j = 0; j < 4; ++j) { const int n = (lane >> 3) + 8 * j; const LAS float* s = scr + (8 * c) * 33 + n;
        u32x4 o; o.x = pk_bf16(s[0 * 33], s[1 * 33]); o.y = pk_bf16(s[2 * 33], s[3 * 33]); o.z = pk_bf16(s[4 * 33], s[5 * 33]); o.w = pk_bf16(s[6 * 33], s[7 * 33]);
        *(u32x4*)(WT + (size_t)(n0 + n) * ldk + koff + k0 + 8 * c) = o; }
    LDS_WAIT(); asm volatile("" ::: "memory");
}

__device__ __forceinline__ void phase_prologue(const Args& a, LAS unsigned char* lds, int tid, int lane, int wave, int bid, int G) {
    unsigned char* ws = a.ws;
    {
        LAS float* scr = (LAS float*)(lds + wave * 16384);
        const int gw = bid * 8 + wave, NGW = G * 8;
        constexpr int I_IN = 32 * 640, I_BR = 16 * 64, I_O = 32 * 64, I_1 = 32 * 256, I_2 = 128 * 64, I_L = I_IN + 4 * I_BR + I_O + I_1 + I_2;
        for (int it = gw; it < DEPTH * I_L; it += NGW) {
            const int l = it / I_L; int r = it - l * I_L;
            if (r < I_IN) { transpose_item(a.in[8] + (size_t)l * D * DIN, DIN, (bf16*)(ws + WS_WIN) + (size_t)l * DIN * D, D, 0, scr, r / 640, r % 640, lane); continue; } r -= I_IN;
            if (r < 4 * I_BR) { const int br = r / I_BR, rr = r % I_BR;
                transpose_item(a.in[16 + br] + (size_t)l * 1024 * D, D, (bf16*)(ws + WS_WCAT) + (size_t)l * D * YCW, YCW, 1024 * br, scr, rr / 64, rr % 64, lane); continue; } r -= 4 * I_BR;
            if (r < I_O) { transpose_item(a.in[20] + (size_t)l * D * D, D, (bf16*)(ws + WS_WO) + (size_t)l * D * D, D, 0, scr, r / 64, r % 64, lane); continue; } r -= I_O;
            if (r < I_1) { transpose_item(a.in[21] + (size_t)l * D * DFF, DFF, (bf16*)(ws + WS_W1) + (size_t)l * DFF * D, D, 0, scr, r / 256, r % 256, lane); continue; } r -= I_1;
            transpose_item(a.in[22] + (size_t)l * DFF * D, D, (bf16*)(ws + WS_W2) + (size_t)l * D * DFF, DFF, 0, scr, r / 64, r % 64, lane);
        }
    }
    __syncthreads();
    {
        LAS float* cact = (LAS float*)lds;
        LAS float* red = (LAS float*)(lds + 16384);
        const float* c = a.in[1];
        for (int i = tid; i < 2 * D; i += 512) { const float v = c[i]; cact[i] = v * fsigmoid(v) ; }
        __syncthreads();
        for (int it = bid; it < DEPTH * 48; it += G) {
            const int l = it / 48, cb = it % 48;
            const float* W = a.in[2] + (size_t)l * D * MODW + cb * 256 + 4 * lane;
            f32x4 a0 = {0.f, 0.f, 0.f, 0.f}, a1 = {0.f, 0.f, 0.f, 0.f};
            const int kb = wave * 256;
#pragma unroll 8
            for (int k = 0; k < 256; ++k) { const f32x4 w = *(const f32x4*)(W + (size_t)(kb + k) * MODW); a0 += w * cact[kb + k]; a1 += w * cact[D + kb + k]; }
            *(LAS f32x4*)(red + (wave * 2 + 0) * 256 + 4 * lane) = a0;
            *(LAS f32x4*)(red + (wave * 2 + 1) * 256 + 4 * lane) = a1;
            __syncthreads();
            { const int b = tid >> 8, col = tid & 255; float s = a.in[3][(size_t)l * MODW + cb * 256 + col];
#pragma unroll
              for (int w = 0; w < 8; ++w) s += red[(w * 2 + b) * 256 + col];
              ((float*)(ws + WS_MOD))[((size_t)l * 2 + b) * MODW + cb * 256 + col] = s; }
            __syncthreads();
        }
    }
    {
        f32x2* tab = (f32x2*)(ws + WS_ROPE);
        for (int e = bid * 512 + tid; e < T * 64; e += G * 512) {
            const int pos = e >> 6, i = e & 63;
            double inv = 1.0; const double rr = 0.8659643233600653;
            for (int k = 0; k < i; ++k) inv *= rr;
            const double ang = (double)pos * inv;
            const double n = __builtin_rint(ang * 0.6366197723675814);
            double r = __builtin_fma(-n, 1.5707963267948966, ang); r = __builtin_fma(-n, 6.123233995736766e-17, r);
            const double r2 = r * r;
            const double sn = r * (1.0 + r2 * (-1.0 / 6 + r2 * (1.0 / 120 + r2 * (-1.0 / 5040 + r2 * (1.0 / 362880 + r2 * (-1.0 / 39916800 + r2 * (1.0 / 6227020800.0)))))));
            const double cs = 1.0 + r2 * (-0.5 + r2 * (1.0 / 24 + r2 * (-1.0 / 720 + r2 * (1.0 / 40320 + r2 * (-1.0 / 3628800 + r2 * (1.0 / 479001600 + r2 * (-1.0 / 87178291200.0)))))));
            const int q = (int)((long long)n & 3);
            double co, si;
            if (q == 0) { co = cs; si = sn; } else if (q == 1) { co = -sn; si = cs; } else if (q == 2) { co = -cs; si = -sn; } else { co = sn; si = -cs; }
            tab[e] = (f32x2){(float)co, (float)si};
        }
    }
}

__device__ __forceinline__ void norm_rows(const float* xsrc, float* xdst, const bf16* y, const float* ga  , const float* gpost,
                                          bool do_h, const float* sc, const float* sh, const float* gpre, bf16* hout, int gw, int NGW, int lane) {
    for (int row = gw; row < M; row += NGW) {
        const int b = row >> 12;
        const f32x4* xr = (const f32x4*)(xsrc + (size_t)row * D) + lane;
        f32x4 xv[8];
#pragma unroll
        for (int j = 0; j < 8; ++j) xv[j] = xr[64 * j];
        if (y) {
            const u32x2* yr = (const u32x2*)(y + (size_t)row * D) + lane;
            f32x4 yv[8]; float ss = 0.f;
#pragma unroll
            for (int j = 0; j < 8; ++j) { const u32x2 w = yr[64 * j]; yv[j] = (f32x4){bf_lo(w.x), bf_hi(w.x), bf_lo(w.y), bf_hi(w.y)};
                ss += (yv[j].x * yv[j].x + yv[j].y * yv[j].y) + (yv[j].z * yv[j].z + yv[j].w * yv[j].w); }
            ss = wave_sum(ss);
            const float r = 1.0f / sqrtf(ss * (1.0f / D) + EPS);
            const f32x4* gar = (const f32x4*)(ga + (size_t)b * MODW) + lane; const f32x4* gp = (const f32x4*)gpost + lane;
#pragma unroll
            for (int j = 0; j < 8; ++j) xv[j] += gar[64 * j] * ((yv[j] * r) * gp[64 * j]);
        }
        f32x4* xw = (f32x4*)(xdst + (size_t)row * D) + lane;
#pragma unroll
        for (int j = 0; j < 8; ++j) xw[64 * j] = xv[j];
        if (do_h) {
            float ss = 0.f;
#pragma unroll
            for (int j = 0; j < 8; ++j) ss += (xv[j].x * xv[j].x + xv[j].y * xv[j].y) + (xv[j].z * xv[j].z + xv[j].w * xv[j].w);
            ss = wave_sum(ss);
            const float r = 1.0f / sqrtf(ss * (1.0f / D) + EPS);
            const f32x4* scr = (const f32x4*)(sc + (size_t)b * MODW) + lane; const f32x4* shr = (const f32x4*)(sh + (size_t)b * MODW) + lane; const f32x4* gp = (const f32x4*)gpre + lane;
            u32x2* ho = (u32x2*)(hout + (size_t)row * D) + lane;
#pragma unroll
            for (int j = 0; j < 8; ++j) { const f32x4 hv = ((xv[j] * r) * gp[64 * j]) * (scr[64 * j] + 1.0f) + shr[64 * j];
                u32x2 w; w.x = pk_bf16(hv.x, hv.y); w.y = pk_bf16(hv.z, hv.w); ho[64 * j] = w; }
        }
    }
}

constexpr int CT = 16;
__device__ __forceinline__ void conv_units(const bf16* Z, bf16* YC, const float* scw, const float* cfw, const float* cfg, const float* cfb,
                                           LAS unsigned char* lds, int tid, int lane, int wave, int bid, int G) {
    const unsigned c00 = 2u * (unsigned)tid;
    LAS unsigned char* U = lds;
    LAS float* red = (LAS float*)(lds + (CT + 30) * 2048);
    LAS float* tot = red + 8 * 2 * CT;
    for (int u = bid; u < M / CT; u += G) {
        const int row0 = CT * u, b = row0 >> 12, ts = row0 & 4095;
        unsigned c0 = c00; asm volatile("" : "+v"(c0));
        const bf16* Zb = Z + (size_t)b * T * DIN;
        for (int it0 = tid; it0 < (CT + 30) * 128; it0 += 4 * 512) {
            u32x4 av[4], gv[4]; bool ok[4];
#pragma unroll
            for (int q = 0; q < 4; ++q) { const int it = it0 + 512 * q, row = it >> 7, ch = it & 127, tok = ts - 15 + row;
                ok[q] = (it < (CT + 30) * 128) && tok >= 0 && tok < T; av[q] = (u32x4){0u, 0u, 0u, 0u}; gv[q] = av[q];
                if (ok[q]) { av[q] = *(const u32x4*)(Zb + (size_t)tok * DIN + ZC_CA + 8 * ch); gv[q] = *(const u32x4*)(Zb + (size_t)tok * DIN + ZC_CG + 8 * ch); } }
#pragma unroll
            for (int q = 0; q < 4; ++q) { const int it = it0 + 512 * q, row = it >> 7, ch = it & 127;
                if (it < (CT + 30) * 128) {
                    u32x4 o = {0u, 0u, 0u, 0u};
                    if (ok[q]) {
                        o.x = pk_bf16(bf_lo(av[q].x) * fsigmoid(bf_lo(gv[q].x)), bf_hi(av[q].x) * fsigmoid(bf_hi(gv[q].x)));
                        o.y = pk_bf16(bf_lo(av[q].y) * fsigmoid(bf_lo(gv[q].y)), bf_hi(av[q].y) * fsigmoid(bf_hi(gv[q].y)));
                        o.z = pk_bf16(bf_lo(av[q].z) * fsigmoid(bf_lo(gv[q].z)), bf_hi(av[q].z) * fsigmoid(bf_hi(gv[q].z)));
                        o.w = pk_bf16(bf_lo(av[q].w) * fsigmoid(bf_lo(gv[q].w)), bf_hi(av[q].w) * fsigmoid(bf_hi(gv[q].w)));
                    }
                    *(LAS u32x4*)(U + row * 2048 + ch * 16) = o; } }
        }
        __syncthreads();
        float w[31][2];
#pragma unroll
        for (int k = 0; k < 31; ++k) { const f32x2 t = *(const f32x2*)((cfw + k * 1024) + c0); w[k][0] = t.x; w[k][1] = t.y; }
        float acc[CT][2];
#pragma unroll
        for (int t = 0; t < CT; ++t) { acc[t][0] = 0.f; acc[t][1] = 0.f; }
#pragma unroll
        for (int j = 0; j < CT + 30; ++j) {
            const unsigned uv = *(const LAS unsigned*)(U + (j * 2048u + c0 * 2u));
            const float u0 = bf_lo(uv), u1 = bf_hi(uv);
#pragma unroll
            for (int t = 0; t < CT; ++t) { const int k = j - t; if (k >= 0 && k <= 30) { acc[t][0] += w[k][0] * u0; acc[t][1] += w[k][1] * u1; } }
            if ((j & 7) == 7) asm volatile("" ::: "memory");
        }
        const f32x2 lg = *(const f32x2*)(cfg + c0), lb = *(const f32x2*)(cfb + c0);
        float st[2 * CT];
#pragma unroll
        for (int t = 0; t < CT; ++t) { st[t] = wave_sum(acc[t][0] + acc[t][1]); st[CT + t] = wave_sum(acc[t][0] * acc[t][0] + acc[t][1] * acc[t][1]); }
        if (lane == 0) {
#pragma unroll
            for (int i = 0; i < 2 * CT; ++i) red[wave * 2 * CT + i] = st[i]; }
        __syncthreads();
        if (tid < 2 * CT) { float s = 0.f;
#pragma unroll
            for (int wv = 0; wv < 8; ++wv) s += red[wv * 2 * CT + tid];
            tot[tid] = s; }
        __syncthreads();
#pragma unroll
        for (int t = 0; t < CT; ++t) {
            const float mu = tot[t] * (1.0f / 1024), var = fmaxf(tot[CT + t] * (1.0f / 1024) - mu * mu, 0.f), rs = 1.0f / sqrtf(var + EPS);
            float y0 = (acc[t][0] - mu) * rs * lg.x + lb.x, y1 = (acc[t][1] - mu) * rs * lg.y + lb.y;
            y0 *= fsigmoid(y0); y1 *= fsigmoid(y1);
            *(unsigned*)(YC + (size_t)(row0 + t) * YCW + YC_CF + c0) = pk_bf16(y0, y1);
        }
        LAS float* P = (LAS float*)U;
        for (int it0 = tid; it0 < (CT + 2) * 128; it0 += 5 * 512) {
            u32x4 cv[5], xv[5]; bool ok[5];
#pragma unroll
            for (int q = 0; q < 5; ++q) { const int it = it0 + 512 * q, row = it >> 7, ch = it & 127, tok = ts - 1 + row;
                ok[q] = (it < (CT + 2) * 128) && tok >= 0 && tok < T; cv[q] = (u32x4){0u, 0u, 0u, 0u}; xv[q] = cv[q];
                if (ok[q]) { cv[q] = *(const u32x4*)(Zb + (size_t)tok * DIN + ZC_SC + 8 * ch); xv[q] = *(const u32x4*)(Zb + (size_t)tok * DIN + ZC_SX + 8 * ch); } }
#pragma unroll
            for (int q = 0; q < 5; ++q) { const int it = it0 + 512 * q, row = it >> 7, ch = it & 127;
                if (it < (CT + 2) * 128) {
                    const f32x4 p0 = {bf_lo(cv[q].x) * bf_lo(xv[q].x), bf_hi(cv[q].x) * bf_hi(xv[q].x), bf_lo(cv[q].y) * bf_lo(xv[q].y), bf_hi(cv[q].y) * bf_hi(xv[q].y)};
                    const f32x4 p1 = {bf_lo(cv[q].z) * bf_lo(xv[q].z), bf_hi(cv[q].z) * bf_hi(xv[q].z), bf_lo(cv[q].w) * bf_lo(xv[q].w), bf_hi(cv[q].w) * bf_hi(xv[q].w)};
                    *(LAS f32x4*)(P + row * 1024 + ch * 8) = p0; *(LAS f32x4*)(P + row * 1024 + ch * 8 + 4) = p1; } }
        }
        __syncthreads();
        {
            float w3[3][2];
#pragma unroll
            for (int k = 0; k < 3; ++k) { const f32x2 t = *(const f32x2*)((scw + k * 1024) + c0); w3[k][0] = t.x; w3[k][1] = t.y; }
            f32x2 pa = *(const LAS f32x2*)(P + 0 * 1024 + c0), pb = *(const LAS f32x2*)(P + 1 * 1024 + c0);
            for (int t = 0; t < CT; ++t) {
                const f32x2 pc = *(const LAS f32x2*)(P + (t + 2) * 1024 + c0);
                const unsigned sb2 = *(const unsigned*)(Zb + (size_t)(ts + t) * DIN + ZC_SB + c0);
                const float o0 = w3[0][0] * pa.x + w3[1][0] * pb.x + w3[2][0] * pc.x;
                const float o1 = w3[0][1] * pa.y + w3[1][1] * pb.y + w3[2][1] * pc.y;
                *(unsigned*)(YC + (size_t)(row0 + t) * YCW + YC_SC + c0) = pk_bf16(bf_lo(sb2) * o0, bf_hi(sb2) * o1);
                pa = pb; pb = pc;
            }
        }
        __syncthreads();
    }
}

__device__ __forceinline__ float log2_sigmoid(float x) { return -log1pf(expf(-x)) * 1.4426950408889634f; }
constexpr int RP = 136 * 2;

__device__ __forceinline__ void ret_local_units(const bf16* Z, const f32x2* rope, const float* dec_f, const float* dec_b, float* LST,
                                                LAS unsigned char* lds, int tid, int lane, int wave, int bid, int G) {
    LAS unsigned char* Ktf = lds; LAS unsigned char* Ktb = lds + 128 * RP; LAS unsigned char* Vt = lds + 2 * 128 * RP;
    const int fr = lane & 15, g = lane >> 4;
    for (int u = bid; u < 16 * NCH; u += G) {
        const int chunk = u & 31, bh = u >> 5, b = bh >> 3, h = bh & 7;
        const float lf2 = log2_sigmoid(dec_f[h]), lb2 = log2_sigmoid(dec_b[h]);
        const size_t rowb = (size_t)b * T + chunk * 128;
#pragma unroll
        for (int rep = 0; rep < 2; ++rep) {
            const int it = tid + 512 * rep, j = it & 127, c = it >> 7;
            const bf16* zr = Z + (rowb + j) * DIN + ZC_RK + h * 128 + 8 * c;
            const u32x4 k1 = *(const u32x4*)zr, k2 = *(const u32x4*)(zr + 64);
            const f32x4* cs = (const f32x4*)(rope + (size_t)(chunk * 128 + j) * 64 + 8 * c);
            const f32x4 cs0 = cs[0], cs1 = cs[1], cs2 = cs[2], cs3 = cs[3];
            const float cosv[8] = {cs0.x, cs0.z, cs1.x, cs1.z, cs2.x, cs2.z, cs3.x, cs3.z}, sinv[8] = {cs0.y, cs0.w, cs1.y, cs1.w, cs2.y, cs2.w, cs3.y, cs3.w};
            const unsigned k1w[4] = {k1.x, k1.y, k1.z, k1.w}, k2w[4] = {k2.x, k2.y, k2.z, k2.w};
            const float df = exp2f(lf2 * (float)(127 - j)) * 0.08838834764831845f, db = exp2f(lb2 * (float)j) * 0.08838834764831845f;
#pragma unroll
            for (int e = 0; e < 8; ++e) {
                const float x1 = (e & 1) ? bf_hi(k1w[e >> 1]) : bf_lo(k1w[e >> 1]), x2 = (e & 1) ? bf_hi(k2w[e >> 1]) : bf_lo(k2w[e >> 1]);
                const float o1 = x1 * cosv[e] - x2 * sinv[e], o2 = x1 * sinv[e] + x2 * cosv[e];
                const unsigned pf = pk_bf16(o1 * df, o2 * df), pb = pk_bf16(o1 * db, o2 * db);
                *(LAS bf16*)(Ktf + (8 * c + e) * RP + 2 * j) = (bf16)(pf & 0xffffu); *(LAS bf16*)(Ktf + (64 + 8 * c + e) * RP + 2 * j) = (bf16)(pf >> 16);
                *(LAS bf16*)(Ktb + (8 * c + e) * RP + 2 * j) = (bf16)(pb & 0xffffu); *(LAS bf16*)(Ktb + (64 + 8 * c + e) * RP + 2 * j) = (bf16)(pb >> 16);
            }
        }
#pragma unroll
        for (int rep = 0; rep < 4; ++rep) {
            const int it = tid + 512 * rep, j = it & 127, c = it >> 7;
            const u32x4 v = *(const u32x4*)(Z + (rowb + j) * DIN + ZC_RV + h * 128 + 8 * c);
            const unsigned vw[4] = {v.x, v.y, v.z, v.w};
#pragma unroll
            for (int e = 0; e < 8; ++e) *(LAS bf16*)(Vt + (8 * c + e) * RP + 2 * j) = (bf16)((e & 1) ? (vw[e >> 1] >> 16) : (vw[e >> 1] & 0xffffu));
        }
        __syncthreads();
        f32x4 acc[2][8];
#pragma unroll
        for (int d = 0; d < 2; ++d)
#pragma unroll
            for (int i = 0; i < 8; ++i) acc[d][i] = (f32x4){0.f, 0.f, 0.f, 0.f};
#pragma unroll
        for (int ks = 0; ks < 4; ++ks) {
            const bf16x8 bv = *(const LAS bf16x8*)(Vt + (16 * wave + fr) * RP + (32 * ks + 8 * g) * 2);
#pragma unroll
            for (int i = 0; i < 8; ++i) {
                const bf16x8 af = *(const LAS bf16x8*)(Ktf + (16 * i + fr) * RP + (32 * ks + 8 * g) * 2);
                const bf16x8 ab = *(const LAS bf16x8*)(Ktb + (16 * i + fr) * RP + (32 * ks + 8 * g) * 2);
                acc[0][i] = MFMA16(af, bv, acc[0][i]); acc[1][i] = MFMA16(ab, bv, acc[1][i]);
            }
        }
#pragma unroll
        for (int d = 0; d < 2; ++d) { float* Lb = LST + ((size_t)((d * 16 + bh) * NCH + chunk)) * 16384 + (size_t)(16 * wave + fr) * 128 + 4 * g;
#pragma unroll
            for (int i = 0; i < 8; ++i) *(f32x4*)(Lb + 16 * i) = acc[d][i]; }
        __syncthreads();
    }
}

__device__ __forceinline__ void ret_scan(const float* LST, bf16* SST, const float* dec_f, const float* dec_b, int tid, int bid, int G) {
    for (int e = bid * 512 + tid; e < 2 * 16 * 4096; e += G * 512) {
        const int dir = e >> 16, rem = e & 65535, bh = rem >> 12, q4 = rem & 4095, h = bh & 7;
        const float dec = exp2f(log2_sigmoid(dir ? dec_b[h] : dec_f[h]) * 128.0f);
        const size_t base = (size_t)((dir * 16 + bh) * NCH) * 16384 + 4 * (size_t)q4;
        f32x4 s = {0.f, 0.f, 0.f, 0.f};
        if (dir == 0) {
#pragma unroll 8
            for (int i = 0; i < NCH; ++i) { u32x2 w; w.x = pk_bf16(s.x, s.y); w.y = pk_bf16(s.z, s.w); *(u32x2*)(SST + base + (size_t)i * 16384) = w;
                s = *(const f32x4*)(LST + base + (size_t)i * 16384) + s * dec; }
        } else {
#pragma unroll 8
            for (int i = NCH - 1; i >= 0; --i) { u32x2 w; w.x = pk_bf16(s.x, s.y); w.y = pk_bf16(s.z, s.w); *(u32x2*)(SST + base + (size_t)i * 16384) = w;
                s = *(const f32x4*)(LST + base + (size_t)i * 16384) + s * dec; }
        }
    }
}

__device__ __forceinline__ void ret_out_units(const bf16* Z, const f32x2* rope, const float* dec_f, const float* dec_b, const bf16* SST, bf16* YC,
                                              LAS unsigned char* lds, int tid, int lane, int wave, int bid, int G) {
    LAS unsigned char* Kl = lds; LAS unsigned char* Vt = lds + 128 * RP; LAS unsigned char* Pl = lds + 2 * 128 * RP + wave * 16 * RP;
    const int fr = lane & 15, g = lane >> 4;
    for (int u = bid; u < 16 * NCH; u += G) {
        const int chunk = u & 31, bh = u >> 5, b = bh >> 3, h = bh & 7;
        const float lf2 = log2_sigmoid(dec_f[h]), lb2 = log2_sigmoid(dec_b[h]);
        const size_t rowb = (size_t)b * T + chunk * 128;
#pragma unroll
        for (int rep = 0; rep < 2; ++rep) {
            const int it = tid + 512 * rep, j = it >> 3, c = it & 7;
            const bf16* zr = Z + (rowb + j) * DIN + ZC_RK + h * 128 + 8 * c;
            const u32x4 k1 = *(const u32x4*)zr, k2 = *(const u32x4*)(zr + 64);
            const f32x4* cs = (const f32x4*)(rope + (size_t)(chunk * 128 + j) * 64 + 8 * c);
            const f32x4 cs0 = cs[0], cs1 = cs[1], cs2 = cs[2], cs3 = cs[3];
            const float cosv[8] = {cs0.x, cs0.z, cs1.x, cs1.z, cs2.x, cs2.z, cs3.x, cs3.z}, sinv[8] = {cs0.y, cs0.w, cs1.y, cs1.w, cs2.y, cs2.w, cs3.y, cs3.w};
            const unsigned k1w[4] = {k1.x, k1.y, k1.z, k1.w}, k2w[4] = {k2.x, k2.y, k2.z, k2.w};
            float o1[8], o2[8];
#pragma unroll
            for (int e = 0; e < 8; ++e) {
                const float x1 = (e & 1) ? bf_hi(k1w[e >> 1]) : bf_lo(k1w[e >> 1]), x2 = (e & 1) ? bf_hi(k2w[e >> 1]) : bf_lo(k2w[e >> 1]);
                o1[e] = (x1 * cosv[e] - x2 * sinv[e]) * 0.08838834764831845f; o2[e] = (x1 * sinv[e] + x2 * cosv[e]) * 0.08838834764831845f;
            }
            u32x4 w1, w2; w1.x = pk_bf16(o1[0], o1[1]); w1.y = pk_bf16(o1[2], o1[3]); w1.z = pk_bf16(o1[4], o1[5]); w1.w = pk_bf16(o1[6], o1[7]);
            w2.x = pk_bf16(o2[0], o2[1]); w2.y = pk_bf16(o2[2], o2[3]); w2.z = pk_bf16(o2[4], o2[5]); w2.w = pk_bf16(o2[6], o2[7]);
            *(LAS u32x4*)(Kl + j * RP + 16 * c) = w1; *(LAS u32x4*)(Kl + j * RP + 128 + 16 * c) = w2;
        }
#pragma unroll
        for (int rep = 0; rep < 4; ++rep) {
            const int it = tid + 512 * rep, j = it & 127, c = it >> 7;
            const u32x4 v = *(const u32x4*)(Z + (rowb + j) * DIN + ZC_RV + h * 128 + 8 * c);
            const unsigned vw[4] = {v.x, v.y, v.z, v.w};
#pragma unroll
            for (int e = 0; e < 8; ++e) *(LAS bf16*)(Vt + (8 * c + e) * RP + 2 * j) = (bf16)((e & 1) ? (vw[e >> 1] >> 16) : (vw[e >> 1] & 0xffffu));
        }
        const int q = 16 * wave + fr;
        bf16x8 qf[4];
        {
            const bf16* zr = Z + (rowb + q) * DIN + ZC_RQ + h * 128 + 8 * g;
#pragma unroll
            for (int ks = 0; ks < 2; ++ks) {
                const u32x4 x1v = *(const u32x4*)(zr + 32 * ks), x2v = *(const u32x4*)(zr + 32 * ks + 64);
                const f32x4* cs = (const f32x4*)(rope + (size_t)(chunk * 128 + q) * 64 + 32 * ks + 8 * g);
                const f32x4 cs0 = cs[0], cs1 = cs[1], cs2 = cs[2], cs3 = cs[3];
                const float cosv[8] = {cs0.x, cs0.z, cs1.x, cs1.z, cs2.x, cs2.z, cs3.x, cs3.z}, sinv[8] = {cs0.y, cs0.w, cs1.y, cs1.w, cs2.y, cs2.w, cs3.y, cs3.w};
                const unsigned x1w[4] = {x1v.x, x1v.y, x1v.z, x1v.w}, x2w[4] = {x2v.x, x2v.y, x2v.z, x2v.w};
                float o1[8], o2[8];
#pragma unroll
                for (int e = 0; e < 8; ++e) {
                    const float x1 = (e & 1) ? bf_hi(x1w[e >> 1]) : bf_lo(x1w[e >> 1]), x2 = (e & 1) ? bf_hi(x2w[e >> 1]) : bf_lo(x2w[e >> 1]);
                    o1[e] = x1 * cosv[e] - x2 * sinv[e]; o2[e] = x1 * sinv[e] + x2 * cosv[e];
                }
                u32x4 w1, w2; w1.x = pk_bf16(o1[0], o1[1]); w1.y = pk_bf16(o1[2], o1[3]); w1.z = pk_bf16(o1[4], o1[5]); w1.w = pk_bf16(o1[6], o1[7]);
                w2.x = pk_bf16(o2[0], o2[1]); w2.y = pk_bf16(o2[2], o2[3]); w2.z = pk_bf16(o2[4], o2[5]); w2.w = pk_bf16(o2[6], o2[7]);
                qf[ks] = __builtin_bit_cast(bf16x8, w1); qf[ks + 2] = __builtin_bit_cast(bf16x8, w2);
            }
        }
        __syncthreads();
#pragma unroll
        for (int kt = 0; kt < 8; ++kt) {
            f32x4 s = {0.f, 0.f, 0.f, 0.f};
#pragma unroll
            for (int ks = 0; ks < 4; ++ks) { const bf16x8 a = *(const LAS bf16x8*)(Kl + (16 * kt + fr) * RP + (32 * ks + 8 * g) * 2); s = MFMA16(a, qf[ks], s); }
            float pv[4];
#pragma unroll
            for (int r = 0; r < 4; ++r) { const int m = 16 * kt + 4 * g + r, diff = q - m;
                const float dc = diff >= 0 ? exp2f(lf2 * (float)diff) : exp2f(lb2 * (float)(-diff)); pv[r] = s[r] * dc; }
            u32x2 w; w.x = pk_bf16(pv[0], pv[1]); w.y = pk_bf16(pv[2], pv[3]);
            *(LAS u32x2*)(Pl + fr * RP + (16 * kt + 4 * g) * 2) = w;
        }
        LDS_WAIT();
        f32x4 o[8];
#pragma unroll
        for (int i = 0; i < 8; ++i) o[i] = (f32x4){0.f, 0.f, 0.f, 0.f};
#pragma unroll
        for (int ks = 0; ks < 4; ++ks) {
            const bf16x8 pb = *(const LAS bf16x8*)(Pl + fr * RP + (32 * ks + 8 * g) * 2);
#pragma unroll
            for (int i = 0; i < 8; ++i) { const bf16x8 a = *(const LAS bf16x8*)(Vt + (16 * i + fr) * RP + (32 * ks + 8 * g) * 2); o[i] = MFMA16(a, pb, o[i]); }
        }
#pragma unroll
        for (int d = 0; d < 2; ++d) {
            const float qd = d == 0 ? exp2f(lf2 * (float)(q + 1)) : exp2f(lb2 * (float)(128 - q));
            const bf16* Sb = SST + ((size_t)((d * 16 + bh) * NCH + chunk)) * 16384 + (size_t)fr * 128 + 8 * g;
#pragma unroll
            for (int i = 0; i < 8; ++i) {
                f32x4 c = {0.f, 0.f, 0.f, 0.f};
#pragma unroll
                for (int ks = 0; ks < 4; ++ks) { const bf16x8 a = *(const bf16x8*)(Sb + (size_t)(16 * i) * 128 + 32 * ks); c = MFMA16(a, qf[ks], c); }
                o[i] += c * qd;
            }
        }
        float s1 = 0.f;
#pragma unroll
        for (int i = 0; i < 8; ++i) s1 += (o[i].x + o[i].y) + (o[i].z + o[i].w);
        s1 += __shfl_xor(s1, 16); s1 += __shfl_xor(s1, 32);
        const float mu = s1 * (1.0f / 128);
        float s2 = 0.f;
#pragma unroll
        for (int i = 0; i < 8; ++i) { const f32x4 dd = o[i] - mu; s2 += (dd.x * dd.x + dd.y * dd.y) + (dd.z * dd.z + dd.w * dd.w); }
        s2 += __shfl_xor(s2, 16); s2 += __shfl_xor(s2, 32);
        const float rs = 1.0f / sqrtf(s2 * (1.0f / 128) + EPS);
        const bf16* rgp = Z + (rowb + q) * DIN + ZC_RG + h * 128 + 4 * g;
        bf16* yo = YC + (rowb + q) * YCW + YC_RET + h * 128 + 4 * g;
#pragma unroll
        for (int i = 0; i < 8; ++i) {
            const u32x2 rg = *(const u32x2*)(rgp + 16 * i);
            const float g0 = bf_lo(rg.x), g1 = bf_hi(rg.x), g2 = bf_lo(rg.y), g3 = bf_hi(rg.y);
            u32x2 w; w.x = pk_bf16(g0 * fsigmoid(g0) * ((o[i].x - mu) * rs), g1 * fsigmoid(g1) * ((o[i].y - mu) * rs));
            w.y = pk_bf16(g2 * fsigmoid(g2) * ((o[i].z - mu) * rs), g3 * fsigmoid(g3) * ((o[i].w - mu) * rs));
            *(u32x2*)(yo + 16 * i) = w;
        }
        __syncthreads();
    }
}

constexpr int NP = 72 * 2;
__device__ __forceinline__ void na_units(const bf16* Z, const float* rpb  , bf16* YC, LAS unsigned char* lds, int tid, int lane, int wave, int bid, int G) {
    LAS unsigned char* Kl = lds;
    LAS unsigned char* Vt = lds + 64 * RP;
    LAS unsigned char* Pl = lds + 64 * RP + 128 * NP + wave * 16 * NP;
    LAS float* bias = (LAS float*)(lds + 64 * RP + 128 * NP + 8 * 16 * NP);
    const int fr = lane & 15, g = lane >> 4;
    for (int u = bid; u < 16 * 32; u += G) {
        const int rp = u & 31, bh = u >> 5, b = bh >> 3, h = bh & 7, r0 = 2 * rp;
        for (int i = tid; i < 465; i += 512) bias[i] = rpb[h * 465 + i];
        const int qr = r0 + (wave >> 2), c = 16 * (wave & 3) + fr;
        const size_t rowq = (size_t)b * T + qr * 64 + c;
        bf16x8 qf[4];
#pragma unroll
        for (int ks = 0; ks < 4; ++ks) qf[ks] = *(const bf16x8*)(Z + rowq * DIN + ZC_NQ + h * 128 + 32 * ks + 8 * g);
        const int rs_q = min(max(qr - 4, 0), 56), cs_q = min(max(c - 8, 0), 48);
        const int kr_lo = min(max(r0 - 4, 0), 56), kr_hi = min(max(r0 - 3, 0), 56) + 7;
        float m_run = -INFINITY, l_run = 0.f;
        f32x4 o[8];
#pragma unroll
        for (int i = 0; i < 8; ++i) o[i] = (f32x4){0.f, 0.f, 0.f, 0.f};
        u32x4 kreg[2], vreg[2];
        { const size_t rowk = (size_t)b * T + kr_lo * 64;
#pragma unroll
          for (int rep = 0; rep < 2; ++rep) { const int it = tid + 512 * rep;
              kreg[rep] = *(const u32x4*)(Z + (rowk + (it >> 4)) * DIN + ZC_NK + h * 128 + 8 * (it & 15));
              vreg[rep] = *(const u32x4*)(Z + (rowk + (it & 63)) * DIN + ZC_NV + h * 128 + 8 * (it >> 6)); } }
        for (int kr = kr_lo; kr <= kr_hi; ++kr) {
#pragma unroll
            for (int rep = 0; rep < 2; ++rep) { const int it = tid + 512 * rep, kc = it >> 4, ch = it & 15;
                *(LAS u32x4*)(Kl + kc * RP + 16 * ch) = kreg[rep]; }
#pragma unroll
            for (int rep = 0; rep < 2; ++rep) { const int it = tid + 512 * rep, kc = it & 63, ch = it >> 6;
                const unsigned vw[4] = {vreg[rep].x, vreg[rep].y, vreg[rep].z, vreg[rep].w};
#pragma unroll
                for (int e = 0; e < 8; ++e) *(LAS bf16*)(Vt + (8 * ch + e) * NP + 2 * kc) = (bf16)((e & 1) ? (vw[e >> 1] >> 16) : (vw[e >> 1] & 0xffffu)); }
            __syncthreads();
            if (kr < kr_hi) { const size_t rowk = (size_t)b * T + (kr + 1) * 64;
#pragma unroll
                for (int rep = 0; rep < 2; ++rep) { const int it = tid + 512 * rep;
                    kreg[rep] = *(const u32x4*)(Z + (rowk + (it >> 4)) * DIN + ZC_NK + h * 128 + 8 * (it & 15));
                    vreg[rep] = *(const u32x4*)(Z + (rowk + (it & 63)) * DIN + ZC_NV + h * 128 + 8 * (it >> 6)); } }
            if (kr >= rs_q && kr < rs_q + 8) {
                float s[4][4]; float mx = -INFINITY;
#pragma unroll
                for (int kt = 0; kt < 4; ++kt) {
                    f32x4 a4 = {0.f, 0.f, 0.f, 0.f};
#pragma unroll
                    for (int ks = 0; ks < 4; ++ks) { const bf16x8 a = *(const LAS bf16x8*)(Kl + (16 * kt + fr) * RP + (32 * ks + 8 * g) * 2); a4 = MFMA16(a, qf[ks], a4); }
#pragma unroll
                    for (int r = 0; r < 4; ++r) { const int kc = 16 * kt + 4 * g + r; const bool valid = (kc >= cs_q) && (kc < cs_q + 16);
                        const int bi = valid ? ((kr - qr + 7) * 31 + (kc - c + 15)) : 0;
                        const float sv = valid ? (a4[r] * 0.08838834764831845f + bias[bi]) : -INFINITY; s[kt][r] = sv; mx = fmaxf(mx, sv); }
                }
                mx = fmaxf(mx, __shfl_xor(mx, 16)); mx = fmaxf(mx, __shfl_xor(mx, 32));
                const float m_new = fmaxf(m_run, mx), alpha = __expf(m_run - m_new);
                float ps = 0.f;
#pragma unroll
                for (int kt = 0; kt < 4; ++kt) {
#pragma unroll
                    for (int r = 0; r < 4; ++r) { s[kt][r] = __expf(s[kt][r] - m_new); ps += s[kt][r]; }
                    u32x2 w; w.x = pk_bf16(s[kt][0], s[kt][1]); w.y = pk_bf16(s[kt][2], s[kt][3]);
                    *(LAS u32x2*)(Pl + fr * NP + (16 * kt + 4 * g) * 2) = w;
                }
                ps += __shfl_xor(ps, 16); ps += __shfl_xor(ps, 32);
                l_run = l_run * alpha + ps; m_run = m_new;
#pragma unroll
                for (int i = 0; i < 8; ++i) o[i] *= alpha;
                LDS_WAIT();
#pragma unroll
                for (int ks = 0; ks < 2; ++ks) {
                    const bf16x8 pb = *(const LAS bf16x8*)(Pl + fr * NP + (32 * ks + 8 * g) * 2);
#pragma unroll
                    for (int i = 0; i < 8; ++i) { const bf16x8 a = *(const LAS bf16x8*)(Vt + (16 * i + fr) * NP + (32 * ks + 8 * g) * 2); o[i] = MFMA16(a, pb, o[i]); }
                }
            }
            __syncthreads();
        }
        const float inv = 1.0f / l_run;
        bf16* yo = YC + rowq * YCW + YC_NA + h * 128 + 4 * g;
#pragma unroll
        for (int i = 0; i < 8; ++i) { u32x2 w; w.x = pk_bf16(o[i].x * inv, o[i].y * inv); w.y = pk_bf16(o[i].z * inv, o[i].w * inv); *(u32x2*)(yo + 16 * i) = w; }
    }
}

#define PH_BEGIN() int wave = wave0; asm volatile("" : "+s"(wave)); const int lane = lane_id(); const int tid = wave * 64 + lane; \
    int G = G0, bid = bid0; asm volatile("" : "+s"(G), "+s"(bid)); unsigned char* ws = args.ws; asm volatile("" : "+s"(ws)); \
    LAS unsigned char* lds = lds0; asm volatile("" : "+s"(lds)); (void)lane; (void)wave; (void)G; (void)bid; (void)ws; (void)lds
__global__ void __launch_bounds__(512, 2) fwd(Args args) {
    extern __shared__ __attribute__((aligned(16))) unsigned char lds_raw[];
    LAS unsigned char* lds0 = (LAS unsigned char*)lds_raw;
    const int wave0 = __builtin_amdgcn_readfirstlane(threadIdx.x >> 6);
    const int G0 = gridDim.x, bid0 = blockIdx.x;
    volatile LAS unsigned* MISC = (volatile LAS unsigned*)(lds0 + MISC_OFF);
    for (int u = wave0 * 64 + lane_id(); u < (LDS_BYTES - LDSCTL_OFF) / 4; u += 512) ((LAS unsigned*)(lds0 + LDSCTL_OFF))[u] = 0u;
    __syncthreads();
    const int lo = args.ph_lo, hi = args.ph_hi;
    XcdBarrier bar; bar.bar = (unsigned*)(args.ws + WS_CTL) + CW_BAR; bar.x = 0; bar.st = nullptr; bar.wave = wave0;
    if (hi - lo > 1) bar = xcd_barrier_post((unsigned*)(args.ws + WS_CTL) + CW_BAR, MISC + 8, wave0);
#define IN(k) (lo <= (k) && (k) < hi)
#define SEAM(k) do { if (IN((k) + 1)) { XcdBarrier bb_ = bar; asm volatile("" : "+s"(bb_.bar), "+s"(bb_.x), "+s"(bb_.wave)); xcd_barrier(bb_); } } while (0)

    if (IN(0)) { PH_BEGIN(); for (int rep_ = 0; rep_ < REP_PRO; ++rep_) phase_prologue(args, lds, tid, lane, wave, bid, G); SEAM(0); }
    if (IN(1)) {
        PH_BEGIN(); const float* MOD = (const float*)(ws + WS_MOD);
        norm_rows(args.in[0], args.out, nullptr, nullptr, nullptr, true, MOD + 1 * D, MOD + 0 * D, args.in[4], (bf16*)(ws + WS_H), bid * 8 + wave, G * 8, lane);
        SEAM(1);
    }
#define LAYER_BODY(l) do { \
        const int p0 = 2 + 10 * l; \
        if (IN(p0 + 0)) { \
            PH_BEGIN(); \
            pg8::Gemm g{(const bf16*)(ws + WS_H), (const bf16*)(ws + WS_WIN) + (size_t)l * DIN * D, M, DIN, D}; pg8::StaticOrder S; S.init(M, DIN, G, bid); \
            pg8::EpiBf16<2> E{(bf16*)(ws + WS_Z), DIN, ZC_GATE / 256}; \
            for (int rep_ = 0; rep_ < REP_G1; ++rep_) pg8::gemm_phase<pg8::EpiBf16<2>, pg8::StaticOrder, true, true>(lds, g, S, E, tid); \
            SEAM(p0 + 0); \
        } \
        if (IN(p0 + 1)) { \
            PH_BEGIN(); \
            for (int rep_ = 0; rep_ < REP_M1; ++rep_) { ret_local_units((const bf16*)(ws + WS_Z), (const f32x2*)(ws + WS_ROPE), args.in[9] + l * NH, args.in[10] + l * NH, (float*)(ws + WS_LST), lds, tid, lane, wave, bid, G); \
            conv_units((const bf16*)(ws + WS_Z), (bf16*)(ws + WS_YCAT), args.in[12] + (size_t)l * 3 * 1024, args.in[13] + (size_t)l * 31 * 1024, args.in[14] + (size_t)l * 1024, args.in[15] + (size_t)l * 1024, lds, tid, lane, wave, bid, G); } \
            SEAM(p0 + 1); \
        } \
        if (IN(p0 + 2)) { \
            PH_BEGIN(); \
            for (int rep_ = 0; rep_ < REP_M2; ++rep_) { ret_scan((const float*)(ws + WS_LST), (bf16*)(ws + WS_SST), args.in[9] + l * NH, args.in[10] + l * NH, tid, bid, G); \
            na_units((const bf16*)(ws + WS_Z), args.in[11] + (size_t)l * NH * 465, (bf16*)(ws + WS_YCAT), lds, tid, lane, wave, bid, G); } \
            SEAM(p0 + 2); \
        } \
        if (IN(p0 + 3)) { \
            PH_BEGIN(); \
            for (int rep_ = 0; rep_ < REP_M3; ++rep_) ret_out_units((const bf16*)(ws + WS_Z), (const f32x2*)(ws + WS_ROPE), args.in[9] + l * NH, args.in[10] + l * NH, (const bf16*)(ws + WS_SST), (bf16*)(ws + WS_YCAT), lds, tid, lane, wave, bid, G); \
            SEAM(p0 + 3); \
        } \
        if (IN(p0 + 4)) { \
            PH_BEGIN(); \
            pg8::Gemm g{(const bf16*)(ws + WS_YCAT), (const bf16*)(ws + WS_WCAT) + (size_t)l * D * YCW, M, D, YCW}; pg8::StaticOrder S; S.init(M, D, G, bid); \
            pg8::EpiMerge E{(const bf16*)(ws + WS_Z) + ZC_GATE, DIN, (bf16*)(ws + WS_MERGED), D}; \
            for (int rep_ = 0; rep_ < REP_G2; ++rep_) pg8::gemm_phase<pg8::EpiMerge, pg8::StaticOrder, false, true>(lds, g, S, E, tid); \
            SEAM(p0 + 4); \
        } \
        if (IN(p0 + 5)) { \
            PH_BEGIN(); \
            pg8::Gemm g{(const bf16*)(ws + WS_MERGED), (const bf16*)(ws + WS_WO) + (size_t)l * D * D, M, D, D}; pg8::StaticOrder S; S.init(M, D, G, bid); \
            pg8::EpiBf16<0> E{(bf16*)(ws + WS_Y), D, 0}; \
            for (int rep_ = 0; rep_ < REP_G3; ++rep_) pg8::gemm_phase<pg8::EpiBf16<0>, pg8::StaticOrder, false, true>(lds, g, S, E, tid); \
            SEAM(p0 + 5); \
        } \
        if (IN(p0 + 6)) { \
            PH_BEGIN(); const float* modl = (const float*)(ws + WS_MOD) + (size_t)l * 2 * MODW; \
            norm_rows(args.out, args.out, (const bf16*)(ws + WS_Y), modl + 2 * D, args.in[5] + (size_t)l * D, true, modl + 4 * D, modl + 3 * D, args.in[6] + (size_t)l * D, (bf16*)(ws + WS_H), bid * 8 + wave, G * 8, lane); \
            SEAM(p0 + 6); \
        } \
        if (IN(p0 + 7)) { \
            PH_BEGIN(); \
            pg8::Gemm g{(const bf16*)(ws + WS_H), (const bf16*)(ws + WS_W1) + (size_t)l * DFF * D, M, DFF, D}; pg8::StaticOrder S; S.init(M, DFF, G, bid); \
            pg8::EpiBf16<1> E{(bf16*)(ws + WS_U), DFF, 0}; \
            for (int rep_ = 0; rep_ < REP_G4; ++rep_) pg8::gemm_phase<pg8::EpiBf16<1>, pg8::StaticOrder, true, true>(lds, g, S, E, tid); \
            SEAM(p0 + 7); \
        } \
        if (IN(p0 + 8)) { \
            PH_BEGIN(); \
            pg8::Gemm g{(const bf16*)(ws + WS_U), (const bf16*)(ws + WS_W2) + (size_t)l * D * DFF, M, D, DFF}; pg8::StaticOrder S; S.init(M, D, G, bid); \
            pg8::EpiBf16<0> E{(bf16*)(ws + WS_Y), D, 0}; \
            for (int rep_ = 0; rep_ < REP_G5; ++rep_) pg8::gemm_phase<pg8::EpiBf16<0>, pg8::StaticOrder, false, true>(lds, g, S, E, tid); \
            SEAM(p0 + 8); \
        } \
        if (IN(p0 + 9)) { \
            PH_BEGIN(); const float* modl = (const float*)(ws + WS_MOD) + (size_t)l * 2 * MODW; \
            const bool nh = (l + 1 < DEPTH); const float* modn = (const float*)(ws + WS_MOD) + (size_t)(nh ? l + 1 : l) * 2 * MODW; \
            norm_rows(args.out, args.out, (const bf16*)(ws + WS_Y), modl + 5 * D, args.in[7] + (size_t)l * D, nh, modn + 1 * D, modn + 0 * D, args.in[4] + (size_t)(nh ? l + 1 : l) * D, (bf16*)(ws + WS_H), bid * 8 + wave, G * 8, lane); \
            SEAM(p0 + 9); \
        } \
    } while (0)
    LAYER_BODY(0); LAYER_BODY(1); LAYER_BODY(2); LAYER_BODY(3);
#undef IN
#undef SEAM
}

extern "C" void kernel_launch(void* const* d_in, const int* in_sizes, int n_in, void* d_out, int out_size, void* d_ws, size_t ws_size, hipStream_t stream) {
    static int grid = 0;
    if (grid == 0) {
        if (n_in != 23 || out_size != M * D || ws_size < WS_END) { fprintf(stderr, "kernel_launch: unexpected problem (n_in %d, out %d, ws %zu)\n", n_in, out_size, ws_size); grid = -1; return; }
        int dev = 0, cus = 0, per_cu = 0;
        if (hipGetDevice(&dev) != hipSuccess || hipDeviceGetAttribute(&cus, hipDeviceAttributeMultiprocessorCount, dev) != hipSuccess) { grid = -1; return; }
        if (hipFuncSetAttribute((const void*)fwd, hipFuncAttributeMaxDynamicSharedMemorySize, LDS_BYTES) != hipSuccess) { fprintf(stderr, "kernel_launch: hipFuncSetAttribute failed\n"); grid = -1; return; }
        if (hipOccupancyMaxActiveBlocksPerMultiprocessor(&per_cu, (const void*)fwd, 512, LDS_BYTES) != hipSuccess || per_cu < 1) fprintf(stderr, "kernel_launch: occupancy query says %d\n", per_cu);
        (void)hipGetLastError();
        grid = cus;
    }
    if (grid < 0) return;
    (void)hipMemsetAsync((char*)d_ws + WS_CTL, 0, CTL_ZERO_BYTES, stream);
    Args a{};
    for (int i = 0; i < 23; ++i) a.in[i] = (const float*)d_in[i];
    a.out = (float*)d_out; a.ws = (unsigned char*)d_ws;
#if MK_SINGLE_LAUNCH
    a.ph_lo = 0; a.ph_hi = N_PHASES;
    hipLaunchKernelGGL(fwd, dim3(grid), dim3(512), LDS_BYTES, stream, a);
#else
    for (int p = 0; p < N_PHASES; ++p) { a.ph_lo = p; a.ph_hi = p + 1; hipLaunchKernelGGL(fwd, dim3(grid), dim3(512), LDS_BYTES, stream, a); }
#endif
}
```

```cpp
#include <hip/hip_runtime.h>
#include <cstdio>
#include <cstdint>

#define LAS __attribute__((address_space(3)))
#define GAS __attribute__((address_space(1)))
#define REP_G1 1
#define REP_M1 1
#define REP_M2 1
#define REP_M3 1
#define REP_G2 1
#define REP_G3 1
#define REP_G4 1
#define REP_G5 1
#define REP_PRO 1
#ifndef MK_SINGLE_LAUNCH
#define MK_SINGLE_LAUNCH 1
#endif

typedef unsigned short bf16;
typedef short bf16x8 __attribute__((ext_vector_type(8)));
typedef float f32x4 __attribute__((ext_vector_type(4)));
typedef float f32x2 __attribute__((ext_vector_type(2)));
typedef unsigned u32x4 __attribute__((ext_vector_type(4)));
typedef unsigned u32x2 __attribute__((ext_vector_type(2)));

__device__ __forceinline__ unsigned pk_bf16(float lo, float hi) { unsigned r; asm("v_cvt_pk_bf16_f32 %0, %1, %2" : "=v"(r) : "v"(lo), "v"(hi)); return r; }
__device__ __forceinline__ float bf_lo(unsigned w) { return __uint_as_float(w << 16); }
__device__ __forceinline__ float bf_hi(unsigned w) { return __uint_as_float(w & 0xffff0000u); }
__device__ __forceinline__ float fsigmoid(float x) { return __builtin_amdgcn_rcpf(1.0f + __expf(-x)); }
__device__ __forceinline__ float wave_sum(float v) {
#pragma unroll
    for (int o = 1; o < 64; o <<= 1) v += __shfl_xor(v, o);
    return v;
}
#define MFMA16(a, b, c) __builtin_amdgcn_mfma_f32_16x16x32_bf16((a), (b), (c), 0, 0, 0)
#define LDS_WAIT() asm volatile("s_waitcnt lgkmcnt(0)" ::: "memory")
#define VM_WAIT() asm volatile("s_waitcnt vmcnt(0)" ::: "memory")

namespace pg8 {
#define PG8_LAS __attribute__((address_space(3)))
typedef unsigned short bf16_t;
constexpr int BM = 256, BK = 64, HALF = 128, HTB = HALF * BK * 2, STAGE_BYTES = 8 * HTB, NXCD = 8, WGM = 8;

__host__ __device__ __forceinline__ int lds_byte(int r, int c) { const int st = (r >> 4) * 2 + (c >> 5), rr = r & 15, cc = c & 31, ob = rr * 64 + cc * 2; return st * 1024 + (ob ^ (((ob >> 9) & 1) << 5)); }
__host__ __device__ __forceinline__ void stage_rc(int b, int& R, int& C) { const int st = b / 1024, sb = b % 1024, swz = sb ^ (((sb >> 9) & 1) << 5); R = (st >> 1) * 16 + swz / 64; C = (st & 1) * 32 + (swz % 64) / 2; }
__host__ __device__ __forceinline__ int perm32(int rho) { const int n = rho >> 4, i = rho & 15; return 8 * (i >> 2) + 4 * n + (i & 3); }

struct Unit { int pm, pn; };
struct Gemm { const bf16_t* A; const bf16_t* Bt; int M, N, K; };

struct StaticOrder {
    int nM, nN, nwg, G, c;
    __host__ __device__ void init(int M, int N, int G_, int c_) { nM = M / BM; nN = N / BM; nwg = nM * nN; G = G_; c = c_; }
    __host__ __device__ bool next(int i, Unit& u) const {
        const long L = (long)i * G + c; if (L >= nwg) return false;
        int wgid = (int)L; { const int q = nwg / NXCD, r = nwg % NXCD, xcd = wgid % NXCD, off = wgid / NXCD; wgid = (xcd < r ? xcd * (q + 1) : r * (q + 1) + (xcd - r) * q) + off; }
        const int nig = WGM * nN, gid = wgid / nig, fm = gid * WGM, gsz = (nM - fm) < WGM ? (nM - fm) : WGM;
        u.pm = fm + ((wgid % nig) % gsz); u.pn = (wgid % nig) / gsz; return true;
    }
    __device__ __forceinline__ void a_ready(const Unit&) const {}
    __device__ __forceinline__ void done(const Unit&) const {}
};

struct EpiF32 {
    static constexpr bool PERM = false, AFTER_DRAIN = false, KHOOK = false;
    float* C; int ldc;
    __device__ __forceinline__ void operator()(const f32x4 (&acc)[2][2][4][2], const Unit& u, int wr, int wc, int fr, int fq) const {
        const int row0 = u.pm * BM + wr * 64 + fr, col0 = u.pn * BM + wc * 32 + 4 * fq;
#pragma unroll
        for (int ai = 0; ai < 2; ++ai)
#pragma unroll
            for (int m = 0; m < 4; ++m) { float* rowp = C + (size_t)(row0 + ai * HALF + m * 16) * ldc + col0;
#pragma unroll
                for (int bj = 0; bj < 2; ++bj)
#pragma unroll
                    for (int n = 0; n < 2; ++n) *(f32x4*)(rowp + bj * HALF + n * 16) = acc[ai][bj][m][n]; }
    }
    __device__ __forceinline__ void khook(f32x4 (&)[2][2][4][2], const Unit&, int, int, int, int, int) const {}
};
template <int ACT> struct EpiBf16 {
    static constexpr bool PERM = true, AFTER_DRAIN = false, KHOOK = false;
    bf16_t* O; int ldc; int sig_pn0;
    __device__ __forceinline__ void operator()(const f32x4 (&acc)[2][2][4][2], const Unit& u, int wr, int wc, int fr, int fq) const {
        const int row0 = u.pm * BM + wr * 64 + fr; const int col0 = u.pn * BM + wc * 32 + 8 * fq;
        const bool sig = (ACT == 2) && (u.pn >= sig_pn0);
#pragma unroll
        for (int ai = 0; ai < 2; ++ai)
#pragma unroll
            for (int m = 0; m < 4; ++m) { bf16_t* rowp = O + (size_t)(row0 + ai * HALF + m * 16) * ldc + col0;
#pragma unroll
                for (int bj = 0; bj < 2; ++bj) { f32x4 v0 = acc[ai][bj][m][0], v1 = acc[ai][bj][m][1];
                    if (ACT == 1) {
#pragma unroll
                        for (int j = 0; j < 4; ++j) { const float a = fmaxf(v0[j], 0.f), b = fmaxf(v1[j], 0.f); v0[j] = a * a; v1[j] = b * b; } }
                    if (ACT == 2) { if (sig) {
#pragma unroll
                        for (int j = 0; j < 4; ++j) { v0[j] = fmaxf(fsigmoid(v0[j]), 1e-20f); v1[j] = fmaxf(fsigmoid(v1[j]), 1e-20f); } } }
                    u32x4 w; w.x = pk_bf16(v0[0], v0[1]); w.y = pk_bf16(v0[2], v0[3]); w.z = pk_bf16(v1[0], v1[1]); w.w = pk_bf16(v1[2], v1[3]);
                    *(u32x4*)(rowp + bj * HALF) = w; } }
    }
    __device__ __forceinline__ void khook(f32x4 (&)[2][2][4][2], const Unit&, int, int, int, int, int) const {}
};
struct EpiMerge {
    static constexpr bool PERM = true, AFTER_DRAIN = false, KHOOK = true;
    const bf16_t* G; int ldg;
    bf16_t* O; int ldc;
    __device__ __forceinline__ void scale(f32x4 (&acc)[2][2][4][2], const Unit& u, int plane, int wr, int wc, int fr, int fq) const {
        const int row0 = u.pm * BM + wr * 64 + fr; const int col0 = u.pn * BM + wc * 32 + 8 * fq;
#pragma unroll
        for (int ai = 0; ai < 2; ++ai) {
#pragma unroll
            for (int m = 0; m < 4; ++m) { const bf16_t* gp = G + (size_t)(row0 + ai * HALF + m * 16) * ldg + plane * 2048 + col0;
#pragma unroll
                for (int bj = 0; bj < 2; ++bj) { const u32x4 r = *(const u32x4*)(gp + bj * HALF);
                    acc[ai][bj][m][0] *= (f32x4){bf_lo(r.x), bf_hi(r.x), bf_lo(r.y), bf_hi(r.y)}; acc[ai][bj][m][1] *= (f32x4){bf_lo(r.z), bf_hi(r.z), bf_lo(r.w), bf_hi(r.w)}; } }
            asm volatile("" ::: "memory"); }
    }
    __device__ __forceinline__ void khook(f32x4 (&acc)[2][2][4][2], const Unit& u, int b, int wr, int wc, int fr, int fq) const { scale(acc, u, b - 1, wr, wc, fr, fq); }
    __device__ __forceinline__ void operator()(f32x4 (&acc)[2][2][4][2], const Unit& u, int wr, int wc, int fr, int fq) const {
        scale(acc, u, 3, wr, wc, fr, fq);
        const int row0 = u.pm * BM + wr * 64 + fr; const int col0 = u.pn * BM + wc * 32 + 8 * fq;
#pragma unroll
        for (int ai = 0; ai < 2; ++ai)
#pragma unroll
            for (int m = 0; m < 4; ++m) { const size_t r = (size_t)(row0 + ai * HALF + m * 16);
#pragma unroll
                for (int bj = 0; bj < 2; ++bj) { const f32x4 v0 = acc[ai][bj][m][0], v1 = acc[ai][bj][m][1];
                    u32x4 w; w.x = pk_bf16(v0[0], v0[1]); w.y = pk_bf16(v0[2], v0[3]); w.z = pk_bf16(v1[0], v1[1]); w.w = pk_bf16(v1[2], v1[3]);
                    *(u32x4*)(O + r * ldc + col0 + bj * HALF) = w; } }
    }
};

template <class Epi, class Sched, bool ALIGN_EPI = false, bool SP2 = false>
__device__ __forceinline__ void gemm_phase(PG8_LAS unsigned char* lds, const Gemm g, const Sched& S, const Epi& E, const int tid) {
    const int wid = __builtin_amdgcn_readfirstlane(tid >> 6), lane = tid & 63, wr = wid >> 2, wc = wid & 3, fr = lane & 15, fq = lane >> 4;
    const int K = g.K, nt = K / BK;
    unsigned voffA[2], voffB[2];
#pragma unroll
    for (int i = 0; i < 2; ++i) { int R, C; stage_rc(tid * 16 + i * 8192, R, C); const int Rb = Epi::PERM ? ((R & ~31) + perm32(R & 31)) : R;
        voffA[i] = (unsigned)(R * K + C) * 2u; voffB[i] = (unsigned)(Rb * K + C) * 2u; }
    const size_t kstep = (size_t)(BK * 2);
    const size_t hstep = (size_t)HALF * K * 2;
    const size_t tstep = 2 * hstep;
    const unsigned ldsw = (unsigned)wid * 1024u;
    const int aoff = lds_byte(wr * 64 + fr, fq * 8), boff = lds_byte(wc * 32 + fr, fq * 8);
#define PG8_SA(b, h) (((b) * 2 + (h)) * HTB)
#define PG8_SB(b, h) ((4 + (b) * 2 + (h)) * HTB)
#define PG8_STAGE(bufoff, gbase, voff) do { _Pragma("unroll") for (int _i = 0; _i < 2; ++_i) \
        __builtin_amdgcn_global_load_lds((const unsigned*)((const char*)(gbase) + (voff)[_i]), (PG8_LAS unsigned*)(lds + (bufoff) + ldsw + _i * 8192), 16, 0, 0); } while (0)
#define PG8_LDA(dst, b, h) do { _Pragma("unroll") for (int m = 0; m < 4; ++m) _Pragma("unroll") for (int k = 0; k < 2; ++k) dst[m][k] = *(const PG8_LAS bf16x8*)(lds + PG8_SA(b, h) + aoff + m * 2048 + k * 1024); } while (0)
#define PG8_LDB(dst, b, h) do { _Pragma("unroll") for (int n = 0; n < 2; ++n) _Pragma("unroll") for (int k = 0; k < 2; ++k) dst[n][k] = *(const PG8_LAS bf16x8*)(lds + PG8_SB(b, h) + boff + n * 2048 + k * 1024); } while (0)
#define PG8_MMA(ai, bj, At, Bt) do { __builtin_amdgcn_s_setprio(1); _Pragma("unroll") for (int m = 0; m < 4; ++m) _Pragma("unroll") for (int n = 0; n < 2; ++n) _Pragma("unroll") for (int k = 0; k < 2; ++k) \
        acc[ai][bj][m][n] = __builtin_amdgcn_mfma_f32_16x16x32_bf16(Bt[n][k], At[m][k], acc[ai][bj][m][n], 0, 0, 0); __builtin_amdgcn_s_setprio(0); } while (0)
#define PG8_WAIT_V(n) asm volatile("s_waitcnt vmcnt(" #n ")" ::: "memory")
#define PG8_WAIT_L(n) asm volatile("s_waitcnt lgkmcnt(" #n ")" ::: "memory")
#define PG8_BAR __builtin_amdgcn_s_barrier()
#define PG8_SCHED __builtin_amdgcn_sched_barrier(0)
    Unit cur, nxt; int ui = 0;
    if (!S.next(0, cur)) return;
    f32x4 acc[2][2][4][2];
#pragma unroll
    for (int a = 0; a < 2; ++a)
#pragma unroll
        for (int b = 0; b < 2; ++b)
#pragma unroll
            for (int m = 0; m < 4; ++m)
#pragma unroll
                for (int n = 0; n < 2; ++n) acc[a][b][m][n] = (f32x4){0.f, 0.f, 0.f, 0.f};
    bf16x8 At[4][2], B0[2][2], B1[2][2];
    const char* cA = (const char*)g.A + (size_t)cur.pm * tstep; const char* cB = (const char*)g.Bt + (size_t)cur.pn * tstep;
    S.a_ready(cur);
    if constexpr (SP2) {
        PG8_STAGE(PG8_SB(0, 0), cB, voffB); PG8_STAGE(PG8_SB(0, 1), cB + hstep, voffB); PG8_STAGE(PG8_SA(0, 0), cA, voffA); PG8_STAGE(PG8_SA(0, 1), cA + hstep, voffA);
        if (wr == 1) PG8_BAR;
        PG8_WAIT_V(2); PG8_BAR;
        PG8_STAGE(PG8_SB(1, 0), cB + kstep, voffB); PG8_STAGE(PG8_SA(1, 0), cA + kstep, voffA); PG8_STAGE(PG8_SB(1, 1), cB + hstep + kstep, voffB);
        PG8_WAIT_V(6); PG8_BAR;
    } else {
        PG8_STAGE(PG8_SB(0, 0), cB, voffB); PG8_STAGE(PG8_SA(0, 0), cA, voffA); PG8_STAGE(PG8_SB(0, 1), cB + hstep, voffB); PG8_STAGE(PG8_SA(0, 1), cA + hstep, voffA);
        if (wr == 1) PG8_BAR;
        PG8_WAIT_V(4); PG8_BAR;
        PG8_STAGE(PG8_SB(1, 0), cB + kstep, voffB); PG8_STAGE(PG8_SA(1, 0), cA + kstep, voffA); PG8_STAGE(PG8_SB(1, 1), cB + hstep + kstep, voffB);
        PG8_WAIT_V(6); PG8_BAR;
    }
    for (;;) {
        const bool has_next = S.next(ui + 1, nxt);
        const char* nA = has_next ? (const char*)g.A + (size_t)nxt.pm * tstep : cA; const char* nB = has_next ? (const char*)g.Bt + (size_t)nxt.pn * tstep : cB;
        for (int t = 0; t < nt; t += 2) {
            const bool last = (t == nt - 2);
            const char* a1 = cA + (size_t)(t + 1) * kstep;
            const char* a2 = last ? nA : cA + (size_t)(t + 2) * kstep; const char* b2 = last ? nB : cB + (size_t)(t + 2) * kstep;
            const char* a3 = a2 + kstep; const char* b3 = b2 + kstep;
            if (last && has_next) S.a_ready(nxt);
            if constexpr (Epi::KHOOK) { if (t != 0 && (t & 15) == 0) E.khook(acc, cur, t >> 4, wr, wc, fr, fq); }
            if constexpr (SP2) {
            PG8_LDB(B0, 0, 0); PG8_LDB(B1, 0, 1); PG8_SCHED; PG8_LDA(At, 0, 0); PG8_STAGE(PG8_SA(1, 1), a1 + hstep, voffA);
            PG8_WAIT_V(8); PG8_WAIT_L(0); PG8_BAR; PG8_MMA(0, 0, At, B0); PG8_MMA(0, 1, At, B1); PG8_BAR; PG8_SCHED;
            PG8_LDA(At, 0, 1); PG8_STAGE(PG8_SB(0, 0), b2, voffB); PG8_STAGE(PG8_SB(0, 1), b2 + hstep, voffB); PG8_STAGE(PG8_SA(0, 0), a2, voffA);
            PG8_WAIT_V(8); PG8_WAIT_L(0); PG8_BAR; PG8_MMA(1, 0, At, B0); PG8_MMA(1, 1, At, B1); PG8_BAR; PG8_SCHED;
            PG8_LDB(B0, 1, 0); PG8_LDB(B1, 1, 1); PG8_SCHED; PG8_LDA(At, 1, 0); PG8_STAGE(PG8_SA(0, 1), a2 + hstep, voffA);
            PG8_WAIT_V(8); PG8_WAIT_L(0); PG8_BAR; PG8_MMA(0, 0, At, B0); PG8_MMA(0, 1, At, B1); PG8_BAR; PG8_SCHED;
            PG8_LDA(At, 1, 1); PG8_STAGE(PG8_SB(1, 0), b3, voffB); PG8_STAGE(PG8_SB(1, 1), b3 + hstep, voffB); PG8_STAGE(PG8_SA(1, 0), a3, voffA);
            PG8_WAIT_V(8); PG8_WAIT_L(0); PG8_BAR; PG8_MMA(1, 0, At, B0); PG8_MMA(1, 1, At, B1); PG8_BAR; PG8_SCHED;
            } else {
            PG8_LDB(B0, 0, 0); PG8_SCHED; PG8_LDA(At, 0, 0); PG8_STAGE(PG8_SA(1, 1), a1 + hstep, voffA);
            PG8_WAIT_L(8); PG8_BAR; PG8_WAIT_L(0); PG8_MMA(0, 0, At, B0); PG8_BAR; PG8_SCHED;
            PG8_LDB(B1, 0, 1); PG8_STAGE(PG8_SB(0, 0), b2, voffB);
            PG8_BAR; PG8_WAIT_L(0); PG8_MMA(0, 1, At, B1); PG8_BAR;
            PG8_LDA(At, 0, 1); PG8_STAGE(PG8_SA(0, 0), a2, voffA);
            PG8_BAR; PG8_WAIT_L(0); PG8_MMA(1, 0, At, B0); PG8_BAR; PG8_SCHED;
            PG8_STAGE(PG8_SB(0, 1), b2 + hstep, voffB);
            PG8_WAIT_V(6); PG8_BAR; PG8_MMA(1, 1, At, B1); PG8_BAR;
            PG8_LDB(B0, 1, 0); PG8_SCHED; PG8_LDA(At, 1, 0); PG8_STAGE(PG8_SA(0, 1), a2 + hstep, voffA);
            PG8_WAIT_L(8); PG8_BAR; PG8_WAIT_L(0); PG8_MMA(0, 0, At, B0); PG8_BAR; PG8_SCHED;
            PG8_LDB(B1, 1, 1); PG8_STAGE(PG8_SB(1, 0), b3, voffB);
            PG8_BAR; PG8_WAIT_L(0); PG8_MMA(0, 1, At, B1); PG8_BAR;
            PG8_LDA(At, 1, 1); PG8_STAGE(PG8_SA(1, 0), a3, voffA);
            PG8_BAR; PG8_WAIT_L(0); PG8_MMA(1, 0, At, B0); PG8_BAR; PG8_SCHED;
            PG8_STAGE(PG8_SB(1, 1), b3 + hstep, voffB);
            PG8_WAIT_V(6); PG8_BAR; PG8_MMA(1, 1, At, B1); PG8_BAR;
            }
        }
        if constexpr (ALIGN_EPI) { if (wr == 0) PG8_BAR; }
        if constexpr (!Epi::AFTER_DRAIN) { E(acc, cur, wr, wc, fr, fq); S.done(cur); }
        if (!has_next) break;
#pragma unroll
        for (int a = 0; a < 2; ++a)
#pragma unroll
            for (int b = 0; b < 2; ++b)
#pragma unroll
                for (int m = 0; m < 4; ++m)
#pragma unroll
                    for (int n = 0; n < 2; ++n) acc[a][b][m][n] = (f32x4){0.f, 0.f, 0.f, 0.f};
        cur = nxt; cA = nA; cB = nB; ++ui;
        if constexpr (ALIGN_EPI) { if (wr == 1) PG8_BAR; }
    }
    PG8_WAIT_V(0);
    if constexpr (!ALIGN_EPI) { if (wr == 0) PG8_BAR; }
    PG8_BAR;
#undef PG8_SA
#undef PG8_SB
#undef PG8_STAGE
#undef PG8_LDA
#undef PG8_LDB
#undef PG8_MMA
#undef PG8_WAIT_V
#undef PG8_WAIT_L
#undef PG8_BAR
#undef PG8_SCHED
}
}

#define XB_TMO      128
#define XB_XCNT(j)  (256  + 64 * (j))
#define XB_XSUB(j)  (1280 + 64 * (j))
#define XB_XGEN(j)  (2304 + 64 * (j))
#define XB_TOP      3328
#define XB_TOPGEN   3392
#define XCD_BAR_WORDS 3456
#define XB_SPIN_CAP (1u << 18)

__device__ __forceinline__ unsigned xb_ld(unsigned* p)              { return __hip_atomic_load(p, __ATOMIC_RELAXED, __HIP_MEMORY_SCOPE_AGENT); }
__device__ __forceinline__ unsigned xb_add(unsigned* p, unsigned v) { return __hip_atomic_fetch_add(p, v, __ATOMIC_RELAXED, __HIP_MEMORY_SCOPE_AGENT); }
__device__ __forceinline__ unsigned xb_xcc_id() { return (unsigned)__builtin_amdgcn_s_getreg((3 << 11) | 20) & 0xFu; }
#define XB_SPIN(cond, bar) do { unsigned _sp = 0; while (cond) { __builtin_amdgcn_s_sleep(1); \
    if ((++_sp & 255u) == 0u) { if (xb_ld(&(bar)[XB_TMO])) break; if (_sp > XB_SPIN_CAP) { atomicAdd(&(bar)[XB_TMO], 1u); break; } } } } while (0)

struct XcdBarrier {
    unsigned* bar; unsigned x;
    volatile LAS unsigned* st;
    int wave;
};
__device__ __forceinline__ int lane_id() { int l; asm volatile("v_mbcnt_lo_u32_b32 %0, -1, 0\n\tv_mbcnt_hi_u32_b32 %0, -1, %0" : "=v"(l)); return l; }
__device__ __forceinline__ XcdBarrier xcd_barrier_post(unsigned* bar, volatile LAS unsigned* st, int wave) {
    XcdBarrier b; b.bar = bar; b.x = xb_xcc_id(); b.st = st; b.wave = wave;
    if (wave == 0 && lane_id() == 0) (void)xb_add(&bar[XB_XCNT(b.x)], 1u);
    return b;
}
__device__ __forceinline__ void xcd_barrier_complete(unsigned* bar, unsigned x, unsigned& nloc, unsigned& nx) {
    const unsigned G = gridDim.x * gridDim.y * gridDim.z;
    unsigned sum, cnt, mine, sp = 0u;
    for (;;) {
        sum = 0u; cnt = 0u; mine = 0u;
#pragma unroll
        for (unsigned j = 0; j < 16; ++j) { const unsigned c = xb_ld(&bar[XB_XCNT(j)]); sum += c; cnt += (c > 0u) ? 1u : 0u; mine = (j == x) ? c : mine; }
        if (sum == G) break;
        __builtin_amdgcn_s_sleep(1);
        if ((++sp & 255u) == 0u) { if (xb_ld(&bar[XB_TMO])) break; if (sp > XB_SPIN_CAP) { atomicAdd(&bar[XB_TMO], 1u); break; } }
    }
    nloc = mine > 0u ? mine : 1u; nx = cnt > 0u ? cnt : 1u;
}
__device__ __forceinline__ void xcd_barrier(const XcdBarrier& b) {
    asm volatile("s_waitcnt vmcnt(0)" ::: "memory");
    __syncthreads();
    if (b.wave == 0 && lane_id() == 0) {
        unsigned* bar = b.bar;
        __builtin_amdgcn_s_waitcnt(0);
        unsigned nloc = b.st[0], nx = b.st[1];
        if (nloc == 0u) { xcd_barrier_complete(bar, b.x, nloc, nx); b.st[0] = nloc; b.st[1] = nx; }
        const unsigned old = xb_add(&bar[XB_XSUB(b.x)], 1u);
        const unsigned gen = old / nloc;
        if (old + 1u == (gen + 1u) * nloc) {
            __builtin_amdgcn_fence(__ATOMIC_RELEASE, "agent");
            asm volatile("s_waitcnt vmcnt(0)" ::: "memory");
            const unsigned og = xb_add(&bar[XB_TOP], 1u);
            const unsigned tg = og / nx;
            if (og + 1u == (tg + 1u) * nx) xb_add(&bar[XB_TOPGEN], 1u);
            else XB_SPIN(xb_ld(&bar[XB_TOPGEN]) == tg, bar);
            __builtin_amdgcn_fence(__ATOMIC_ACQUIRE, "agent");
            xb_add(&bar[XB_XGEN(b.x)], 1u);
            asm volatile("s_waitcnt vmcnt(0)" ::: "memory");
        } else {
            XB_SPIN(xb_ld(&bar[XB_XGEN(b.x)]) == gen, bar);
            __builtin_amdgcn_fence(__ATOMIC_ACQUIRE, "agent");
            asm volatile("s_waitcnt vmcnt(0)" ::: "memory");
        }
    }
    __syncthreads();
}

constexpr int BATCH = 2, T = 4096, D = 2048, DEPTH = 4, M = BATCH * T;
constexpr int DIN = 20480, DFF = 8192, NH = 8, NCH = 32;
constexpr float EPS = 1e-6f;
constexpr int ZW = 18432;
constexpr int ZN_RQ = 0, ZN_RK = 1024, ZN_RV = 2048, ZN_RG = 3072, ZN_NQ = 4096, ZN_NK = 5120, ZN_NV = 6144, ZN_SB = 7168, ZN_P = 8192, ZN_U = 9216, ZN_R1 = 10240, ZN_G3 = 16384;
__host__ __device__ __forceinline__ int win_dest(int s) {
    if (s < 2048) { const int t = s & 255, bj = t >> 7, w = t & 127, n = w >> 6, dp = w & 63; return (s & ~255) + 128 * bj + 32 * (dp >> 4) + 8 * ((dp >> 2) & 3) + 4 * n + (dp & 3); }
    if (s < 8192) return s;
    if (s < 12288) { const int base = s < 10240 ? 8192 : 10240; const int n = (s - base) >> 10, didx = (s - base) & 1023, dd = didx & 127; const int pnb = base / 256 + (didx >> 7);
        return 256 * pnb + 128 * (dd >> 6) + 32 * ((dd >> 4) & 3) + 8 * ((dd >> 2) & 3) + 4 * n + (dd & 3); }
    const int b = (s - 12288) >> 11, d = (s - 12288) & 2047, dd = d & 63;
    return 256 * (48 + (d >> 6)) + 128 * (b >> 1) + 32 * (dd >> 4) + 8 * ((dd >> 2) & 3) + 4 * (b & 1) + (dd & 3);
}
constexpr int YC_RET = 0, YC_NA = 1024, YC_SC = 2048, YC_CF = 3072, YCW = 4096;
constexpr int MODW = 6 * D;

constexpr size_t MiB = (size_t)1 << 20;
constexpr size_t WS_CTL = 0, CTL_ZERO_BYTES = 1 * MiB;
constexpr size_t WS_MOD = 1 * MiB;
constexpr size_t WS_ROPE = 2 * MiB;
constexpr size_t WS_WIN = 4 * MiB;
constexpr size_t WS_WCAT = 324 * MiB;
constexpr size_t WS_WO = 388 * MiB;
constexpr size_t WS_W1 = 420 * MiB;
constexpr size_t WS_W2 = 548 * MiB;
constexpr size_t WS_H = 676 * MiB;
constexpr size_t WS_Z = 708 * MiB;
constexpr size_t WS_LST = 1028 * MiB;
constexpr size_t WS_SST = 1092 * MiB;
constexpr size_t WS_YCAT = 1124 * MiB;
constexpr size_t WS_MERGED = 1188 * MiB;
constexpr size_t WS_Y = 1220 * MiB;
constexpr size_t WS_U = 1284 * MiB;
constexpr size_t WS_END = 1412 * MiB;
constexpr int CW_BAR = 4096;

constexpr int RING_BYTES = 131072;
constexpr int LDSCTL_OFF = RING_BYTES, MISC_OFF = LDSCTL_OFF + 320;
constexpr int LDS_BYTES = 147456;

constexpr int N_PHASES = 2 + 10 * DEPTH;

struct EpiZ {
    static constexpr bool PERM = true, AFTER_DRAIN = false, KHOOK = false;
    bf16* O; const f32x2* rope;
    __device__ __forceinline__ void khook(f32x4 (&)[2][2][4][2], const pg8::Unit&, int, int, int, int, int) const {}
    __device__ __forceinline__ void operator()(const f32x4 (&acc)[2][2][4][2], const pg8::Unit& u, int wr, int wc, int fr, int fq) const {
        const int row0 = u.pm * 256 + wr * 64 + fr, pn = u.pn;
        if (pn < 8) {
            const float sc = pn >= 4 ? 0.08838834764831845f : 1.0f;
#pragma unroll
            for (int ai = 0; ai < 2; ++ai)
#pragma unroll
                for (int m = 0; m < 4; ++m) { const int row = row0 + ai * 128 + m * 16;
                    const f32x4* cs = (const f32x4*)(rope + (size_t)(row & 4095) * 64 + 16 * wc + 4 * fq); const f32x4 c0 = cs[0], c1 = cs[1];
                    const float cosv[4] = {c0.x, c0.z, c1.x, c1.z}, sinv[4] = {c0.y, c0.w, c1.y, c1.w};
#pragma unroll
                    for (int bj = 0; bj < 2; ++bj) { const f32x4 x1 = acc[ai][bj][m][0], x2 = acc[ai][bj][m][1]; float o1[4], o2[4];
#pragma unroll
                        for (int j = 0; j < 4; ++j) { o1[j] = (x1[j] * cosv[j] - x2[j] * sinv[j]) * sc; o2[j] = (x1[j] * sinv[j] + x2[j] * cosv[j]) * sc; }
                        bf16* op = O + (size_t)row * ZW + pn * 256 + bj * 128 + 16 * wc + 4 * fq;
                        u32x2 w1, w2; w1.x = pk_bf16(o1[0], o1[1]); w1.y = pk_bf16(o1[2], o1[3]); w2.x = pk_bf16(o2[0], o2[1]); w2.y = pk_bf16(o2[2], o2[3]);
                        *(u32x2*)op = w1; *(u32x2*)(op + 64) = w2; } }
        } else if (pn < 32) {
            const int mode = (pn >= 12 && pn < 16) ? 1 : ((pn >= 16 && pn < 20) ? 2 : 0);
#pragma unroll
            for (int ai = 0; ai < 2; ++ai)
#pragma unroll
                for (int m = 0; m < 4; ++m) { bf16* rowp = O + (size_t)(row0 + ai * 128 + m * 16) * ZW + pn * 256 + wc * 32 + 8 * fq;
#pragma unroll
                    for (int bj = 0; bj < 2; ++bj) { f32x4 v0 = acc[ai][bj][m][0], v1 = acc[ai][bj][m][1];
                        if (mode == 1) {
#pragma unroll
                            for (int j = 0; j < 4; ++j) { v0[j] *= fsigmoid(v0[j]); v1[j] *= fsigmoid(v1[j]); } }
                        if (mode == 2) { v0 = v0 * 0.08838834764831845f; v1 = v1 * 0.08838834764831845f; }
                        u32x4 w; w.x = pk_bf16(v0[0], v0[1]); w.y = pk_bf16(v0[2], v0[3]); w.z = pk_bf16(v1[0], v1[1]); w.w = pk_bf16(v1[2], v1[3]);
                        *(u32x4*)(rowp + bj * 128) = w; } }
        } else if (pn < 48) {
            const bool glu = pn >= 40; const int cb = (glu ? ZN_U + 128 * (pn - 40) : ZN_P + 128 * (pn - 32)) + 16 * wc + 4 * fq;
#pragma unroll
            for (int ai = 0; ai < 2; ++ai)
#pragma unroll
                for (int m = 0; m < 4; ++m) { bf16* rowp = O + (size_t)(row0 + ai * 128 + m * 16) * ZW + cb;
#pragma unroll
                    for (int bj = 0; bj < 2; ++bj) { const f32x4 v0 = acc[ai][bj][m][0], v1 = acc[ai][bj][m][1]; float o[4];
#pragma unroll
                        for (int j = 0; j < 4; ++j) o[j] = v0[j] * (glu ? fsigmoid(v1[j]) : v1[j]);
                        u32x2 w; w.x = pk_bf16(o[0], o[1]); w.y = pk_bf16(o[2], o[3]); *(u32x2*)(rowp + 64 * bj) = w; } }
        } else {
            const int d0 = 64 * (pn - 48) + 16 * wc + 4 * fq;
#pragma unroll
            for (int ai = 0; ai < 2; ++ai)
#pragma unroll
                for (int m = 0; m < 4; ++m) { bf16* rowp = O + (size_t)(row0 + ai * 128 + m * 16) * ZW + ZN_R1 + d0; float r1[4], r2[4], r3[4], g3[4];
#pragma unroll
                    for (int j = 0; j < 4; ++j) { const float a0 = fmaxf(fsigmoid(acc[ai][0][m][0][j]), 1e-20f), a1 = fmaxf(fsigmoid(acc[ai][0][m][1][j]), 1e-20f),
                                                              a2 = fmaxf(fsigmoid(acc[ai][1][m][0][j]), 1e-20f), a3 = fmaxf(fsigmoid(acc[ai][1][m][1][j]), 1e-20f);
                        r1[j] = a0 * __builtin_amdgcn_rcpf(a1); r2[j] = a1 * __builtin_amdgcn_rcpf(a2); r3[j] = a2 * __builtin_amdgcn_rcpf(a3); g3[j] = a3; }
                    u32x2 w; w.x = pk_bf16(r1[0], r1[1]); w.y = pk_bf16(r1[2], r1[3]); *(u32x2*)(rowp) = w;
                    w.x = pk_bf16(r2[0], r2[1]); w.y = pk_bf16(r2[2], r2[3]); *(u32x2*)(rowp + 2048) = w;
                    w.x = pk_bf16(r3[0], r3[1]); w.y = pk_bf16(r3[2], r3[3]); *(u32x2*)(rowp + 4096) = w;
                    w.x = pk_bf16(g3[0], g3[1]); w.y = pk_bf16(g3[2], g3[3]); *(u32x2*)(rowp + 6144) = w; }
        }
    }
};

struct Args { const float* in[23]; float* out; unsigned char* ws; int ph_lo, ph_hi; };

template <bool MAPWIN = false>
__device__ __forceinline__ void transpose_item(const float* W, int N, bf16* WT, int ldk, int koff, LAS float* scr, int kb, int nb, int lane) {
    const int k0 = 64 * kb, n0 = 32 * nb;
#pragma unroll 8
    for (int i = 0; i < 32; ++i) { const int kk = 2 * i + (lane >> 5); scr[kk * 33 + (lane & 31)] = W[(size_t)(k0 + kk) * N + n0 + (lane & 31)]; }
    LDS_WAIT(); asm volatile("" ::: "memory");
    const int c = lane & 7;
#pragma unroll
    for (int j = 0; j < 4; ++j) { const int n = (lane >> 3) + 8 * j; const LAS float* s = scr + (8 * c) * 33 + n;
        u32x4 o; o.x = pk_bf16(s[0 * 33], s[1 * 33]); o.y = pk_bf16(s[2 * 33], s[3 * 33]); o.z = pk_bf16(s[4 * 33], s[5 * 33]); o.w = pk_bf16(s[6 * 33], s[7 * 33]);
        const int nd = MAPWIN ? win_dest(n0 + n) : n0 + n;
        *(u32x4*)(WT + (size_t)nd * ldk + koff + k0 + 8 * c) = o; }
    LDS_WAIT(); asm volatile("" ::: "memory");
}

__device__ __forceinline__ void phase_prologue(const Args& a, LAS unsigned char* lds, int tid, int lane, int wave, int bid, int G) {
    unsigned char* ws = a.ws;
    {
        LAS float* scr = (LAS float*)(lds + wave * 16384);
        const int gw = bid * 8 + wave, NGW = G * 8;
        constexpr int I_IN = 32 * 640, I_BR = 16 * 64, I_O = 32 * 64, I_1 = 32 * 256, I_2 = 128 * 64, I_L = I_IN + 4 * I_BR + I_O + I_1 + I_2;
        for (int it = gw; it < DEPTH * I_L; it += NGW) {
            const int l = it / I_L; int r = it - l * I_L;
            if (r < I_IN) { transpose_item<true>(a.in[8] + (size_t)l * D * DIN, DIN, (bf16*)(ws + WS_WIN) + (size_t)l * DIN * D, D, 0, scr, r / 640, r % 640, lane); continue; } r -= I_IN;
            if (r < 4 * I_BR) { const int br = r / I_BR, rr = r % I_BR;
                transpose_item(a.in[16 + br] + (size_t)l * 1024 * D, D, (bf16*)(ws + WS_WCAT) + (size_t)l * D * YCW, YCW, 1024 * br, scr, rr / 64, rr % 64, lane); continue; } r -= 4 * I_BR;
            if (r < I_O) { transpose_item(a.in[20] + (size_t)l * D * D, D, (bf16*)(ws + WS_WO) + (size_t)l * D * D, D, 0, scr, r / 64, r % 64, lane); continue; } r -= I_O;
            if (r < I_1) { transpose_item(a.in[21] + (size_t)l * D * DFF, DFF, (bf16*)(ws + WS_W1) + (size_t)l * DFF * D, D, 0, scr, r / 256, r % 256, lane); continue; } r -= I_1;
            transpose_item(a.in[22] + (size_t)l * DFF * D, D, (bf16*)(ws + WS_W2) + (size_t)l * D * DFF, DFF, 0, scr, r / 64, r % 64, lane);
        }
    }
    __syncthreads();
    {
        LAS float* cact = (LAS float*)lds;
        LAS float* red = (LAS float*)(lds + 16384);
        const float* c = a.in[1];
        for (int i = tid; i < 2 * D; i += 512) { const float v = c[i]; cact[i] = v * fsigmoid(v) ; }
        __syncthreads();
        for (int it = bid; it < DEPTH * 48; it += G) {
            const int l = it / 48, cb = it % 48;
            const float* W = a.in[2] + (size_t)l * D * MODW + cb * 256 + 4 * lane;
            f32x4 a0 = {0.f, 0.f, 0.f, 0.f}, a1 = {0.f, 0.f, 0.f, 0.f};
            const int kb = wave * 256;
#pragma unroll 8
            for (int k = 0; k < 256; ++k) { const f32x4 w = *(const f32x4*)(W + (size_t)(kb + k) * MODW); a0 += w * cact[kb + k]; a1 += w * cact[D + kb + k]; }
            *(LAS f32x4*)(red + (wave * 2 + 0) * 256 + 4 * lane) = a0;
            *(LAS f32x4*)(red + (wave * 2 + 1) * 256 + 4 * lane) = a1;
            __syncthreads();
            { const int b = tid >> 8, col = tid & 255; float s = a.in[3][(size_t)l * MODW + cb * 256 + col];
#pragma unroll
              for (int w = 0; w < 8; ++w) s += red[(w * 2 + b) * 256 + col];
              ((float*)(ws + WS_MOD))[((size_t)l * 2 + b) * MODW + cb * 256 + col] = s; }
            __syncthreads();
        }
    }
    {
        f32x2* tab = (f32x2*)(ws + WS_ROPE);
        for (int e = bid * 512 + tid; e < T * 64; e += G * 512) {
            const int pos = e >> 6, i = e & 63;
            double inv = 1.0; const double rr = 0.8659643233600653;
            for (int k = 0; k < i; ++k) inv *= rr;
            const double ang = (double)pos * inv;
            const double n = __builtin_rint(ang * 0.6366197723675814);
            double r = __builtin_fma(-n, 1.5707963267948966, ang); r = __builtin_fma(-n, 6.123233995736766e-17, r);
            const double r2 = r * r;
            const double sn = r * (1.0 + r2 * (-1.0 / 6 + r2 * (1.0 / 120 + r2 * (-1.0 / 5040 + r2 * (1.0 / 362880 + r2 * (-1.0 / 39916800 + r2 * (1.0 / 6227020800.0)))))));
            const double cs = 1.0 + r2 * (-0.5 + r2 * (1.0 / 24 + r2 * (-1.0 / 720 + r2 * (1.0 / 40320 + r2 * (-1.0 / 3628800 + r2 * (1.0 / 479001600 + r2 * (-1.0 / 87178291200.0)))))));
            const int q = (int)((long long)n & 3);
            double co, si;
            if (q == 0) { co = cs; si = sn; } else if (q == 1) { co = -sn; si = cs; } else if (q == 2) { co = -cs; si = -sn; } else { co = sn; si = -cs; }
            tab[e] = (f32x2){(float)co, (float)si};
        }
    }
}

__device__ __forceinline__ void norm_rows(const float* xsrc, float* xdst, const bf16* y, const float* ga  , const float* gpost,
                                          bool do_h, const float* sc, const float* sh, const float* gpre, bf16* hout, int gw, int NGW, int lane) {
    for (int row = gw; row < M; row += NGW) {
        const int b = row >> 12;
        const f32x4* xr = (const f32x4*)(xsrc + (size_t)row * D) + lane;
        f32x4 xv[8];
#pragma unroll
        for (int j = 0; j < 8; ++j) xv[j] = xr[64 * j];
        if (y) {
            const u32x2* yr = (const u32x2*)(y + (size_t)row * D) + lane;
            f32x4 yv[8]; float ss = 0.f;
#pragma unroll
            for (int j = 0; j < 8; ++j) { const u32x2 w = yr[64 * j]; yv[j] = (f32x4){bf_lo(w.x), bf_hi(w.x), bf_lo(w.y), bf_hi(w.y)};
                ss += (yv[j].x * yv[j].x + yv[j].y * yv[j].y) + (yv[j].z * yv[j].z + yv[j].w * yv[j].w); }
            ss = wave_sum(ss);
            const float r = 1.0f / sqrtf(ss * (1.0f / D) + EPS);
            const f32x4* gar = (const f32x4*)(ga + (size_t)b * MODW) + lane; const f32x4* gp = (const f32x4*)gpost + lane;
#pragma unroll
            for (int j = 0; j < 8; ++j) xv[j] += gar[64 * j] * ((yv[j] * r) * gp[64 * j]);
        }
        f32x4* xw = (f32x4*)(xdst + (size_t)row * D) + lane;
#pragma unroll
        for (int j = 0; j < 8; ++j) xw[64 * j] = xv[j];
        if (do_h) {
            float ss = 0.f;
#pragma unroll
            for (int j = 0; j < 8; ++j) ss += (xv[j].x * xv[j].x + xv[j].y * xv[j].y) + (xv[j].z * xv[j].z + xv[j].w * xv[j].w);
            ss = wave_sum(ss);
            const float r = 1.0f / sqrtf(ss * (1.0f / D) + EPS);
            const f32x4* scr = (const f32x4*)(sc + (size_t)b * MODW) + lane; const f32x4* shr = (const f32x4*)(sh + (size_t)b * MODW) + lane; const f32x4* gp = (const f32x4*)gpre + lane;
            u32x2* ho = (u32x2*)(hout + (size_t)row * D) + lane;
#pragma unroll
            for (int j = 0; j < 8; ++j) { const f32x4 hv = ((xv[j] * r) * gp[64 * j]) * (scr[64 * j] + 1.0f) + shr[64 * j];
                u32x2 w; w.x = pk_bf16(hv.x, hv.y); w.y = pk_bf16(hv.z, hv.w); ho[64 * j] = w; }
        }
    }
}

constexpr int CT = 16;
__device__ __forceinline__ void conv_units(const bf16* Z, bf16* YC, const float* scw, const float* cfw, const float* cfg, const float* cfb,
                                           LAS unsigned char* lds, int tid, int lane, int wave, int bid, int G) {
    const unsigned c00 = 2u * (unsigned)tid;
    LAS unsigned char* U = lds;
    LAS float* red = (LAS float*)(lds + (CT + 30) * 2048);
    LAS float* tot = red + 8 * 2 * CT;
    for (int u = bid; u < M / CT; u += G) {
        const int row0 = CT * u, b = row0 >> 12, ts = row0 & 4095;
        unsigned c0 = c00; asm volatile("" : "+v"(c0));
        const bf16* Zb = Z + (size_t)b * T * ZW;
        for (int it0 = tid; it0 < (CT + 30) * 128; it0 += 4 * 512) {
            u32x4 uv[4];
#pragma unroll
            for (int q = 0; q < 4; ++q) { const int it = it0 + 512 * q, row = it >> 7, ch = it & 127, tok = ts - 15 + row;
                uv[q] = (u32x4){0u, 0u, 0u, 0u};
                if ((it < (CT + 30) * 128) && tok >= 0 && tok < T) uv[q] = *(const u32x4*)(Zb + (size_t)tok * ZW + ZN_U + 8 * ch); }
#pragma unroll
            for (int q = 0; q < 4; ++q) { const int it = it0 + 512 * q, row = it >> 7, ch = it & 127;
                if (it < (CT + 30) * 128) *(LAS u32x4*)(U + row * 2048 + ch * 16) = uv[q]; }
        }
        __syncthreads();
        float w[31][2];
#pragma unroll
        for (int k = 0; k < 31; ++k) { const f32x2 t = *(const f32x2*)((cfw + k * 1024) + c0); w[k][0] = t.x; w[k][1] = t.y; }
        float acc[CT][2];
#pragma unroll
        for (int t = 0; t < CT; ++t) { acc[t][0] = 0.f; acc[t][1] = 0.f; }
#pragma unroll
        for (int j = 0; j < CT + 30; ++j) {
            const unsigned uv = *(const LAS unsigned*)(U + (j * 2048u + c0 * 2u));
            const float u0 = bf_lo(uv), u1 = bf_hi(uv);
#pragma unroll
            for (int t = 0; t < CT; ++t) { const int k = j - t; if (k >= 0 && k <= 30) { acc[t][0] += w[k][0] * u0; acc[t][1] += w[k][1] * u1; } }
            if ((j & 7) == 7) asm volatile("" ::: "memory");
        }
        const f32x2 lg = *(const f32x2*)(cfg + c0), lb = *(const f32x2*)(cfb + c0);
        float st[2 * CT];
#pragma unroll
        for (int t = 0; t < CT; ++t) { st[t] = wave_sum(acc[t][0] + acc[t][1]); st[CT + t] = wave_sum(acc[t][0] * acc[t][0] + acc[t][1] * acc[t][1]); }
        if (lane == 0) {
#pragma unroll
            for (int i = 0; i < 2 * CT; ++i) red[wave * 2 * CT + i] = st[i]; }
        __syncthreads();
        if (tid < 2 * CT) { float s = 0.f;
#pragma unroll
            for (int wv = 0; wv < 8; ++wv) s += red[wv * 2 * CT + tid];
            tot[tid] = s; }
        __syncthreads();
#pragma unroll
        for (int t = 0; t < CT; ++t) {
            const float mu = tot[t] * (1.0f / 1024), var = fmaxf(tot[CT + t] * (1.0f / 1024) - mu * mu, 0.f), rs = 1.0f / sqrtf(var + EPS);
            float y0 = (acc[t][0] - mu) * rs * lg.x + lb.x, y1 = (acc[t][1] - mu) * rs * lg.y + lb.y;
            y0 *= fsigmoid(y0); y1 *= fsigmoid(y1);
            *(unsigned*)(YC + (size_t)(row0 + t) * YCW + YC_CF + c0) = pk_bf16(y0, y1);
        }
        LAS float* P = (LAS float*)U;
        for (int it0 = tid; it0 < (CT + 2) * 128; it0 += 5 * 512) {
            u32x4 pv[5];
#pragma unroll
            for (int q = 0; q < 5; ++q) { const int it = it0 + 512 * q, row = it >> 7, ch = it & 127, tok = ts - 1 + row;
                pv[q] = (u32x4){0u, 0u, 0u, 0u};
                if ((it < (CT + 2) * 128) && tok >= 0 && tok < T) pv[q] = *(const u32x4*)(Zb + (size_t)tok * ZW + ZN_P + 8 * ch); }
#pragma unroll
            for (int q = 0; q < 5; ++q) { const int it = it0 + 512 * q, row = it >> 7, ch = it & 127;
                if (it < (CT + 2) * 128) {
                    *(LAS f32x4*)(P + row * 1024 + ch * 8) = (f32x4){bf_lo(pv[q].x), bf_hi(pv[q].x), bf_lo(pv[q].y), bf_hi(pv[q].y)};
                    *(LAS f32x4*)(P + row * 1024 + ch * 8 + 4) = (f32x4){bf_lo(pv[q].z), bf_hi(pv[q].z), bf_lo(pv[q].w), bf_hi(pv[q].w)}; } }
        }
        __syncthreads();
        {
            float w3[3][2];
#pragma unroll
            for (int k = 0; k < 3; ++k) { const f32x2 t = *(const f32x2*)((scw + k * 1024) + c0); w3[k][0] = t.x; w3[k][1] = t.y; }
            f32x2 pa = *(const LAS f32x2*)(P + 0 * 1024 + c0), pb = *(const LAS f32x2*)(P + 1 * 1024 + c0);
            for (int t = 0; t < CT; ++t) {
                const f32x2 pc = *(const LAS f32x2*)(P + (t + 2) * 1024 + c0);
                const unsigned sb2 = *(const unsigned*)(Zb + (size_t)(ts + t) * ZW + ZN_SB + c0);
                const float o0 = w3[0][0] * pa.x + w3[1][0] * pb.x + w3[2][0] * pc.x;
                const float o1 = w3[0][1] * pa.y + w3[1][1] * pb.y + w3[2][1] * pc.y;
                *(unsigned*)(YC + (size_t)(row0 + t) * YCW + YC_SC + c0) = pk_bf16(bf_lo(sb2) * o0, bf_hi(sb2) * o1);
                pa = pb; pb = pc;
            }
        }
        __syncthreads();
    }
}

__device__ __forceinline__ float log2_sigmoid(float x) { return -log1pf(expf(-x)) * 1.4426950408889634f; }
constexpr int RP = 136 * 2;

__device__ __forceinline__ void ret_local_units(const bf16* Z, const f32x2* rope, const float* dec_f, const float* dec_b, float* LST,
                                                LAS unsigned char* lds, int tid, int lane, int wave, int bid, int G) {
    LAS unsigned char* Ktf = lds; LAS unsigned char* Ktb = lds + 128 * RP; LAS unsigned char* Vt = lds + 2 * 128 * RP;
    const int fr = lane & 15, g = lane >> 4;
    for (int u = bid; u < 16 * NCH; u += G) {
        const int chunk = u & 31, bh = u >> 5, b = bh >> 3, h = bh & 7;
        const float lf2 = log2_sigmoid(dec_f[h]), lb2 = log2_sigmoid(dec_b[h]);
        const size_t rowb = (size_t)b * T + chunk * 128;
#pragma unroll
        for (int rep = 0; rep < 4; ++rep) {
            const int it = tid + 512 * rep, j = it & 127, c = it >> 7;
            const u32x4 kv = *(const u32x4*)(Z + (rowb + j) * ZW + ZN_RK + h * 128 + 8 * c);
            const unsigned kw[4] = {kv.x, kv.y, kv.z, kv.w};
            const float df = exp2f(lf2 * (float)(127 - j)), db = exp2f(lb2 * (float)j);
#pragma unroll
            for (int e = 0; e < 8; ++e) {
                const float x = (e & 1) ? bf_hi(kw[e >> 1]) : bf_lo(kw[e >> 1]);
                const unsigned pf = pk_bf16(x * df, x * db);
                *(LAS bf16*)(Ktf + (8 * c + e) * RP + 2 * j) = (bf16)(pf & 0xffffu); *(LAS bf16*)(Ktb + (8 * c + e) * RP + 2 * j) = (bf16)(pf >> 16);
            }
        }
#pragma unroll
        for (int rep = 0; rep < 4; ++rep) {
            const int it = tid + 512 * rep, j = it & 127, c = it >> 7;
            const u32x4 v = *(const u32x4*)(Z + (rowb + j) * ZW + ZN_RV + h * 128 + 8 * c);
            const unsigned vw[4] = {v.x, v.y, v.z, v.w};
#pragma unroll
            for (int e = 0; e < 8; ++e) *(LAS bf16*)(Vt + (8 * c + e) * RP + 2 * j) = (bf16)((e & 1) ? (vw[e >> 1] >> 16) : (vw[e >> 1] & 0xffffu));
        }
        __syncthreads();
        f32x4 acc[2][8];
#pragma unroll
        for (int d = 0; d < 2; ++d)
#pragma unroll
            for (int i = 0; i < 8; ++i) acc[d][i] = (f32x4){0.f, 0.f, 0.f, 0.f};
#pragma unroll
        for (int ks = 0; ks < 4; ++ks) {
            const bf16x8 bv = *(const LAS bf16x8*)(Vt + (16 * wave + fr) * RP + (32 * ks + 8 * g) * 2);
#pragma unroll
            for (int i = 0; i < 8; ++i) {
                const bf16x8 af = *(const LAS bf16x8*)(Ktf + (16 * i + fr) * RP + (32 * ks + 8 * g) * 2);
                const bf16x8 ab = *(const LAS bf16x8*)(Ktb + (16 * i + fr) * RP + (32 * ks + 8 * g) * 2);
                acc[0][i] = MFMA16(af, bv, acc[0][i]); acc[1][i] = MFMA16(ab, bv, acc[1][i]);
            }
        }
#pragma unroll
        for (int d = 0; d < 2; ++d) { float* Lb = LST + ((size_t)((d * 16 + bh) * NCH + chunk)) * 16384 + (size_t)(16 * wave + fr) * 128 + 4 * g;
#pragma unroll
            for (int i = 0; i < 8; ++i) *(f32x4*)(Lb + 16 * i) = acc[d][i]; }
        __syncthreads();
    }
}

__device__ __forceinline__ void ret_scan(const float* LST, bf16* SST, const float* dec_f, const float* dec_b, int tid, int bid, int G) {
    for (int e = bid * 512 + tid; e < 2 * 16 * 4096; e += G * 512) {
        const int dir = e >> 16, rem = e & 65535, bh = rem >> 12, q4 = rem & 4095, h = bh & 7;
        const float dec = exp2f(log2_sigmoid(dir ? dec_b[h] : dec_f[h]) * 128.0f);
        const size_t base = (size_t)((dir * 16 + bh) * NCH) * 16384 + 4 * (size_t)q4;
        f32x4 s = {0.f, 0.f, 0.f, 0.f};
        if (dir == 0) {
#pragma unroll 8
            for (int i = 0; i < NCH; ++i) { u32x2 w; w.x = pk_bf16(s.x, s.y); w.y = pk_bf16(s.z, s.w); *(u32x2*)(SST + base + (size_t)i * 16384) = w;
                s = *(const f32x4*)(LST + base + (size_t)i * 16384) + s * dec; }
        } else {
#pragma unroll 8
            for (int i = NCH - 1; i >= 0; --i) { u32x2 w; w.x = pk_bf16(s.x, s.y); w.y = pk_bf16(s.z, s.w); *(u32x2*)(SST + base + (size_t)i * 16384) = w;
                s = *(const f32x4*)(LST + base + (size_t)i * 16384) + s * dec; }
        }
    }
}

__device__ __forceinline__ void ret_out_units(const bf16* Z, const f32x2* rope, const float* dec_f, const float* dec_b, const bf16* SST, bf16* YC,
                                              LAS unsigned char* lds, int tid, int lane, int wave, int bid, int G) {
    LAS unsigned char* Kl = lds; LAS unsigned char* Vt = lds + 128 * RP; LAS unsigned char* Pl = lds + 2 * 128 * RP + wave * 16 * RP;
    const int fr = lane & 15, g = lane >> 4;
    for (int u = bid; u < 16 * NCH; u += G) {
        const int chunk = u & 31, bh = u >> 5, b = bh >> 3, h = bh & 7;
        const float lf2 = log2_sigmoid(dec_f[h]), lb2 = log2_sigmoid(dec_b[h]);
        const size_t rowb = (size_t)b * T + chunk * 128;
#pragma unroll
        for (int rep = 0; rep < 4; ++rep) {
            const int it = tid + 512 * rep, j = it >> 4, c = it & 15;
            *(LAS u32x4*)(Kl + j * RP + 16 * c) = *(const u32x4*)(Z + (rowb + j) * ZW + ZN_RK + h * 128 + 8 * c);
        }
#pragma unroll
        for (int rep = 0; rep < 4; ++rep) {
            const int it = tid + 512 * rep, j = it & 127, c = it >> 7;
            const u32x4 v = *(const u32x4*)(Z + (rowb + j) * ZW + ZN_RV + h * 128 + 8 * c);
            const unsigned vw[4] = {v.x, v.y, v.z, v.w};
#pragma unroll
            for (int e = 0; e < 8; ++e) *(LAS bf16*)(Vt + (8 * c + e) * RP + 2 * j) = (bf16)((e & 1) ? (vw[e >> 1] >> 16) : (vw[e >> 1] & 0xffffu));
        }
        const int q = 16 * wave + fr;
        bf16x8 qf[4];
#pragma unroll
        for (int ks = 0; ks < 4; ++ks) qf[ks] = *(const bf16x8*)(Z + (rowb + q) * ZW + ZN_RQ + h * 128 + 32 * ks + 8 * g);
        __syncthreads();
#pragma unroll
        for (int kt = 0; kt < 8; ++kt) {
            f32x4 s = {0.f, 0.f, 0.f, 0.f};
#pragma unroll
            for (int ks = 0; ks < 4; ++ks) { const bf16x8 a = *(const LAS bf16x8*)(Kl + (16 * kt + fr) * RP + (32 * ks + 8 * g) * 2); s = MFMA16(a, qf[ks], s); }
            float pv[4];
#pragma unroll
            for (int r = 0; r < 4; ++r) { const int m = 16 * kt + 4 * g + r, diff = q - m;
                const float dc = diff >= 0 ? exp2f(lf2 * (float)diff) : exp2f(lb2 * (float)(-diff)); pv[r] = s[r] * dc; }
            u32x2 w; w.x = pk_bf16(pv[0], pv[1]); w.y = pk_bf16(pv[2], pv[3]);
            *(LAS u32x2*)(Pl + fr * RP + (16 * kt + 4 * g) * 2) = w;
        }
        LDS_WAIT();
        f32x4 o[8];
#pragma unroll
        for (int i = 0; i < 8; ++i) o[i] = (f32x4){0.f, 0.f, 0.f, 0.f};
#pragma unroll
        for (int ks = 0; ks < 4; ++ks) {
            const bf16x8 pb = *(const LAS bf16x8*)(Pl + fr * RP + (32 * ks + 8 * g) * 2);
#pragma unroll
            for (int i = 0; i < 8; ++i) { const bf16x8 a = *(const LAS bf16x8*)(Vt + (16 * i + fr) * RP + (32 * ks + 8 * g) * 2); o[i] = MFMA16(a, pb, o[i]); }
        }
#pragma unroll
        for (int d = 0; d < 2; ++d) {
            const float qd = d == 0 ? exp2f(lf2 * (float)(q + 1)) : exp2f(lb2 * (float)(128 - q));
            const bf16* Sb = SST + ((size_t)((d * 16 + bh) * NCH + chunk)) * 16384 + (size_t)fr * 128 + 8 * g;
#pragma unroll
            for (int i = 0; i < 8; ++i) {
                f32x4 c = {0.f, 0.f, 0.f, 0.f};
#pragma unroll
                for (int ks = 0; ks < 4; ++ks) { const bf16x8 a = *(const bf16x8*)(Sb + (size_t)(16 * i) * 128 + 32 * ks); c = MFMA16(a, qf[ks], c); }
                o[i] += c * qd;
            }
        }
        float s1 = 0.f;
#pragma unroll
        for (int i = 0; i < 8; ++i) s1 += (o[i].x + o[i].y) + (o[i].z + o[i].w);
        s1 += __shfl_xor(s1, 16); s1 += __shfl_xor(s1, 32);
        const float mu = s1 * (1.0f / 128);
        float s2 = 0.f;
#pragma unroll
        for (int i = 0; i < 8; ++i) { const f32x4 dd = o[i] - mu; s2 += (dd.x * dd.x + dd.y * dd.y) + (dd.z * dd.z + dd.w * dd.w); }
        s2 += __shfl_xor(s2, 16); s2 += __shfl_xor(s2, 32);
        const float rs = 1.0f / sqrtf(s2 * (1.0f / 128) + EPS);
        const bf16* rgp = Z + (rowb + q) * ZW + ZN_RG + h * 128 + 4 * g;
        bf16* yo = YC + (rowb + q) * YCW + YC_RET + h * 128 + 4 * g;
#pragma unroll
        for (int i = 0; i < 8; ++i) {
            const u32x2 rg = *(const u32x2*)(rgp + 16 * i);
            const float g0 = bf_lo(rg.x), g1 = bf_hi(rg.x), g2 = bf_lo(rg.y), g3 = bf_hi(rg.y);
            u32x2 w; w.x = pk_bf16(g0 * ((o[i].x - mu) * rs), g1 * ((o[i].y - mu) * rs));
            w.y = pk_bf16(g2 * ((o[i].z - mu) * rs), g3 * ((o[i].w - mu) * rs));
            *(u32x2*)(yo + 16 * i) = w;
        }
        __syncthreads();
    }
}

typedef short v4i16 __attribute__((ext_vector_type(4)));
__device__ __forceinline__ int swz_b(int row) { return ((row & 3) << 2) | ((row >> 2) & 3); }
__device__ __forceinline__ int off_b(int row, int ch) { return 256 * row + 16 * (ch ^ swz_b(row)); }
__device__ __forceinline__ void dma_tile_b(const bf16* g, size_t gpitch, LAS unsigned char* dst, int rows, int wave, int lane) {
    for (int i = wave; i < rows / 4; i += 8) { const int s = 64 * i + lane, row = s >> 4, ch = (s & 15) ^ swz_b(row);
        __builtin_amdgcn_global_load_lds((const unsigned*)(g + (size_t)row * gpitch + 8 * ch), (LAS unsigned*)(dst + 1024 * i), 16, 0, 0); }
}
__device__ __forceinline__ bf16x8 frag_row_b(const LAS unsigned char* tile, int row, int ks, int g) { return *(const LAS bf16x8*)(tile + off_b(row, 4 * ks + g)); }
__device__ __forceinline__ bf16x8 frag_tr_b(const LAS unsigned char* tile, int lane, int c, int ks) {
    const int g = lane >> 4, q = (lane & 15) >> 2, p = lane & 3, r0 = 32 * ks + 8 * g + q;
    const v4i16 lo = __builtin_amdgcn_ds_read_tr16_b64_v4i16((LAS v4i16*)(tile + off_b(r0, 2 * c + (p >> 1)) + 8 * (p & 1)));
    const v4i16 hi = __builtin_amdgcn_ds_read_tr16_b64_v4i16((LAS v4i16*)(tile + off_b(r0 + 4, 2 * c + (p >> 1)) + 8 * (p & 1)));
    return (bf16x8){lo[0], lo[1], lo[2], lo[3], hi[0], hi[1], hi[2], hi[3]};
}
#define DMA_WAIT_ALL() asm volatile("s_waitcnt vmcnt(0)" ::: "memory")

__device__ __forceinline__ void ret_local_units2(const bf16* Z, const float* dec_f, const float* dec_b, float* LST, LAS unsigned char* lds, int tid, int lane, int wave, int bid, int G) {
    const int fr = lane & 15, g = lane >> 4;
    for (int u0 = bid; u0 < 16 * NCH; u0 += 2 * G) {
#pragma unroll
        for (int s = 0; s < 2; ++s) { const int u = u0 + s * G; if (u < 16 * NCH) {
            const int chunk = u & 31, bh = u >> 5, b = bh >> 3, h = bh & 7; const size_t rowb = (size_t)b * T + chunk * 128;
            dma_tile_b(Z + rowb * ZW + ZN_RK + h * 128, ZW, lds + s * 65536, 128, wave, lane);
            dma_tile_b(Z + rowb * ZW + ZN_RV + h * 128, ZW, lds + s * 65536 + 32768, 128, wave, lane); } }
        DMA_WAIT_ALL(); __syncthreads();
#pragma unroll 1
        for (int s = 0; s < 2; ++s) { const int u = u0 + s * G; if (u < 16 * NCH) {
            const int chunk = u & 31, bh = u >> 5, h = bh & 7;
            const float lf2 = log2_sigmoid(dec_f[h]), lb2 = log2_sigmoid(dec_b[h]);
            const LAS unsigned char* Kt = lds + s * 65536; const LAS unsigned char* Vt = Kt + 32768;
            f32x4 acc[2][8];
#pragma unroll
            for (int d = 0; d < 2; ++d)
#pragma unroll
                for (int i = 0; i < 8; ++i) acc[d][i] = (f32x4){0.f, 0.f, 0.f, 0.f};
#pragma unroll
            for (int ks = 0; ks < 4; ++ks) {
                const bf16x8 bv = frag_tr_b(Vt, lane, wave, ks);
                u32x4 wf, wb; const u32x4 bw = __builtin_bit_cast(u32x4, bv);
                { const int t0 = 32 * ks + 8 * g; float df[8], db[8];
#pragma unroll
                  for (int e = 0; e < 8; ++e) { df[e] = exp2f(lf2 * (float)(127 - (t0 + e))); db[e] = exp2f(lb2 * (float)(t0 + e)); }
                  wf.x = pk_bf16(bf_lo(bw.x) * df[0], bf_hi(bw.x) * df[1]); wf.y = pk_bf16(bf_lo(bw.y) * df[2], bf_hi(bw.y) * df[3]);
                  wf.z = pk_bf16(bf_lo(bw.z) * df[4], bf_hi(bw.z) * df[5]); wf.w = pk_bf16(bf_lo(bw.w) * df[6], bf_hi(bw.w) * df[7]);
                  wb.x = pk_bf16(bf_lo(bw.x) * db[0], bf_hi(bw.x) * db[1]); wb.y = pk_bf16(bf_lo(bw.y) * db[2], bf_hi(bw.y) * db[3]);
                  wb.z = pk_bf16(bf_lo(bw.z) * db[4], bf_hi(bw.z) * db[5]); wb.w = pk_bf16(bf_lo(bw.w) * db[6], bf_hi(bw.w) * db[7]); }
                const bf16x8 bvf = __builtin_bit_cast(bf16x8, wf), bvb = __builtin_bit_cast(bf16x8, wb);
#pragma unroll
                for (int i = 0; i < 8; ++i) { const bf16x8 a = frag_tr_b(Kt, lane, i, ks);
                    acc[0][i] = MFMA16(a, bvf, acc[0][i]); acc[1][i] = MFMA16(a, bvb, acc[1][i]); }
            }
#pragma unroll
            for (int d = 0; d < 2; ++d) { float* Lb = LST + ((size_t)((d * 16 + bh) * NCH + chunk)) * 16384 + (size_t)(16 * wave + fr) * 128 + 4 * g;
#pragma unroll
                for (int i = 0; i < 8; ++i) *(f32x4*)(Lb + 16 * i) = acc[d][i]; }
        } }
        __syncthreads();
    }
}

__device__ __forceinline__ void ret_out_units2(const bf16* Z, const float* dec_f, const float* dec_b, const bf16* SST, bf16* YC, LAS unsigned char* lds, int tid, int lane, int wave, int bid, int G) {
    const LAS unsigned char* Kt = lds; const LAS unsigned char* Vt = lds + 32768; const LAS unsigned char* Sft = lds + 65536; const LAS unsigned char* Sbt = lds + 98304;
    LAS unsigned char* Pt = lds;
    const int fr = lane & 15, g = lane >> 4;
    for (int u = bid; u < 16 * NCH; u += G) {
        const int chunk = u & 31, bh = u >> 5, b = bh >> 3, h = bh & 7;
        const float lf2 = log2_sigmoid(dec_f[h]), lb2 = log2_sigmoid(dec_b[h]);
        const size_t rowb = (size_t)b * T + chunk * 128;
        dma_tile_b(Z + rowb * ZW + ZN_RK + h * 128, ZW, lds, 128, wave, lane);
        dma_tile_b(Z + rowb * ZW + ZN_RV + h * 128, ZW, lds + 32768, 128, wave, lane);
        dma_tile_b(SST + ((size_t)((0 * 16 + bh) * NCH + chunk)) * 16384, 128, lds + 65536, 128, wave, lane);
        dma_tile_b(SST + ((size_t)((1 * 16 + bh) * NCH + chunk)) * 16384, 128, lds + 98304, 128, wave, lane);
        const int q = 16 * wave + fr;
        bf16x8 qf[4];
#pragma unroll
        for (int ks = 0; ks < 4; ++ks) qf[ks] = *(const bf16x8*)(Z + (rowb + q) * ZW + ZN_RQ + h * 128 + 32 * ks + 8 * g);
        u32x2 rg[8];
        { const bf16* rgp = Z + (rowb + q) * ZW + ZN_RG + h * 128 + 4 * g;
#pragma unroll
          for (int i = 0; i < 8; ++i) rg[i] = *(const u32x2*)(rgp + 16 * i); }
        DMA_WAIT_ALL(); __syncthreads();
        u32x2 pw[8];
#pragma unroll
        for (int kt = 0; kt < 8; ++kt) {
            f32x4 s = {0.f, 0.f, 0.f, 0.f};
#pragma unroll
            for (int ks = 0; ks < 4; ++ks) s = MFMA16(frag_row_b(Kt, 16 * kt + fr, ks, g), qf[ks], s);
            float pv[4];
#pragma unroll
            for (int r = 0; r < 4; ++r) { const int m = 16 * kt + 4 * g + r, diff = q - m;
                const float dc = diff >= 0 ? exp2f(lf2 * (float)diff) : exp2f(lb2 * (float)(-diff)); pv[r] = s[r] * dc; }
            pw[kt].x = pk_bf16(pv[0], pv[1]); pw[kt].y = pk_bf16(pv[2], pv[3]);
        }
        __syncthreads();
#pragma unroll
        for (int kt = 0; kt < 8; ++kt) *(LAS u32x2*)(Pt + off_b(q, 2 * kt + (g >> 1)) + 8 * (g & 1)) = pw[kt];
        LDS_WAIT();
        f32x4 o[8];
#pragma unroll
        for (int i = 0; i < 8; ++i) o[i] = (f32x4){0.f, 0.f, 0.f, 0.f};
#pragma unroll
        for (int ks = 0; ks < 4; ++ks) {
            const bf16x8 pb = frag_row_b(Pt, q, ks, g);
#pragma unroll
            for (int i = 0; i < 8; ++i) o[i] = MFMA16(frag_tr_b(Vt, lane, i, ks), pb, o[i]);
        }
#pragma unroll
        for (int d = 0; d < 2; ++d) {
            const float qd = d == 0 ? exp2f(lf2 * (float)(q + 1)) : exp2f(lb2 * (float)(128 - q));
            const LAS unsigned char* St = d == 0 ? Sft : Sbt;
#pragma unroll
            for (int i = 0; i < 8; ++i) {
                f32x4 c = {0.f, 0.f, 0.f, 0.f};
#pragma unroll
                for (int ks = 0; ks < 4; ++ks) c = MFMA16(frag_row_b(St, 16 * i + fr, ks, g), qf[ks], c);
                o[i] += c * qd;
            }
        }
        float s1 = 0.f;
#pragma unroll
        for (int i = 0; i < 8; ++i) s1 += (o[i].x + o[i].y) + (o[i].z + o[i].w);
        s1 += __shfl_xor(s1, 16); s1 += __shfl_xor(s1, 32);
        const float mu = s1 * (1.0f / 128);
        float s2 = 0.f;
#pragma unroll
        for (int i = 0; i < 8; ++i) { const f32x4 dd = o[i] - mu; s2 += (dd.x * dd.x + dd.y * dd.y) + (dd.z * dd.z + dd.w * dd.w); }
        s2 += __shfl_xor(s2, 16); s2 += __shfl_xor(s2, 32);
        const float rs = 1.0f / sqrtf(s2 * (1.0f / 128) + EPS);
        bf16* yo = YC + (rowb + q) * YCW + YC_RET + h * 128 + 4 * g;
#pragma unroll
        for (int i = 0; i < 8; ++i) {
            const float g0 = bf_lo(rg[i].x), g1 = bf_hi(rg[i].x), g2 = bf_lo(rg[i].y), g3 = bf_hi(rg[i].y);
            u32x2 w; w.x = pk_bf16(g0 * ((o[i].x - mu) * rs), g1 * ((o[i].y - mu) * rs));
            w.y = pk_bf16(g2 * ((o[i].z - mu) * rs), g3 * ((o[i].w - mu) * rs));
            *(u32x2*)(yo + 16 * i) = w;
        }
        __syncthreads();
    }
}

constexpr int NP = 72 * 2;
__device__ __forceinline__ void na_units(const bf16* Z, const float* rpb  , bf16* YC, LAS unsigned char* lds, int tid, int lane, int wave, int bid, int G) {
    LAS unsigned char* Kl = lds;
    LAS unsigned char* Vt = lds + 64 * RP;
    LAS unsigned char* Pl = lds + 64 * RP + 128 * NP + wave * 16 * NP;
    LAS float* bias = (LAS float*)(lds + 64 * RP + 128 * NP + 8 * 16 * NP);
    const int fr = lane & 15, g = lane >> 4;
    for (int u = bid; u < 16 * 32; u += G) {
        const int rp = u & 31, bh = u >> 5, b = bh >> 3, h = bh & 7, r0 = 2 * rp;
        for (int i = tid; i < 465; i += 512) bias[i] = rpb[h * 465 + i];
        const int qr = r0 + (wave >> 2), c = 16 * (wave & 3) + fr;
        const size_t rowq = (size_t)b * T + qr * 64 + c;
        bf16x8 qf[4];
#pragma unroll
        for (int ks = 0; ks < 4; ++ks) qf[ks] = *(const bf16x8*)(Z + rowq * ZW + ZN_NQ + h * 128 + 32 * ks + 8 * g);
        const int rs_q = min(max(qr - 4, 0), 56), cs_q = min(max(c - 8, 0), 48);
        const int kr_lo = min(max(r0 - 4, 0), 56), kr_hi = min(max(r0 - 3, 0), 56) + 7;
        float m_run = -INFINITY, l_run = 0.f;
        f32x4 o[8];
#pragma unroll
        for (int i = 0; i < 8; ++i) o[i] = (f32x4){0.f, 0.f, 0.f, 0.f};
        u32x4 kreg[2], vreg[2];
        { const size_t rowk = (size_t)b * T + kr_lo * 64;
#pragma unroll
          for (int rep = 0; rep < 2; ++rep) { const int it = tid + 512 * rep;
              kreg[rep] = *(const u32x4*)(Z + (rowk + (it >> 4)) * ZW + ZN_NK + h * 128 + 8 * (it & 15));
              vreg[rep] = *(const u32x4*)(Z + (rowk + (it & 63)) * ZW + ZN_NV + h * 128 + 8 * (it >> 6)); } }
        for (int kr = kr_lo; kr <= kr_hi; ++kr) {
#pragma unroll
            for (int rep = 0; rep < 2; ++rep) { const int it = tid + 512 * rep, kc = it >> 4, ch = it & 15;
                *(LAS u32x4*)(Kl + kc * RP + 16 * ch) = kreg[rep]; }
#pragma unroll
            for (int rep = 0; rep < 2; ++rep) { const int it = tid + 512 * rep, kc = it & 63, ch = it >> 6;
                const unsigned vw[4] = {vreg[rep].x, vreg[rep].y, vreg[rep].z, vreg[rep].w};
#pragma unroll
                for (int e = 0; e < 8; ++e) *(LAS bf16*)(Vt + (8 * ch + e) * NP + 2 * kc) = (bf16)((e & 1) ? (vw[e >> 1] >> 16) : (vw[e >> 1] & 0xffffu)); }
            __syncthreads();
            if (kr < kr_hi) { const size_t rowk = (size_t)b * T + (kr + 1) * 64;
#pragma unroll
                for (int rep = 0; rep < 2; ++rep) { const int it = tid + 512 * rep;
                    kreg[rep] = *(const u32x4*)(Z + (rowk + (it >> 4)) * ZW + ZN_NK + h * 128 + 8 * (it & 15));
                    vreg[rep] = *(const u32x4*)(Z + (rowk + (it & 63)) * ZW + ZN_NV + h * 128 + 8 * (it >> 6)); } }
            if (kr >= rs_q && kr < rs_q + 8) {
                float s[4][4]; float mx = -INFINITY;
#pragma unroll
                for (int kt = 0; kt < 4; ++kt) {
                    f32x4 a4 = {0.f, 0.f, 0.f, 0.f};
#pragma unroll
                    for (int ks = 0; ks < 4; ++ks) { const bf16x8 a = *(const LAS bf16x8*)(Kl + (16 * kt + fr) * RP + (32 * ks + 8 * g) * 2); a4 = MFMA16(a, qf[ks], a4); }
#pragma unroll
                    for (int r = 0; r < 4; ++r) { const int kc = 16 * kt + 4 * g + r; const bool valid = (kc >= cs_q) && (kc < cs_q + 16);
                        const int bi = valid ? ((kr - qr + 7) * 31 + (kc - c + 15)) : 0;
                        const float sv = valid ? (a4[r] + bias[bi]) : -INFINITY; s[kt][r] = sv; mx = fmaxf(mx, sv); }
                }
                mx = fmaxf(mx, __shfl_xor(mx, 16)); mx = fmaxf(mx, __shfl_xor(mx, 32));
                const float m_new = fmaxf(m_run, mx), alpha = __expf(m_run - m_new);
                float ps = 0.f;
#pragma unroll
                for (int kt = 0; kt < 4; ++kt) {
#pragma unroll
                    for (int r = 0; r < 4; ++r) { s[kt][r] = __expf(s[kt][r] - m_new); ps += s[kt][r]; }
                    u32x2 w; w.x = pk_bf16(s[kt][0], s[kt][1]); w.y = pk_bf16(s[kt][2], s[kt][3]);
                    *(LAS u32x2*)(Pl + fr * NP + (16 * kt + 4 * g) * 2) = w;
                }
                ps += __shfl_xor(ps, 16); ps += __shfl_xor(ps, 32);
                l_run = l_run * alpha + ps; m_run = m_new;
#pragma unroll
                for (int i = 0; i < 8; ++i) o[i] *= alpha;
                LDS_WAIT();
#pragma unroll
                for (int ks = 0; ks < 2; ++ks) {
                    const bf16x8 pb = *(const LAS bf16x8*)(Pl + fr * NP + (32 * ks + 8 * g) * 2);
#pragma unroll
                    for (int i = 0; i < 8; ++i) { const bf16x8 a = *(const LAS bf16x8*)(Vt + (16 * i + fr) * NP + (32 * ks + 8 * g) * 2); o[i] = MFMA16(a, pb, o[i]); }
                }
            }
            __syncthreads();
        }
        const float inv = 1.0f / l_run;
        bf16* yo = YC + rowq * YCW + YC_NA + h * 128 + 4 * g;
#pragma unroll
        for (int i = 0; i < 8; ++i) { u32x2 w; w.x = pk_bf16(o[i].x * inv, o[i].y * inv); w.y = pk_bf16(o[i].z * inv, o[i].w * inv); *(u32x2*)(yo + 16 * i) = w; }
    }
}

__device__ __forceinline__ void na_dma_row(const bf16* Z, size_t rowk, int h, LAS unsigned char* slot, int wave, int lane) {
    dma_tile_b(Z + rowk * ZW + ZN_NK + h * 128, ZW, slot, 64, wave, lane);
    dma_tile_b(Z + rowk * ZW + ZN_NV + h * 128, ZW, slot + 16384, 64, wave, lane);
}
__device__ __forceinline__ void na_units2(const bf16* Z, const float* rpb  , bf16* YC, LAS unsigned char* lds, int tid, int lane, int wave, int bid, int G) {
    LAS unsigned char* Pw = lds + 98304 + wave * 4096;
    LAS float* bias = (LAS float*)(lds + LDSCTL_OFF + 512);
    const int fr = lane & 15, g = lane >> 4;
    for (int u = bid; u < 256; u += G) {
        const int rq = u & 15, bh = u >> 4, b = bh >> 3, h = bh & 7, r0 = 4 * rq;
        for (int i = tid; i < 465; i += 512) bias[i] = rpb[h * 465 + i];
        const int jc = wave & 3, c = 16 * jc + fr, qr0 = r0 + 2 * (wave >> 2);
        bf16x8 qf[2][4];
#pragma unroll
        for (int i = 0; i < 2; ++i)
#pragma unroll
            for (int ks = 0; ks < 4; ++ks) qf[i][ks] = *(const bf16x8*)(Z + ((size_t)b * T + (qr0 + i) * 64 + c) * ZW + ZN_NQ + h * 128 + 32 * ks + 8 * g);
        const int cs_q = min(max(c - 8, 0), 48);
        const int kt_lo = min(max(16 * jc - 8, 0), 48) >> 4, kt_hi = (min(max(16 * jc + 7, 0), 48) + 15) >> 4;
        const int kr_lo = min(max(r0 - 4, 0), 56), kr_hi = min(max(r0 - 1, 0), 56) + 7;
        const int rs0 = min(max(qr0 - 4, 0), 56), rs1 = min(max(qr0 - 3, 0), 56);
        float m_run[2] = {-INFINITY, -INFINITY}, l_run[2] = {0.f, 0.f};
        f32x4 o[2][8];
#pragma unroll
        for (int i = 0; i < 2; ++i)
#pragma unroll
            for (int d = 0; d < 8; ++d) o[i][d] = (f32x4){0.f, 0.f, 0.f, 0.f};
        na_dma_row(Z, (size_t)b * T + kr_lo * 64, h, lds, wave, lane);
        if (kr_lo + 1 <= kr_hi) na_dma_row(Z, (size_t)b * T + (kr_lo + 1) * 64, h, lds + 32768, wave, lane);
        int slot = 0;
        for (int kr = kr_lo; kr <= kr_hi; ++kr) {
            if (kr + 1 <= kr_hi) asm volatile("s_waitcnt vmcnt(4) lgkmcnt(0)" ::: "memory"); else asm volatile("s_waitcnt vmcnt(0) lgkmcnt(0)" ::: "memory");
            __builtin_amdgcn_s_barrier(); asm volatile("" ::: "memory");
            if (kr + 2 <= kr_hi) { const int s2 = slot >= 1 ? slot - 1 : 2; na_dma_row(Z, (size_t)b * T + (kr + 2) * 64, h, lds + s2 * 32768, wave, lane); }
            const LAS unsigned char* Ks = lds + slot * 32768; const LAS unsigned char* Vs = Ks + 16384;
            const bool act0 = (kr >= rs0) && (kr < rs0 + 8), act1 = (kr >= rs1) && (kr < rs1 + 8);
            if (act0 || act1) {
                float s[2][4][4];
#pragma unroll
                for (int kt = 0; kt < 4; ++kt) {
                    if (kt >= kt_lo && kt <= kt_hi) {
                        f32x4 a0 = {0.f, 0.f, 0.f, 0.f}, a1 = {0.f, 0.f, 0.f, 0.f};
#pragma unroll
                        for (int ks = 0; ks < 4; ++ks) { const bf16x8 a = frag_row_b(Ks, 16 * kt + fr, ks, g); a0 = MFMA16(a, qf[0][ks], a0); a1 = MFMA16(a, qf[1][ks], a1); }
#pragma unroll
                        for (int r = 0; r < 4; ++r) { const int kc = 16 * kt + 4 * g + r; const bool valid = (kc >= cs_q) && (kc < cs_q + 16);
                            const int bi0 = valid ? ((kr - qr0 + 7) * 31 + (kc - c + 15)) : 0;
                            const int b0c = min(max(bi0, 0), 464), b1c = min(max(bi0 - 31, 0), 464);
                            s[0][kt][r] = valid ? (a0[r] + bias[b0c]) : -INFINITY; s[1][kt][r] = valid ? (a1[r] + bias[b1c]) : -INFINITY; }
                    } else {
#pragma unroll
                        for (int r = 0; r < 4; ++r) { s[0][kt][r] = -INFINITY; s[1][kt][r] = -INFINITY; }
                    }
                }
#pragma unroll
                for (int i = 0; i < 2; ++i) {
                    if (i == 0 ? act0 : act1) {
                        float mx = -INFINITY;
#pragma unroll
                        for (int kt = 0; kt < 4; ++kt)
#pragma unroll
                            for (int r = 0; r < 4; ++r) mx = fmaxf(mx, s[i][kt][r]);
                        mx = fmaxf(mx, __shfl_xor(mx, 16)); mx = fmaxf(mx, __shfl_xor(mx, 32));
                        const float m_new = fmaxf(m_run[i], mx), alpha = __expf(m_run[i] - m_new);
                        float ps = 0.f;
#pragma unroll
                        for (int kt = 0; kt < 4; ++kt) {
#pragma unroll
                            for (int r = 0; r < 4; ++r) { s[i][kt][r] = __expf(s[i][kt][r] - m_new); ps += s[i][kt][r]; }
                            u32x2 w; w.x = pk_bf16(s[i][kt][0], s[i][kt][1]); w.y = pk_bf16(s[i][kt][2], s[i][kt][3]);
                            *(LAS u32x2*)(Pw + i * 2048 + fr * 128 + 16 * ((2 * kt + (g >> 1)) ^ (fr & 7)) + 8 * (g & 1)) = w;
                        }
                        ps += __shfl_xor(ps, 16); ps += __shfl_xor(ps, 32);
                        l_run[i] = l_run[i] * alpha + ps; m_run[i] = m_new;
#pragma unroll
                        for (int d = 0; d < 8; ++d) o[i][d] *= alpha;
                    }
                }
                LDS_WAIT();
#pragma unroll
                for (int ks = 0; ks < 2; ++ks) {
                    if (ks >= (kt_lo >> 1) && ks <= (kt_hi >> 1)) {
                        const bf16x8 pb0 = *(const LAS bf16x8*)(Pw + 0 * 2048 + fr * 128 + 16 * ((4 * ks + g) ^ (fr & 7)));
                        const bf16x8 pb1 = *(const LAS bf16x8*)(Pw + 1 * 2048 + fr * 128 + 16 * ((4 * ks + g) ^ (fr & 7)));
#pragma unroll
                        for (int d = 0; d < 8; ++d) { const bf16x8 a = frag_tr_b(Vs, lane, d, ks);
                            if (act0) o[0][d] = MFMA16(a, pb0, o[0][d]);
                            if (act1) o[1][d] = MFMA16(a, pb1, o[1][d]); }
                    }
                }
            }
            slot = slot == 2 ? 0 : slot + 1;
        }
#pragma unroll
        for (int i = 0; i < 2; ++i) {
            const float inv = 1.0f / l_run[i];
            bf16* yo = YC + ((size_t)b * T + (qr0 + i) * 64 + c) * YCW + YC_NA + h * 128 + 4 * g;
#pragma unroll
            for (int d = 0; d < 8; ++d) { u32x2 w; w.x = pk_bf16(o[i][d].x * inv, o[i][d].y * inv); w.y = pk_bf16(o[i][d].z * inv, o[i][d].w * inv); *(u32x2*)(yo + 16 * d) = w; }
        }
        __syncthreads();
    }
}

__device__ __forceinline__ void conv_units2(const bf16* Z, bf16* YC, const float* scw, const float* cfw, const float* cfg, const float* cfb,
                                            LAS unsigned char* lds, int tid, int lane, int wave, int bid, int G) {
    const unsigned c00 = 2u * (unsigned)tid;
    LAS unsigned char* U = lds;
    LAS unsigned char* Pb = lds + (CT + 30) * 2048;
    LAS float* red = (LAS float*)(lds + LDSCTL_OFF + 512);
    LAS float* tot = red + 8 * 2 * CT;
    for (int u = bid; u < M / CT; u += G) {
        const int row0 = CT * u, b = row0 >> 12, ts = row0 & 4095;
        unsigned c0 = c00; asm volatile("" : "+v"(c0));
        const bf16* Zb = Z + (size_t)b * T * ZW;
        for (int i = wave; i < 2 * (CT + 30); i += 8) { const int tok = ts - 15 + (i >> 1);
            if (tok >= 0 && tok < T) __builtin_amdgcn_global_load_lds((const unsigned*)(Zb + (size_t)tok * ZW + ZN_U + 512 * (i & 1) + 8 * lane), (LAS unsigned*)(U + 1024 * i), 16, 0, 0);
            else *(LAS u32x4*)(U + 1024 * i + 16 * lane) = (u32x4){0u, 0u, 0u, 0u}; }
        for (int i = wave; i < 2 * (CT + 2); i += 8) { const int tok = ts - 1 + (i >> 1);
            if (tok >= 0 && tok < T) __builtin_amdgcn_global_load_lds((const unsigned*)(Zb + (size_t)tok * ZW + ZN_P + 512 * (i & 1) + 8 * lane), (LAS unsigned*)(Pb + 1024 * i), 16, 0, 0);
            else *(LAS u32x4*)(Pb + 1024 * i + 16 * lane) = (u32x4){0u, 0u, 0u, 0u}; }
        float w[31][2];
#pragma unroll
        for (int k = 0; k < 31; ++k) { const f32x2 t = *(const f32x2*)((cfw + k * 1024) + c0); w[k][0] = t.x; w[k][1] = t.y; }
        unsigned sbv[CT];
#pragma unroll
        for (int t = 0; t < CT; ++t) sbv[t] = *(const unsigned*)((Zb + (size_t)(ts + t) * ZW + ZN_SB) + c0);
        float w3[3][2];
#pragma unroll
        for (int k = 0; k < 3; ++k) { const f32x2 t = *(const f32x2*)((scw + k * 1024) + c0); w3[k][0] = t.x; w3[k][1] = t.y; }
        const f32x2 lg = *(const f32x2*)(cfg + c0), lb = *(const f32x2*)(cfb + c0);
        DMA_WAIT_ALL(); __syncthreads();
        float acc[CT][2];
#pragma unroll
        for (int t = 0; t < CT; ++t) { acc[t][0] = 0.f; acc[t][1] = 0.f; }
#pragma unroll
        for (int j = 0; j < CT + 30; ++j) {
            const unsigned uv = *(const LAS unsigned*)(U + (j * 2048u + c0 * 2u));
            const float u0 = bf_lo(uv), u1 = bf_hi(uv);
#pragma unroll
            for (int t = 0; t < CT; ++t) { const int k = j - t; if (k >= 0 && k <= 30) { acc[t][0] += w[k][0] * u0; acc[t][1] += w[k][1] * u1; } }
            if ((j & 7) == 7) asm volatile("" ::: "memory");
        }
        float st[2 * CT];
#pragma unroll
        for (int t = 0; t < CT; ++t) { st[t] = wave_sum(acc[t][0] + acc[t][1]); st[CT + t] = wave_sum(acc[t][0] * acc[t][0] + acc[t][1] * acc[t][1]); }
        if (lane == 0) {
#pragma unroll
            for (int i = 0; i < 2 * CT; ++i) red[wave * 2 * CT + i] = st[i]; }
        __syncthreads();
        if (tid < 2 * CT) { float s = 0.f;
#pragma unroll
            for (int wv = 0; wv < 8; ++wv) s += red[wv * 2 * CT + tid];
            tot[tid] = s; }
        __syncthreads();
#pragma unroll
        for (int t = 0; t < CT; ++t) {
            const float mu = tot[t] * (1.0f / 1024), var = fmaxf(tot[CT + t] * (1.0f / 1024) - mu * mu, 0.f), rs = 1.0f / sqrtf(var + EPS);
            float y0 = (acc[t][0] - mu) * rs * lg.x + lb.x, y1 = (acc[t][1] - mu) * rs * lg.y + lb.y;
            y0 *= fsigmoid(y0); y1 *= fsigmoid(y1);
            *(unsigned*)(YC + (size_t)(row0 + t) * YCW + YC_CF + c0) = pk_bf16(y0, y1);
        }
        {
            unsigned pa = *(const LAS unsigned*)(Pb + (0 * 2048u + c0 * 2u)), pbv = *(const LAS unsigned*)(Pb + (1 * 2048u + c0 * 2u));
#pragma unroll
            for (int t = 0; t < CT; ++t) {
                const unsigned pc = *(const LAS unsigned*)(Pb + ((t + 2) * 2048u + c0 * 2u));
                const float o0 = w3[0][0] * bf_lo(pa) + w3[1][0] * bf_lo(pbv) + w3[2][0] * bf_lo(pc);
                const float o1 = w3[0][1] * bf_hi(pa) + w3[1][1] * bf_hi(pbv) + w3[2][1] * bf_hi(pc);
                *(unsigned*)(YC + (size_t)(row0 + t) * YCW + YC_SC + c0) = pk_bf16(bf_lo(sbv[t]) * o0, bf_hi(sbv[t]) * o1);
                pa = pbv; pbv = pc;
            }
        }
        __syncthreads();
    }
}

#define PH_BEGIN() int wave = wave0; asm volatile("" : "+s"(wave)); const int lane = lane_id(); const int tid = wave * 64 + lane; \
    int G = G0, bid = bid0; asm volatile("" : "+s"(G), "+s"(bid)); unsigned char* ws = args.ws; asm volatile("" : "+s"(ws)); \
    LAS unsigned char* lds = lds0; asm volatile("" : "+s"(lds)); (void)lane; (void)wave; (void)G; (void)bid; (void)ws; (void)lds
__global__ void __launch_bounds__(512, 2) fwd(Args args) {
    extern __shared__ __attribute__((aligned(16))) unsigned char lds_raw[];
    LAS unsigned char* lds0 = (LAS unsigned char*)lds_raw;
    const int wave0 = __builtin_amdgcn_readfirstlane(threadIdx.x >> 6);
    const int G0 = gridDim.x, bid0 = blockIdx.x;
    volatile LAS unsigned* MISC = (volatile LAS unsigned*)(lds0 + MISC_OFF);
    for (int u = wave0 * 64 + lane_id(); u < (LDS_BYTES - LDSCTL_OFF) / 4; u += 512) ((LAS unsigned*)(lds0 + LDSCTL_OFF))[u] = 0u;
    __syncthreads();
    const int lo = args.ph_lo, hi = args.ph_hi;
    XcdBarrier bar; bar.bar = (unsigned*)(args.ws + WS_CTL) + CW_BAR; bar.x = 0; bar.st = nullptr; bar.wave = wave0;
    if (hi - lo > 1) bar = xcd_barrier_post((unsigned*)(args.ws + WS_CTL) + CW_BAR, MISC + 8, wave0);
#define IN(k) (lo <= (k) && (k) < hi)
#ifndef PROBE_KIND
#define PROBE_KIND (-1)
#endif
    unsigned long long pt_acc = 0ull, pt_t0 = 0ull;
#define PT_BEG(kind) do { if ((kind) == PROBE_KIND) pt_t0 = __builtin_amdgcn_s_memrealtime(); } while (0)
#define PT_END(kind) do { if ((kind) == PROBE_KIND) pt_acc += __builtin_amdgcn_s_memrealtime() - pt_t0; } while (0)
#define SEAM(k) do { if (IN((k) + 1)) { XcdBarrier bb_ = bar; asm volatile("" : "+s"(bb_.bar), "+s"(bb_.x), "+s"(bb_.wave)); xcd_barrier(bb_); } } while (0)

    if (IN(0)) { PT_BEG(10); PH_BEGIN(); for (int rep_ = 0; rep_ < REP_PRO; ++rep_) phase_prologue(args, lds, tid, lane, wave, bid, G); SEAM(0); PT_END(10); }
    if (IN(1)) {
        PT_BEG(11); PH_BEGIN(); const float* MOD = (const float*)(ws + WS_MOD);
        norm_rows(args.in[0], args.out, nullptr, nullptr, nullptr, true, MOD + 1 * D, MOD + 0 * D, args.in[4], (bf16*)(ws + WS_H), bid * 8 + wave, G * 8, lane);
        SEAM(1); PT_END(11);
    }
#define LAYER_BODY(l) do { \
        const int p0 = 2 + 10 * l; \
        if (IN(p0 + 0)) { PT_BEG(0); \
            PH_BEGIN(); \
            pg8::Gemm g{(const bf16*)(ws + WS_H), (const bf16*)(ws + WS_WIN) + (size_t)l * DIN * D, M, DIN, D}; pg8::StaticOrder S; S.init(M, DIN, G, bid); \
            EpiZ E{(bf16*)(ws + WS_Z), (const f32x2*)(ws + WS_ROPE)}; \
            for (int rep_ = 0; rep_ < REP_G1; ++rep_) pg8::gemm_phase<EpiZ, pg8::StaticOrder, true, true>(lds, g, S, E, tid); \
            SEAM(p0 + 0); PT_END(0); \
        } \
        if (IN(p0 + 1)) { PT_BEG(1); \
            PH_BEGIN(); \
            for (int rep_ = 0; rep_ < REP_M1; ++rep_) { PT_BEG(14); ret_local_units2((const bf16*)(ws + WS_Z), args.in[9] + l * NH, args.in[10] + l * NH, (float*)(ws + WS_LST), lds, tid, lane, wave, bid, G); PT_END(14); \
            PT_BEG(15); conv_units2((const bf16*)(ws + WS_Z), (bf16*)(ws + WS_YCAT), args.in[12] + (size_t)l * 3 * 1024, args.in[13] + (size_t)l * 31 * 1024, args.in[14] + (size_t)l * 1024, args.in[15] + (size_t)l * 1024, lds, tid, lane, wave, bid, G); PT_END(15); } \
            SEAM(p0 + 1); PT_END(1); \
        } \
        if (IN(p0 + 2)) { PT_BEG(2); \
            PH_BEGIN(); \
            for (int rep_ = 0; rep_ < REP_M2; ++rep_) { PT_BEG(12); ret_scan((const float*)(ws + WS_LST), (bf16*)(ws + WS_SST), args.in[9] + l * NH, args.in[10] + l * NH, tid, bid, G); PT_END(12); \
            PT_BEG(13); na_units2((const bf16*)(ws + WS_Z), args.in[11] + (size_t)l * NH * 465, (bf16*)(ws + WS_YCAT), lds, tid, lane, wave, bid, G); PT_END(13); } \
            SEAM(p0 + 2); PT_END(2); \
        } \
        if (IN(p0 + 3)) { PT_BEG(3); \
            PH_BEGIN(); \
            for (int rep_ = 0; rep_ < REP_M3; ++rep_) ret_out_units2((const bf16*)(ws + WS_Z), args.in[9] + l * NH, args.in[10] + l * NH, (const bf16*)(ws + WS_SST), (bf16*)(ws + WS_YCAT), lds, tid, lane, wave, bid, G); \
            SEAM(p0 + 3); PT_END(3); \
        } \
        if (IN(p0 + 4)) { PT_BEG(4); \
            PH_BEGIN(); \
            pg8::Gemm g{(const bf16*)(ws + WS_YCAT), (const bf16*)(ws + WS_WCAT) + (size_t)l * D * YCW, M, D, YCW}; pg8::StaticOrder S; S.init(M, D, G, bid); \
            pg8::EpiMerge E{(const bf16*)(ws + WS_Z) + ZN_R1, ZW, (bf16*)(ws + WS_MERGED), D}; \
            for (int rep_ = 0; rep_ < REP_G2; ++rep_) pg8::gemm_phase<pg8::EpiMerge, pg8::StaticOrder, false, true>(lds, g, S, E, tid); \
            SEAM(p0 + 4); PT_END(4); \
        } \
        if (IN(p0 + 5)) { PT_BEG(5); \
            PH_BEGIN(); \
            pg8::Gemm g{(const bf16*)(ws + WS_MERGED), (const bf16*)(ws + WS_WO) + (size_t)l * D * D, M, D, D}; pg8::StaticOrder S; S.init(M, D, G, bid); \
            pg8::EpiBf16<0> E{(bf16*)(ws + WS_Y), D, 0}; \
            for (int rep_ = 0; rep_ < REP_G3; ++rep_) pg8::gemm_phase<pg8::EpiBf16<0>, pg8::StaticOrder, false, true>(lds, g, S, E, tid); \
            SEAM(p0 + 5); PT_END(5); \
        } \
        if (IN(p0 + 6)) { PT_BEG(6); \
            PH_BEGIN(); const float* modl = (const float*)(ws + WS_MOD) + (size_t)l * 2 * MODW; \
            norm_rows(args.out, args.out, (const bf16*)(ws + WS_Y), modl + 2 * D, args.in[5] + (size_t)l * D, true, modl + 4 * D, modl + 3 * D, args.in[6] + (size_t)l * D, (bf16*)(ws + WS_H), bid * 8 + wave, G * 8, lane); \
            SEAM(p0 + 6); PT_END(6); \
        } \
        if (IN(p0 + 7)) { PT_BEG(7); \
            PH_BEGIN(); \
            pg8::Gemm g{(const bf16*)(ws + WS_H), (const bf16*)(ws + WS_W1) + (size_t)l * DFF * D, M, DFF, D}; pg8::StaticOrder S; S.init(M, DFF, G, bid); \
            pg8::EpiBf16<1> E{(bf16*)(ws + WS_U), DFF, 0}; \
            for (int rep_ = 0; rep_ < REP_G4; ++rep_) pg8::gemm_phase<pg8::EpiBf16<1>, pg8::StaticOrder, true, true>(lds, g, S, E, tid); \
            SEAM(p0 + 7); PT_END(7); \
        } \
        if (IN(p0 + 8)) { PT_BEG(8); \
            PH_BEGIN(); \
            pg8::Gemm g{(const bf16*)(ws + WS_U), (const bf16*)(ws + WS_W2) + (size_t)l * D * DFF, M, D, DFF}; pg8::StaticOrder S; S.init(M, D, G, bid); \
            pg8::EpiBf16<0> E{(bf16*)(ws + WS_Y), D, 0}; \
            for (int rep_ = 0; rep_ < REP_G5; ++rep_) pg8::gemm_phase<pg8::EpiBf16<0>, pg8::StaticOrder, false, true>(lds, g, S, E, tid); \
            SEAM(p0 + 8); PT_END(8); \
        } \
        if (IN(p0 + 9)) { PT_BEG(9); \
            PH_BEGIN(); const float* modl = (const float*)(ws + WS_MOD) + (size_t)l * 2 * MODW; \
            const bool nh = (l + 1 < DEPTH); const float* modn = (const float*)(ws + WS_MOD) + (size_t)(nh ? l + 1 : l) * 2 * MODW; \
            norm_rows(args.out, args.out, (const bf16*)(ws + WS_Y), modl + 5 * D, args.in[7] + (size_t)l * D, nh, modn + 1 * D, modn + 0 * D, args.in[4] + (size_t)(nh ? l + 1 : l) * D, (bf16*)(ws + WS_H), bid * 8 + wave, G * 8, lane); \
            SEAM(p0 + 9); PT_END(9); \
        } \
    } while (0)
    LAYER_BODY(0); LAYER_BODY(1); LAYER_BODY(2); LAYER_BODY(3);
    if (PROBE_KIND >= 0 && bid0 == 0) { const unsigned long long t0 = __builtin_amdgcn_s_memrealtime(); while (__builtin_amdgcn_s_memrealtime() - t0 < pt_acc) __builtin_amdgcn_s_sleep(8); }
#undef IN
#undef SEAM
}

extern "C" void kernel_launch(void* const* d_in, const int* in_sizes, int n_in, void* d_out, int out_size, void* d_ws, size_t ws_size, hipStream_t stream) {
    static int grid = 0;
    if (grid == 0) {
        if (n_in != 23 || out_size != M * D || ws_size < WS_END) { fprintf(stderr, "kernel_launch: unexpected problem (n_in %d, out %d, ws %zu)\n", n_in, out_size, ws_size); grid = -1; return; }
        int dev = 0, cus = 0, per_cu = 0;
        if (hipGetDevice(&dev) != hipSuccess || hipDeviceGetAttribute(&cus, hipDeviceAttributeMultiprocessorCount, dev) != hipSuccess) { grid = -1; return; }
        if (hipFuncSetAttribute((const void*)fwd, hipFuncAttributeMaxDynamicSharedMemorySize, LDS_BYTES) != hipSuccess) { fprintf(stderr, "kernel_launch: hipFuncSetAttribute failed\n"); grid = -1; return; }
        if (hipOccupancyMaxActiveBlocksPerMultiprocessor(&per_cu, (const void*)fwd, 512, LDS_BYTES) != hipSuccess || per_cu < 1) fprintf(stderr, "kernel_launch: occupancy query says %d\n", per_cu);
        (void)hipGetLastError();
        grid = cus;
    }
    if (grid < 0) return;
    (void)hipMemsetAsync((char*)d_ws + WS_CTL, 0, CTL_ZERO_BYTES, stream);
    Args a{};
    for (int i = 0; i < 23; ++i) a.in[i] = (const float*)d_in[i];
    a.out = (float*)d_out; a.ws = (unsigned char*)d_ws;
#if MK_SINGLE_LAUNCH
    a.ph_lo = 0; a.ph_hi = N_PHASES;
    hipLaunchKernelGGL(fwd, dim3(grid), dim3(512), LDS_BYTES, stream, a);
#else
    for (int p = 0; p < N_PHASES; ++p) { a.ph_lo = p; a.ph_hi = p + 1; hipLaunchKernelGGL(fwd, dim3(grid), dim3(512), LDS_BYTES, stream, a); }
#endif
}
```

```cpp
#include <hip/hip_runtime.h>
#include <cstdio>
#include <cstdint>

#define LAS __attribute__((address_space(3)))
#define GAS __attribute__((address_space(1)))
#define REP_G1 1
#define REP_M1 1
#define REP_M2 1
#define REP_M3 1
#define REP_G2 1
#define REP_G3 1
#define REP_G4 1
#define REP_G5 1
#define REP_PRO 1
#ifndef MK_SINGLE_LAUNCH
#define MK_SINGLE_LAUNCH 1
#endif

typedef unsigned short bf16;
typedef short bf16x8 __attribute__((ext_vector_type(8)));
typedef float f32x4 __attribute__((ext_vector_type(4)));
typedef float f32x2 __attribute__((ext_vector_type(2)));
typedef unsigned u32x4 __attribute__((ext_vector_type(4)));
typedef unsigned u32x2 __attribute__((ext_vector_type(2)));

__device__ __forceinline__ unsigned pk_bf16(float lo, float hi) { unsigned r; asm("v_cvt_pk_bf16_f32 %0, %1, %2" : "=v"(r) : "v"(lo), "v"(hi)); return r; }
__device__ __forceinline__ float bf_lo(unsigned w) { return __uint_as_float(w << 16); }
__device__ __forceinline__ float bf_hi(unsigned w) { return __uint_as_float(w & 0xffff0000u); }
__device__ __forceinline__ float fsigmoid(float x) { return __builtin_amdgcn_rcpf(1.0f + __expf(-x)); }
__device__ __forceinline__ float wave_sum(float v) {
#pragma unroll
    for (int o = 1; o < 64; o <<= 1) v += __shfl_xor(v, o);
    return v;
}
__device__ __forceinline__ float row16_sum(float v) {
    v += __builtin_bit_cast(float, __builtin_amdgcn_mov_dpp(__builtin_bit_cast(int, v), 0xB1, 0xf, 0xf, true));
    v += __builtin_bit_cast(float, __builtin_amdgcn_mov_dpp(__builtin_bit_cast(int, v), 0x4E, 0xf, 0xf, true));
    v += __builtin_bit_cast(float, __builtin_amdgcn_mov_dpp(__builtin_bit_cast(int, v), 0x141, 0xf, 0xf, true));
    v += __builtin_bit_cast(float, __builtin_amdgcn_mov_dpp(__builtin_bit_cast(int, v), 0x140, 0xf, 0xf, true));
    return v;
}
#define MFMA16(a, b, c) __builtin_amdgcn_mfma_f32_16x16x32_bf16((a), (b), (c), 0, 0, 0)
#define LDS_WAIT() asm volatile("s_waitcnt lgkmcnt(0)" ::: "memory")
#define VM_WAIT() asm volatile("s_waitcnt vmcnt(0)" ::: "memory")

namespace pg8 {
#define PG8_LAS __attribute__((address_space(3)))
typedef unsigned short bf16_t;
constexpr int BM = 256, BK = 64, HALF = 128, HTB = HALF * BK * 2, STAGE_BYTES = 8 * HTB, NXCD = 8, WGM = 8;

__host__ __device__ __forceinline__ int lds_byte(int r, int c) { const int st = (r >> 4) * 2 + (c >> 5), rr = r & 15, cc = c & 31, ob = rr * 64 + cc * 2; return st * 1024 + (ob ^ (((ob >> 9) & 1) << 5)); }
__host__ __device__ __forceinline__ void stage_rc(int b, int& R, int& C) { const int st = b / 1024, sb = b % 1024, swz = sb ^ (((sb >> 9) & 1) << 5); R = (st >> 1) * 16 + swz / 64; C = (st & 1) * 32 + (swz % 64) / 2; }
__host__ __device__ __forceinline__ int perm32(int rho) { const int n = rho >> 4, i = rho & 15; return 8 * (i >> 2) + 4 * n + (i & 3); }

struct Unit { int pm, pn; };
struct Gemm { const bf16_t* A; const bf16_t* Bt; int M, N, K; };

struct StaticOrder {
    int nM, nN, nwg, G, c;
    __host__ __device__ void init(int M, int N, int G_, int c_) { nM = M / BM; nN = N / BM; nwg = nM * nN; G = G_; c = c_; }
    __host__ __device__ bool next(int i, Unit& u) const {
        const long L = (long)i * G + c; if (L >= nwg) return false;
        int wgid = (int)L; { const int q = nwg / NXCD, r = nwg % NXCD, xcd = wgid % NXCD, off = wgid / NXCD; wgid = (xcd < r ? xcd * (q + 1) : r * (q + 1) + (xcd - r) * q) + off; }
        const int nig = WGM * nN, gid = wgid / nig, fm = gid * WGM, gsz = (nM - fm) < WGM ? (nM - fm) : WGM;
        u.pm = fm + ((wgid % nig) % gsz); u.pn = (wgid % nig) / gsz; return true;
    }
    __device__ __forceinline__ void a_ready(const Unit&) const {}
    __device__ __forceinline__ void done(const Unit&) const {}
};

struct EpiF32 {
    static constexpr bool PERM = false, AFTER_DRAIN = false, KHOOK = false;
    float* C; int ldc;
    __device__ __forceinline__ void operator()(const f32x4 (&acc)[2][2][4][2], const Unit& u, int wr, int wc, int fr, int fq) const {
        const int row0 = u.pm * BM + wr * 64 + fr, col0 = u.pn * BM + wc * 32 + 4 * fq;
#pragma unroll
        for (int ai = 0; ai < 2; ++ai)
#pragma unroll
            for (int m = 0; m < 4; ++m) { float* rowp = C + (size_t)(row0 + ai * HALF + m * 16) * ldc + col0;
#pragma unroll
                for (int bj = 0; bj < 2; ++bj)
#pragma unroll
                    for (int n = 0; n < 2; ++n) *(f32x4*)(rowp + bj * HALF + n * 16) = acc[ai][bj][m][n]; }
    }
    __device__ __forceinline__ void khook(f32x4 (&)[2][2][4][2], const Unit&, int, int, int, int, int) const {}
};
template <int ACT> struct EpiBf16 {
    static constexpr bool PERM = true, AFTER_DRAIN = false, KHOOK = false;
    bf16_t* O; int ldc; int sig_pn0;
    __device__ __forceinline__ void operator()(const f32x4 (&acc)[2][2][4][2], const Unit& u, int wr, int wc, int fr, int fq) const {
        const int row0 = u.pm * BM + wr * 64 + fr; const int col0 = u.pn * BM + wc * 32 + 8 * fq;
        const bool sig = (ACT == 2) && (u.pn >= sig_pn0);
#pragma unroll
        for (int ai = 0; ai < 2; ++ai)
#pragma unroll
            for (int m = 0; m < 4; ++m) { bf16_t* rowp = O + (size_t)(row0 + ai * HALF + m * 16) * ldc + col0;
#pragma unroll
                for (int bj = 0; bj < 2; ++bj) { f32x4 v0 = acc[ai][bj][m][0], v1 = acc[ai][bj][m][1];
                    if (ACT == 1) {
#pragma unroll
                        for (int j = 0; j < 4; ++j) { const float a = fmaxf(v0[j], 0.f), b = fmaxf(v1[j], 0.f); v0[j] = a * a; v1[j] = b * b; } }
                    if (ACT == 2) { if (sig) {
#pragma unroll
                        for (int j = 0; j < 4; ++j) { v0[j] = fmaxf(fsigmoid(v0[j]), 1e-20f); v1[j] = fmaxf(fsigmoid(v1[j]), 1e-20f); } } }
                    u32x4 w; w.x = pk_bf16(v0[0], v0[1]); w.y = pk_bf16(v0[2], v0[3]); w.z = pk_bf16(v1[0], v1[1]); w.w = pk_bf16(v1[2], v1[3]);
                    *(u32x4*)(rowp + bj * HALF) = w; } }
    }
    __device__ __forceinline__ void khook(f32x4 (&)[2][2][4][2], const Unit&, int, int, int, int, int) const {}
};
struct EpiMerge {
    static constexpr bool PERM = true, AFTER_DRAIN = false, KHOOK = true;
    const bf16_t* G; int ldg;
    bf16_t* O; int ldc;
    __device__ __forceinline__ void scale(f32x4 (&acc)[2][2][4][2], const Unit& u, int plane, int wr, int wc, int fr, int fq) const {
        const int row0 = u.pm * BM + wr * 64 + fr; const int col0 = u.pn * BM + wc * 32 + 8 * fq;
#pragma unroll
        for (int ai = 0; ai < 2; ++ai) {
#pragma unroll
            for (int m = 0; m < 4; ++m) { const bf16_t* gp = G + (size_t)(row0 + ai * HALF + m * 16) * ldg + plane * 2048 + col0;
#pragma unroll
                for (int bj = 0; bj < 2; ++bj) { const u32x4 r = *(const u32x4*)(gp + bj * HALF);
                    acc[ai][bj][m][0] *= (f32x4){bf_lo(r.x), bf_hi(r.x), bf_lo(r.y), bf_hi(r.y)}; acc[ai][bj][m][1] *= (f32x4){bf_lo(r.z), bf_hi(r.z), bf_lo(r.w), bf_hi(r.w)}; } }
            asm volatile("" ::: "memory"); }
    }
    __device__ __forceinline__ void khook(f32x4 (&acc)[2][2][4][2], const Unit& u, int b, int wr, int wc, int fr, int fq) const { scale(acc, u, b - 1, wr, wc, fr, fq); }
    __device__ __forceinline__ void operator()(f32x4 (&acc)[2][2][4][2], const Unit& u, int wr, int wc, int fr, int fq) const {
        scale(acc, u, 3, wr, wc, fr, fq);
        const int row0 = u.pm * BM + wr * 64 + fr; const int col0 = u.pn * BM + wc * 32 + 8 * fq;
#pragma unroll
        for (int ai = 0; ai < 2; ++ai)
#pragma unroll
            for (int m = 0; m < 4; ++m) { const size_t r = (size_t)(row0 + ai * HALF + m * 16);
#pragma unroll
                for (int bj = 0; bj < 2; ++bj) { const f32x4 v0 = acc[ai][bj][m][0], v1 = acc[ai][bj][m][1];
                    u32x4 w; w.x = pk_bf16(v0[0], v0[1]); w.y = pk_bf16(v0[2], v0[3]); w.z = pk_bf16(v1[0], v1[1]); w.w = pk_bf16(v1[2], v1[3]);
                    *(u32x4*)(O + r * ldc + col0 + bj * HALF) = w; } }
    }
};

template <class Epi, class Sched, bool ALIGN_EPI = false, bool SP2 = false>
__device__ __forceinline__ void gemm_phase(PG8_LAS unsigned char* lds, const Gemm g, const Sched& S, const Epi& E, const int tid) {
    const int wid = __builtin_amdgcn_readfirstlane(tid >> 6), lane = tid & 63, wr = wid >> 2, wc = wid & 3, fr = lane & 15, fq = lane >> 4;
    const int K = g.K, nt = K / BK;
    unsigned voffA[2], voffB[2];
#pragma unroll
    for (int i = 0; i < 2; ++i) { int R, C; stage_rc(tid * 16 + i * 8192, R, C); const int Rb = Epi::PERM ? ((R & ~31) + perm32(R & 31)) : R;
        voffA[i] = (unsigned)(R * K + C) * 2u; voffB[i] = (unsigned)(Rb * K + C) * 2u; }
    const size_t kstep = (size_t)(BK * 2);
    const size_t hstep = (size_t)HALF * K * 2;
    const size_t tstep = 2 * hstep;
    const unsigned ldsw = (unsigned)wid * 1024u;
    const int aoff = lds_byte(wr * 64 + fr, fq * 8), boff = lds_byte(wc * 32 + fr, fq * 8);
#define PG8_SA(b, h) (((b) * 2 + (h)) * HTB)
#define PG8_SB(b, h) ((4 + (b) * 2 + (h)) * HTB)
#define PG8_STAGE(bufoff, gbase, voff) do { _Pragma("unroll") for (int _i = 0; _i < 2; ++_i) \
        __builtin_amdgcn_global_load_lds((const unsigned*)((const char*)(gbase) + (voff)[_i]), (PG8_LAS unsigned*)(lds + (bufoff) + ldsw + _i * 8192), 16, 0, 0); } while (0)
#define PG8_LDA(dst, b, h) do { _Pragma("unroll") for (int m = 0; m < 4; ++m) _Pragma("unroll") for (int k = 0; k < 2; ++k) dst[m][k] = *(const PG8_LAS bf16x8*)(lds + PG8_SA(b, h) + aoff + m * 2048 + k * 1024); } while (0)
#define PG8_LDB(dst, b, h) do { _Pragma("unroll") for (int n = 0; n < 2; ++n) _Pragma("unroll") for (int k = 0; k < 2; ++k) dst[n][k] = *(const PG8_LAS bf16x8*)(lds + PG8_SB(b, h) + boff + n * 2048 + k * 1024); } while (0)
#define PG8_MMA(ai, bj, At, Bt) do { __builtin_amdgcn_s_setprio(1); _Pragma("unroll") for (int m = 0; m < 4; ++m) _Pragma("unroll") for (int n = 0; n < 2; ++n) _Pragma("unroll") for (int k = 0; k < 2; ++k) \
        acc[ai][bj][m][n] = __builtin_amdgcn_mfma_f32_16x16x32_bf16(Bt[n][k], At[m][k], acc[ai][bj][m][n], 0, 0, 0); __builtin_amdgcn_s_setprio(0); } while (0)
#define PG8_WAIT_V(n) asm volatile("s_waitcnt vmcnt(" #n ")" ::: "memory")
#define PG8_WAIT_L(n) asm volatile("s_waitcnt lgkmcnt(" #n ")" ::: "memory")
#define PG8_BAR __builtin_amdgcn_s_barrier()
#define PG8_SCHED __builtin_amdgcn_sched_barrier(0)
    Unit cur, nxt; int ui = 0;
    if (!S.next(0, cur)) return;
    f32x4 acc[2][2][4][2];
#pragma unroll
    for (int a = 0; a < 2; ++a)
#pragma unroll
        for (int b = 0; b < 2; ++b)
#pragma unroll
            for (int m = 0; m < 4; ++m)
#pragma unroll
                for (int n = 0; n < 2; ++n) acc[a][b][m][n] = (f32x4){0.f, 0.f, 0.f, 0.f};
    bf16x8 At[4][2], B0[2][2], B1[2][2];
    const char* cA = (const char*)g.A + (size_t)cur.pm * tstep; const char* cB = (const char*)g.Bt + (size_t)cur.pn * tstep;
    S.a_ready(cur);
    if constexpr (SP2) {
        PG8_STAGE(PG8_SB(0, 0), cB, voffB); PG8_STAGE(PG8_SB(0, 1), cB + hstep, voffB); PG8_STAGE(PG8_SA(0, 0), cA, voffA); PG8_STAGE(PG8_SA(0, 1), cA + hstep, voffA);
        if (wr == 1) PG8_BAR;
        PG8_WAIT_V(2); PG8_BAR;
        PG8_STAGE(PG8_SB(1, 0), cB + kstep, voffB); PG8_STAGE(PG8_SA(1, 0), cA + kstep, voffA); PG8_STAGE(PG8_SB(1, 1), cB + hstep + kstep, voffB);
        PG8_WAIT_V(6); PG8_BAR;
    } else {
        PG8_STAGE(PG8_SB(0, 0), cB, voffB); PG8_STAGE(PG8_SA(0, 0), cA, voffA); PG8_STAGE(PG8_SB(0, 1), cB + hstep, voffB); PG8_STAGE(PG8_SA(0, 1), cA + hstep, voffA);
        if (wr == 1) PG8_BAR;
        PG8_WAIT_V(4); PG8_BAR;
        PG8_STAGE(PG8_SB(1, 0), cB + kstep, voffB); PG8_STAGE(PG8_SA(1, 0), cA + kstep, voffA); PG8_STAGE(PG8_SB(1, 1), cB + hstep + kstep, voffB);
        PG8_WAIT_V(6); PG8_BAR;
    }
    for (;;) {
        const bool has_next = S.next(ui + 1, nxt);
        const char* nA = has_next ? (const char*)g.A + (size_t)nxt.pm * tstep : cA; const char* nB = has_next ? (const char*)g.Bt + (size_t)nxt.pn * tstep : cB;
        for (int t = 0; t < nt; t += 2) {
            const bool last = (t == nt - 2);
            const char* a1 = cA + (size_t)(t + 1) * kstep;
            const char* a2 = last ? nA : cA + (size_t)(t + 2) * kstep; const char* b2 = last ? nB : cB + (size_t)(t + 2) * kstep;
            const char* a3 = a2 + kstep; const char* b3 = b2 + kstep;
            if (last && has_next) S.a_ready(nxt);
            if constexpr (Epi::KHOOK) { if (t != 0 && (t & 15) == 0) E.khook(acc, cur, t >> 4, wr, wc, fr, fq); }
            if constexpr (SP2) {
            PG8_LDB(B0, 0, 0); PG8_LDB(B1, 0, 1); PG8_SCHED; PG8_LDA(At, 0, 0); PG8_STAGE(PG8_SA(1, 1), a1 + hstep, voffA);
            PG8_WAIT_V(8); PG8_WAIT_L(0); PG8_BAR; PG8_MMA(0, 0, At, B0); PG8_MMA(0, 1, At, B1); PG8_BAR; PG8_SCHED;
            PG8_LDA(At, 0, 1); PG8_STAGE(PG8_SB(0, 0), b2, voffB); PG8_STAGE(PG8_SB(0, 1), b2 + hstep, voffB); PG8_STAGE(PG8_SA(0, 0), a2, voffA);
            PG8_WAIT_V(8); PG8_WAIT_L(0); PG8_BAR; PG8_MMA(1, 0, At, B0); PG8_MMA(1, 1, At, B1); PG8_BAR; PG8_SCHED;
            PG8_LDB(B0, 1, 0); PG8_LDB(B1, 1, 1); PG8_SCHED; PG8_LDA(At, 1, 0); PG8_STAGE(PG8_SA(0, 1), a2 + hstep, voffA);
            PG8_WAIT_V(8); PG8_WAIT_L(0); PG8_BAR; PG8_MMA(0, 0, At, B0); PG8_MMA(0, 1, At, B1); PG8_BAR; PG8_SCHED;
            PG8_LDA(At, 1, 1); PG8_STAGE(PG8_SB(1, 0), b3, voffB); PG8_STAGE(PG8_SB(1, 1), b3 + hstep, voffB); PG8_STAGE(PG8_SA(1, 0), a3, voffA);
            PG8_WAIT_V(8); PG8_WAIT_L(0); PG8_BAR; PG8_MMA(1, 0, At, B0); PG8_MMA(1, 1, At, B1); PG8_BAR; PG8_SCHED;
            } else {
            PG8_LDB(B0, 0, 0); PG8_SCHED; PG8_LDA(At, 0, 0); PG8_STAGE(PG8_SA(1, 1), a1 + hstep, voffA);
            PG8_WAIT_L(8); PG8_BAR; PG8_WAIT_L(0); PG8_MMA(0, 0, At, B0); PG8_BAR; PG8_SCHED;
            PG8_LDB(B1, 0, 1); PG8_STAGE(PG8_SB(0, 0), b2, voffB);
            PG8_BAR; PG8_WAIT_L(0); PG8_MMA(0, 1, At, B1); PG8_BAR;
            PG8_LDA(At, 0, 1); PG8_STAGE(PG8_SA(0, 0), a2, voffA);
            PG8_BAR; PG8_WAIT_L(0); PG8_MMA(1, 0, At, B0); PG8_BAR; PG8_SCHED;
            PG8_STAGE(PG8_SB(0, 1), b2 + hstep, voffB);
            PG8_WAIT_V(6); PG8_BAR; PG8_MMA(1, 1, At, B1); PG8_BAR;
            PG8_LDB(B0, 1, 0); PG8_SCHED; PG8_LDA(At, 1, 0); PG8_STAGE(PG8_SA(0, 1), a2 + hstep, voffA);
            PG8_WAIT_L(8); PG8_BAR; PG8_WAIT_L(0); PG8_MMA(0, 0, At, B0); PG8_BAR; PG8_SCHED;
            PG8_LDB(B1, 1, 1); PG8_STAGE(PG8_SB(1, 0), b3, voffB);
            PG8_BAR; PG8_WAIT_L(0); PG8_MMA(0, 1, At, B1); PG8_BAR;
            PG8_LDA(At, 1, 1); PG8_STAGE(PG8_SA(1, 0), a3, voffA);
            PG8_BAR; PG8_WAIT_L(0); PG8_MMA(1, 0, At, B0); PG8_BAR; PG8_SCHED;
            PG8_STAGE(PG8_SB(1, 1), b3 + hstep, voffB);
            PG8_WAIT_V(6); PG8_BAR; PG8_MMA(1, 1, At, B1); PG8_BAR;
            }
        }
        if constexpr (ALIGN_EPI) { if (wr == 0) PG8_BAR; }
        if constexpr (!Epi::AFTER_DRAIN) { E(acc, cur, wr, wc, fr, fq); S.done(cur); }
        if (!has_next) break;
#pragma unroll
        for (int a = 0; a < 2; ++a)
#pragma unroll
            for (int b = 0; b < 2; ++b)
#pragma unroll
                for (int m = 0; m < 4; ++m)
#pragma unroll
                    for (int n = 0; n < 2; ++n) acc[a][b][m][n] = (f32x4){0.f, 0.f, 0.f, 0.f};
        cur = nxt; cA = nA; cB = nB; ++ui;
        if constexpr (ALIGN_EPI) { if (wr == 1) PG8_BAR; }
    }
    PG8_WAIT_V(0);
    if constexpr (!ALIGN_EPI) { if (wr == 0) PG8_BAR; }
    PG8_BAR;
#undef PG8_SA
#undef PG8_SB
#undef PG8_STAGE
#undef PG8_LDA
#undef PG8_LDB
#undef PG8_MMA
#undef PG8_WAIT_V
#undef PG8_WAIT_L
#undef PG8_BAR
#undef PG8_SCHED
}
}

#define XB_TMO      128
#define XB_XCNT(j)  (256  + 64 * (j))
#define XB_XSUB(j)  (1280 + 64 * (j))
#define XB_XGEN(j)  (2304 + 64 * (j))
#define XB_TOP      3328
#define XB_TOPGEN   3392
#define XCD_BAR_WORDS 3456
#define XB_SPIN_CAP (1u << 18)

__device__ __forceinline__ unsigned xb_ld(unsigned* p)              { return __hip_atomic_load(p, __ATOMIC_RELAXED, __HIP_MEMORY_SCOPE_AGENT); }
__device__ __forceinline__ unsigned xb_add(unsigned* p, unsigned v) { return __hip_atomic_fetch_add(p, v, __ATOMIC_RELAXED, __HIP_MEMORY_SCOPE_AGENT); }
__device__ __forceinline__ unsigned xb_xcc_id() { return (unsigned)__builtin_amdgcn_s_getreg((3 << 11) | 20) & 0xFu; }
#define XB_SPIN(cond, bar) do { unsigned _sp = 0; while (cond) { __builtin_amdgcn_s_sleep(1); \
    if ((++_sp & 255u) == 0u) { if (xb_ld(&(bar)[XB_TMO])) break; if (_sp > XB_SPIN_CAP) { atomicAdd(&(bar)[XB_TMO], 1u); break; } } } } while (0)

struct XcdBarrier {
    unsigned* bar; unsigned x;
    volatile LAS unsigned* st;
    int wave;
};
__device__ __forceinline__ int lane_id() { int l; asm volatile("v_mbcnt_lo_u32_b32 %0, -1, 0\n\tv_mbcnt_hi_u32_b32 %0, -1, %0" : "=v"(l)); return l; }
__device__ __forceinline__ XcdBarrier xcd_barrier_post(unsigned* bar, volatile LAS unsigned* st, int wave) {
    XcdBarrier b; b.bar = bar; b.x = xb_xcc_id(); b.st = st; b.wave = wave;
    if (wave == 0 && lane_id() == 0) (void)xb_add(&bar[XB_XCNT(b.x)], 1u);
    return b;
}
__device__ __forceinline__ void xcd_barrier_complete(unsigned* bar, unsigned x, unsigned& nloc, unsigned& nx) {
    const unsigned G = gridDim.x * gridDim.y * gridDim.z;
    unsigned sum, cnt, mine, sp = 0u;
    for (;;) {
        sum = 0u; cnt = 0u; mine = 0u;
#pragma unroll
        for (unsigned j = 0; j < 16; ++j) { const unsigned c = xb_ld(&bar[XB_XCNT(j)]); sum += c; cnt += (c > 0u) ? 1u : 0u; mine = (j == x) ? c : mine; }
        if (sum == G) break;
        __builtin_amdgcn_s_sleep(1);
        if ((++sp & 255u) == 0u) { if (xb_ld(&bar[XB_TMO])) break; if (sp > XB_SPIN_CAP) { atomicAdd(&bar[XB_TMO], 1u); break; } }
    }
    nloc = mine > 0u ? mine : 1u; nx = cnt > 0u ? cnt : 1u;
}
__device__ __forceinline__ void xcd_barrier(const XcdBarrier& b) {
    asm volatile("s_waitcnt vmcnt(0)" ::: "memory");
    __syncthreads();
    if (b.wave == 0 && lane_id() == 0) {
        unsigned* bar = b.bar;
        __builtin_amdgcn_s_waitcnt(0);
        unsigned nloc = b.st[0], nx = b.st[1];
        if (nloc == 0u) { xcd_barrier_complete(bar, b.x, nloc, nx); b.st[0] = nloc; b.st[1] = nx; }
        const unsigned old = xb_add(&bar[XB_XSUB(b.x)], 1u);
        const unsigned gen = old / nloc;
        if (old + 1u == (gen + 1u) * nloc) {
            __builtin_amdgcn_fence(__ATOMIC_RELEASE, "agent");
            asm volatile("s_waitcnt vmcnt(0)" ::: "memory");
            const unsigned og = xb_add(&bar[XB_TOP], 1u);
            const unsigned tg = og / nx;
            if (og + 1u == (tg + 1u) * nx) xb_add(&bar[XB_TOPGEN], 1u);
            else XB_SPIN(xb_ld(&bar[XB_TOPGEN]) == tg, bar);
            __builtin_amdgcn_fence(__ATOMIC_ACQUIRE, "agent");
            xb_add(&bar[XB_XGEN(b.x)], 1u);
            asm volatile("s_waitcnt vmcnt(0)" ::: "memory");
        } else {
            XB_SPIN(xb_ld(&bar[XB_XGEN(b.x)]) == gen, bar);
            __builtin_amdgcn_fence(__ATOMIC_ACQUIRE, "agent");
            asm volatile("s_waitcnt vmcnt(0)" ::: "memory");
        }
    }
    __syncthreads();
}

constexpr int BATCH = 2, T = 4096, D = 2048, DEPTH = 4, M = BATCH * T;
constexpr int DIN = 20480, DFF = 8192, NH = 8, NCH = 32;
constexpr float EPS = 1e-6f;
constexpr int ZW = 18432;
constexpr int ZN_RQ = 0, ZN_RK = 1024, ZN_RV = 2048, ZN_RG = 3072, ZN_NQ = 4096, ZN_NK = 5120, ZN_NV = 6144, ZN_SB = 7168, ZN_P = 8192, ZN_U = 9216, ZN_R1 = 10240, ZN_G3 = 16384;
__host__ __device__ __forceinline__ int win_dest(int s) {
    if (s < 2048) { const int t = s & 255, bj = t >> 7, w = t & 127, n = w >> 6, dp = w & 63; return (s & ~255) + 128 * bj + 32 * (dp >> 4) + 8 * ((dp >> 2) & 3) + 4 * n + (dp & 3); }
    if (s < 8192) return s;
    if (s < 12288) { const int base = s < 10240 ? 8192 : 10240; const int n = (s - base) >> 10, didx = (s - base) & 1023, dd = didx & 127; const int pnb = base / 256 + (didx >> 7);
        return 256 * pnb + 128 * (dd >> 6) + 32 * ((dd >> 4) & 3) + 8 * ((dd >> 2) & 3) + 4 * n + (dd & 3); }
    const int b = (s - 12288) >> 11, d = (s - 12288) & 2047, dd = d & 63;
    return 256 * (48 + (d >> 6)) + 128 * (b >> 1) + 32 * (dd >> 4) + 8 * ((dd >> 2) & 3) + 4 * (b & 1) + (dd & 3);
}
constexpr int YC_RET = 0, YC_NA = 1024, YC_SC = 2048, YC_CF = 3072, YCW = 4096;
constexpr int MODW = 6 * D;

constexpr size_t MiB = (size_t)1 << 20;
constexpr size_t WS_CTL = 0, CTL_ZERO_BYTES = 1 * MiB;
constexpr size_t WS_MOD = 1 * MiB;
constexpr size_t WS_ROPE = 2 * MiB;
constexpr size_t WS_WIN = 4 * MiB;
constexpr size_t WS_WCAT = 324 * MiB;
constexpr size_t WS_WO = 388 * MiB;
constexpr size_t WS_W1 = 420 * MiB;
constexpr size_t WS_W2 = 548 * MiB;
constexpr size_t WS_H = 676 * MiB;
constexpr size_t WS_Z = 708 * MiB;
constexpr size_t WS_LST = 1028 * MiB;
constexpr size_t WS_SST = 1092 * MiB;
constexpr size_t WS_YCAT = 1124 * MiB;
constexpr size_t WS_MERGED = 1188 * MiB;
constexpr size_t WS_Y = 1220 * MiB;
constexpr size_t WS_U = 1284 * MiB;
constexpr size_t WS_END = 1412 * MiB;
constexpr int CW_BAR = 4096;

constexpr int RING_BYTES = 131072;
constexpr int LDSCTL_OFF = RING_BYTES, MISC_OFF = LDSCTL_OFF + 320;
constexpr int LDS_BYTES = 147456;

constexpr int N_PHASES = 2 + 10 * DEPTH;

struct EpiZ {
    static constexpr bool PERM = true, AFTER_DRAIN = false, KHOOK = false;
    bf16* O; const f32x2* rope;
    __device__ __forceinline__ void khook(f32x4 (&)[2][2][4][2], const pg8::Unit&, int, int, int, int, int) const {}
    __device__ __forceinline__ void operator()(const f32x4 (&acc)[2][2][4][2], const pg8::Unit& u, int wr, int wc, int fr, int fq) const {
        const int row0 = u.pm * 256 + wr * 64 + fr, pn = u.pn;
        if (pn < 8) {
            const float sc = pn >= 4 ? 0.08838834764831845f : 1.0f;
#pragma unroll
            for (int ai = 0; ai < 2; ++ai)
#pragma unroll
                for (int m = 0; m < 4; ++m) { const int row = row0 + ai * 128 + m * 16;
                    const f32x4* cs = (const f32x4*)(rope + (size_t)(row & 4095) * 64 + 16 * wc + 4 * fq); const f32x4 c0 = cs[0], c1 = cs[1];
                    const float cosv[4] = {c0.x, c0.z, c1.x, c1.z}, sinv[4] = {c0.y, c0.w, c1.y, c1.w};
#pragma unroll
                    for (int bj = 0; bj < 2; ++bj) { const f32x4 x1 = acc[ai][bj][m][0], x2 = acc[ai][bj][m][1]; float o1[4], o2[4];
#pragma unroll
                        for (int j = 0; j < 4; ++j) { o1[j] = (x1[j] * cosv[j] - x2[j] * sinv[j]) * sc; o2[j] = (x1[j] * sinv[j] + x2[j] * cosv[j]) * sc; }
                        bf16* op = O + (size_t)row * ZW + pn * 256 + bj * 128 + 16 * wc + 4 * fq;
                        u32x2 w1, w2; w1.x = pk_bf16(o1[0], o1[1]); w1.y = pk_bf16(o1[2], o1[3]); w2.x = pk_bf16(o2[0], o2[1]); w2.y = pk_bf16(o2[2], o2[3]);
                        *(u32x2*)op = w1; *(u32x2*)(op + 64) = w2; } }
        } else if (pn < 32) {
            const int mode = (pn >= 12 && pn < 16) ? 1 : ((pn >= 16 && pn < 20) ? 2 : 0);
#pragma unroll
            for (int ai = 0; ai < 2; ++ai)
#pragma unroll
                for (int m = 0; m < 4; ++m) { bf16* rowp = O + (size_t)(row0 + ai * 128 + m * 16) * ZW + pn * 256 + wc * 32 + 8 * fq;
#pragma unroll
                    for (int bj = 0; bj < 2; ++bj) { f32x4 v0 = acc[ai][bj][m][0], v1 = acc[ai][bj][m][1];
                        if (mode == 1) {
#pragma unroll
                            for (int j = 0; j < 4; ++j) { v0[j] *= fsigmoid(v0[j]); v1[j] *= fsigmoid(v1[j]); } }
                        if (mode == 2) { v0 = v0 * 0.08838834764831845f; v1 = v1 * 0.08838834764831845f; }
                        u32x4 w; w.x = pk_bf16(v0[0], v0[1]); w.y = pk_bf16(v0[2], v0[3]); w.z = pk_bf16(v1[0], v1[1]); w.w = pk_bf16(v1[2], v1[3]);
                        *(u32x4*)(rowp + bj * 128) = w; } }
        } else if (pn < 48) {
            const bool glu = pn >= 40; const int cb = (glu ? ZN_U + 128 * (pn - 40) : ZN_P + 128 * (pn - 32)) + 16 * wc + 4 * fq;
#pragma unroll
            for (int ai = 0; ai < 2; ++ai)
#pragma unroll
                for (int m = 0; m < 4; ++m) { bf16* rowp = O + (size_t)(row0 + ai * 128 + m * 16) * ZW + cb;
#pragma unroll
                    for (int bj = 0; bj < 2; ++bj) { const f32x4 v0 = acc[ai][bj][m][0], v1 = acc[ai][bj][m][1]; float o[4];
#pragma unroll
                        for (int j = 0; j < 4; ++j) o[j] = v0[j] * (glu ? fsigmoid(v1[j]) : v1[j]);
                        u32x2 w; w.x = pk_bf16(o[0], o[1]); w.y = pk_bf16(o[2], o[3]); *(u32x2*)(rowp + 64 * bj) = w; } }
        } else {
            const int d0 = 64 * (pn - 48) + 16 * wc + 4 * fq;
#pragma unroll
            for (int ai = 0; ai < 2; ++ai)
#pragma unroll
                for (int m = 0; m < 4; ++m) { bf16* rowp = O + (size_t)(row0 + ai * 128 + m * 16) * ZW + ZN_R1 + d0; float r1[4], r2[4], r3[4], g3[4];
#pragma unroll
                    for (int j = 0; j < 4; ++j) { const float a0 = fmaxf(fsigmoid(acc[ai][0][m][0][j]), 1e-20f), a1 = fmaxf(fsigmoid(acc[ai][0][m][1][j]), 1e-20f),
                                                              a2 = fmaxf(fsigmoid(acc[ai][1][m][0][j]), 1e-20f), a3 = fmaxf(fsigmoid(acc[ai][1][m][1][j]), 1e-20f);
                        r1[j] = a0 * __builtin_amdgcn_rcpf(a1); r2[j] = a1 * __builtin_amdgcn_rcpf(a2); r3[j] = a2 * __builtin_amdgcn_rcpf(a3); g3[j] = a3; }
                    u32x2 w; w.x = pk_bf16(r1[0], r1[1]); w.y = pk_bf16(r1[2], r1[3]); *(u32x2*)(rowp) = w;
                    w.x = pk_bf16(r2[0], r2[1]); w.y = pk_bf16(r2[2], r2[3]); *(u32x2*)(rowp + 2048) = w;
                    w.x = pk_bf16(r3[0], r3[1]); w.y = pk_bf16(r3[2], r3[3]); *(u32x2*)(rowp + 4096) = w;
                    w.x = pk_bf16(g3[0], g3[1]); w.y = pk_bf16(g3[2], g3[3]); *(u32x2*)(rowp + 6144) = w; }
        }
    }
};

struct Args { const float* in[23]; float* out; unsigned char* ws; int ph_lo, ph_hi; };

template <bool MAPWIN = false>
__device__ __forceinline__ void transpose_item(const float* W, int N, bf16* WT, int ldk, int koff, LAS float* scr, int kb, int nb, int lane) {
    const int k0 = 64 * kb, n0 = 32 * nb;
    { f32x4 v[8];
#pragma unroll
      for (int i = 0; i < 8; ++i) v[i] = __builtin_nontemporal_load((const f32x4*)(W + (size_t)(k0 + 8 * i + (lane >> 3)) * N + n0 + 4 * (lane & 7)));
#pragma unroll
      for (int i = 0; i < 8; ++i) { LAS float* d = scr + (8 * i + (lane >> 3)) * 33 + 4 * (lane & 7); d[0] = v[i].x; d[1] = v[i].y; d[2] = v[i].z; d[3] = v[i].w; } }
    LDS_WAIT(); asm volatile("" ::: "memory");
    const int c = lane & 7;
#pragma unroll
    for (int j = 0; j < 4; ++j) { const int n = (lane >> 3) + 8 * j; const LAS float* s = scr + (8 * c) * 33 + n;
        u32x4 o; o.x = pk_bf16(s[0 * 33], s[1 * 33]); o.y = pk_bf16(s[2 * 33], s[3 * 33]); o.z = pk_bf16(s[4 * 33], s[5 * 33]); o.w = pk_bf16(s[6 * 33], s[7 * 33]);
        const int nd = MAPWIN ? win_dest(n0 + n) : n0 + n;
        *(u32x4*)(WT + (size_t)nd * ldk + koff + k0 + 8 * c) = o; }
    LDS_WAIT(); asm volatile("" ::: "memory");
}

__device__ __forceinline__ void phase_prologue(const Args& a, LAS unsigned char* lds, int tid, int lane, int wave, int bid, int G) {
    unsigned char* ws = a.ws;
    const int NGB = (G >= 64) ? (G * 3) / 16 : 0;
    if (bid >= NGB) {
        LAS float* scr = (LAS float*)(lds + wave * 16384);
        const int gw = (bid - NGB) * 8 + wave, NGW = (G - NGB) * 8;
        constexpr int I_IN = 32 * 640, I_BR = 16 * 64, I_O = 32 * 64, I_1 = 32 * 256, I_2 = 128 * 64, I_L = I_IN + 4 * I_BR + I_O + I_1 + I_2;
        for (int it = gw; it < DEPTH * I_L; it += NGW) {
            const int l = it / I_L; int r = it - l * I_L;
            if (r < I_IN) { transpose_item<true>(a.in[8] + (size_t)l * D * DIN, DIN, (bf16*)(ws + WS_WIN) + (size_t)l * DIN * D, D, 0, scr, r / 640, r % 640, lane); continue; } r -= I_IN;
            if (r < 4 * I_BR) { const int br = r / I_BR, rr = r % I_BR;
                transpose_item(a.in[16 + br] + (size_t)l * 1024 * D, D, (bf16*)(ws + WS_WCAT) + (size_t)l * D * YCW, YCW, 1024 * br, scr, rr / 64, rr % 64, lane); continue; } r -= 4 * I_BR;
            if (r < I_O) { transpose_item(a.in[20] + (size_t)l * D * D, D, (bf16*)(ws + WS_WO) + (size_t)l * D * D, D, 0, scr, r / 64, r % 64, lane); continue; } r -= I_O;
            if (r < I_1) { transpose_item(a.in[21] + (size_t)l * D * DFF, DFF, (bf16*)(ws + WS_W1) + (size_t)l * DFF * D, D, 0, scr, r / 256, r % 256, lane); continue; } r -= I_1;
            transpose_item(a.in[22] + (size_t)l * DFF * D, D, (bf16*)(ws + WS_W2) + (size_t)l * D * DFF, DFF, 0, scr, r / 64, r % 64, lane);
        }
    }
    if (bid < NGB || NGB == 0) {
        if (NGB == 0) __syncthreads();
        LAS float* cact = (LAS float*)lds;
        LAS float* red = (LAS float*)(lds + 16384);
        const float* c = a.in[1];
        for (int i = tid; i < 2 * D; i += 512) { const float v = c[i]; cact[i] = v * fsigmoid(v); }
        __syncthreads();
        const int nb = NGB ? NGB : G;
        for (int it = bid; it < DEPTH * 48; it += nb) {
            const int l = it / 48, cb = it % 48;
            const float* W = a.in[2] + (size_t)l * D * MODW + cb * 256 + 4 * lane;
            f32x4 a0 = {0.f, 0.f, 0.f, 0.f}, a1 = {0.f, 0.f, 0.f, 0.f};
            const int kb = wave * 256;
#pragma unroll 8
            for (int k = 0; k < 256; ++k) { const f32x4 w = __builtin_nontemporal_load((const f32x4*)(W + (size_t)(kb + k) * MODW)); a0 += w * cact[kb + k]; a1 += w * cact[D + kb + k]; }
            *(LAS f32x4*)(red + (wave * 2 + 0) * 256 + 4 * lane) = a0;
            *(LAS f32x4*)(red + (wave * 2 + 1) * 256 + 4 * lane) = a1;
            __syncthreads();
            { const int b = tid >> 8, col = tid & 255; float s = a.in[3][(size_t)l * MODW + cb * 256 + col];
#pragma unroll
              for (int w = 0; w < 8; ++w) s += red[(w * 2 + b) * 256 + col];
              ((float*)(ws + WS_MOD))[((size_t)l * 2 + b) * MODW + cb * 256 + col] = s; }
            __syncthreads();
        }
    }
    {
        f32x2* tab = (f32x2*)(ws + WS_ROPE);
        for (int e = bid * 512 + tid; e < T * 64; e += G * 512) {
            const int pos = e >> 6, i = e & 63;
            double inv = 1.0; const double rr = 0.8659643233600653;
            for (int k = 0; k < i; ++k) inv *= rr;
            const double ang = (double)pos * inv;
            const double n = __builtin_rint(ang * 0.6366197723675814);
            double r = __builtin_fma(-n, 1.5707963267948966, ang); r = __builtin_fma(-n, 6.123233995736766e-17, r);
            const double r2 = r * r;
            const double sn = r * (1.0 + r2 * (-1.0 / 6 + r2 * (1.0 / 120 + r2 * (-1.0 / 5040 + r2 * (1.0 / 362880 + r2 * (-1.0 / 39916800 + r2 * (1.0 / 6227020800.0)))))));
            const double cs = 1.0 + r2 * (-0.5 + r2 * (1.0 / 24 + r2 * (-1.0 / 720 + r2 * (1.0 / 40320 + r2 * (-1.0 / 3628800 + r2 * (1.0 / 479001600 + r2 * (-1.0 / 87178291200.0)))))));
            const int q = (int)((long long)n & 3);
            double co, si;
            if (q == 0) { co = cs; si = sn; } else if (q == 1) { co = -sn; si = cs; } else if (q == 2) { co = -cs; si = -sn; } else { co = sn; si = -cs; }
            tab[e] = (f32x2){(float)co, (float)si};
        }
    }
}

__device__ __forceinline__ void norm_rows(const float* xsrc, float* xdst, const bf16* y, const float* ga  , const float* gpost,
                                          bool do_h, const float* sc, const float* sh, const float* gpre, bf16* hout, int gw, int NGW, int lane) {
    for (int row = gw; row < M; row += NGW) {
        const int b = row >> 12;
        const f32x4* xr = (const f32x4*)(xsrc + (size_t)row * D) + lane;
        f32x4 xv[8];
#pragma unroll
        for (int j = 0; j < 8; ++j) xv[j] = xr[64 * j];
        if (y) {
            const u32x2* yr = (const u32x2*)(y + (size_t)row * D) + lane;
            f32x4 yv[8]; float ss = 0.f;
#pragma unroll
            for (int j = 0; j < 8; ++j) { const u32x2 w = yr[64 * j]; yv[j] = (f32x4){bf_lo(w.x), bf_hi(w.x), bf_lo(w.y), bf_hi(w.y)};
                ss += (yv[j].x * yv[j].x + yv[j].y * yv[j].y) + (yv[j].z * yv[j].z + yv[j].w * yv[j].w); }
            ss = wave_sum(ss);
            const float r = 1.0f / sqrtf(ss * (1.0f / D) + EPS);
            const f32x4* gar = (const f32x4*)(ga + (size_t)b * MODW) + lane; const f32x4* gp = (const f32x4*)gpost + lane;
#pragma unroll
            for (int j = 0; j < 8; ++j) xv[j] += gar[64 * j] * ((yv[j] * r) * gp[64 * j]);
        }
        f32x4* xw = (f32x4*)(xdst + (size_t)row * D) + lane;
#pragma unroll
        for (int j = 0; j < 8; ++j) xw[64 * j] = xv[j];
        if (do_h) {
            float ss = 0.f;
#pragma unroll
            for (int j = 0; j < 8; ++j) ss += (xv[j].x * xv[j].x + xv[j].y * xv[j].y) + (xv[j].z * xv[j].z + xv[j].w * xv[j].w);
            ss = wave_sum(ss);
            const float r = 1.0f / sqrtf(ss * (1.0f / D) + EPS);
            const f32x4* scr = (const f32x4*)(sc + (size_t)b * MODW) + lane; const f32x4* shr = (const f32x4*)(sh + (size_t)b * MODW) + lane; const f32x4* gp = (const f32x4*)gpre + lane;
            u32x2* ho = (u32x2*)(hout + (size_t)row * D) + lane;
#pragma unroll
            for (int j = 0; j < 8; ++j) { const f32x4 hv = ((xv[j] * r) * gp[64 * j]) * (scr[64 * j] + 1.0f) + shr[64 * j];
                u32x2 w; w.x = pk_bf16(hv.x, hv.y); w.y = pk_bf16(hv.z, hv.w); ho[64 * j] = w; }
        }
    }
}

constexpr int CT = 16;
__device__ __forceinline__ void conv_units(const bf16* Z, bf16* YC, const float* scw, const float* cfw, const float* cfg, const float* cfb,
                                           LAS unsigned char* lds, int tid, int lane, int wave, int bid, int G) {
    const unsigned c00 = 2u * (unsigned)tid;
    LAS unsigned char* U = lds;
    LAS float* red = (LAS float*)(lds + (CT + 30) * 2048);
    LAS float* tot = red + 8 * 2 * CT;
    for (int u = bid; u < M / CT; u += G) {
        const int row0 = CT * u, b = row0 >> 12, ts = row0 & 4095;
        unsigned c0 = c00; asm volatile("" : "+v"(c0));
        const bf16* Zb = Z + (size_t)b * T * ZW;
        for (int it0 = tid; it0 < (CT + 30) * 128; it0 += 4 * 512) {
            u32x4 uv[4];
#pragma unroll
            for (int q = 0; q < 4; ++q) { const int it = it0 + 512 * q, row = it >> 7, ch = it & 127, tok = ts - 15 + row;
                uv[q] = (u32x4){0u, 0u, 0u, 0u};
                if ((it < (CT + 30) * 128) && tok >= 0 && tok < T) uv[q] = *(const u32x4*)(Zb + (size_t)tok * ZW + ZN_U + 8 * ch); }
#pragma unroll
            for (int q = 0; q < 4; ++q) { const int it = it0 + 512 * q, row = it >> 7, ch = it & 127;
                if (it < (CT + 30) * 128) *(LAS u32x4*)(U + row * 2048 + ch * 16) = uv[q]; }
        }
        __syncthreads();
        float w[31][2];
#pragma unroll
        for (int k = 0; k < 31; ++k) { const f32x2 t = *(const f32x2*)((cfw + k * 1024) + c0); w[k][0] = t.x; w[k][1] = t.y; }
        float acc[CT][2];
#pragma unroll
        for (int t = 0; t < CT; ++t) { acc[t][0] = 0.f; acc[t][1] = 0.f; }
#pragma unroll
        for (int j = 0; j < CT + 30; ++j) {
            const unsigned uv = *(const LAS unsigned*)(U + (j * 2048u + c0 * 2u));
            const float u0 = bf_lo(uv), u1 = bf_hi(uv);
#pragma unroll
            for (int t = 0; t < CT; ++t) { const int k = j - t; if (k >= 0 && k <= 30) { acc[t][0] += w[k][0] * u0; acc[t][1] += w[k][1] * u1; } }
            if ((j & 7) == 7) asm volatile("" ::: "memory");
        }
        const f32x2 lg = *(const f32x2*)(cfg + c0), lb = *(const f32x2*)(cfb + c0);
        float st[2 * CT];
#pragma unroll
        for (int t = 0; t < CT; ++t) { st[t] = wave_sum(acc[t][0] + acc[t][1]); st[CT + t] = wave_sum(acc[t][0] * acc[t][0] + acc[t][1] * acc[t][1]); }
        if (lane == 0) {
#pragma unroll
            for (int i = 0; i < 2 * CT; ++i) red[wave * 2 * CT + i] = st[i]; }
        __syncthreads();
        if (tid < 2 * CT) { float s = 0.f;
#pragma unroll
            for (int wv = 0; wv < 8; ++wv) s += red[wv * 2 * CT + tid];
            tot[tid] = s; }
        __syncthreads();
#pragma unroll
        for (int t = 0; t < CT; ++t) {
            const float mu = tot[t] * (1.0f / 1024), var = fmaxf(tot[CT + t] * (1.0f / 1024) - mu * mu, 0.f), rs = 1.0f / sqrtf(var + EPS);
            float y0 = (acc[t][0] - mu) * rs * lg.x + lb.x, y1 = (acc[t][1] - mu) * rs * lg.y + lb.y;
            y0 *= fsigmoid(y0); y1 *= fsigmoid(y1);
            *(unsigned*)(YC + (size_t)(row0 + t) * YCW + YC_CF + c0) = pk_bf16(y0, y1);
        }
        LAS float* P = (LAS float*)U;
        for (int it0 = tid; it0 < (CT + 2) * 128; it0 += 5 * 512) {
            u32x4 pv[5];
#pragma unroll
            for (int q = 0; q < 5; ++q) { const int it = it0 + 512 * q, row = it >> 7, ch = it & 127, tok = ts - 1 + row;
                pv[q] = (u32x4){0u, 0u, 0u, 0u};
                if ((it < (CT + 2) * 128) && tok >= 0 && tok < T) pv[q] = *(const u32x4*)(Zb + (size_t)tok * ZW + ZN_P + 8 * ch); }
#pragma unroll
            for (int q = 0; q < 5; ++q) { const int it = it0 + 512 * q, row = it >> 7, ch = it & 127;
                if (it < (CT + 2) * 128) {
                    *(LAS f32x4*)(P + row * 1024 + ch * 8) = (f32x4){bf_lo(pv[q].x), bf_hi(pv[q].x), bf_lo(pv[q].y), bf_hi(pv[q].y)};
                    *(LAS f32x4*)(P + row * 1024 + ch * 8 + 4) = (f32x4){bf_lo(pv[q].z), bf_hi(pv[q].z), bf_lo(pv[q].w), bf_hi(pv[q].w)}; } }
        }
        __syncthreads();
        {
            float w3[3][2];
#pragma unroll
            for (int k = 0; k < 3; ++k) { const f32x2 t = *(const f32x2*)((scw + k * 1024) + c0); w3[k][0] = t.x; w3[k][1] = t.y; }
            f32x2 pa = *(const LAS f32x2*)(P + 0 * 1024 + c0), pb = *(const LAS f32x2*)(P + 1 * 1024 + c0);
            for (int t = 0; t < CT; ++t) {
                const f32x2 pc = *(const LAS f32x2*)(P + (t + 2) * 1024 + c0);
                const unsigned sb2 = *(const unsigned*)(Zb + (size_t)(ts + t) * ZW + ZN_SB + c0);
                const float o0 = w3[0][0] * pa.x + w3[1][0] * pb.x + w3[2][0] * pc.x;
                const float o1 = w3[0][1] * pa.y + w3[1][1] * pb.y + w3[2][1] * pc.y;
                *(unsigned*)(YC + (size_t)(row0 + t) * YCW + YC_SC + c0) = pk_bf16(bf_lo(sb2) * o0, bf_hi(sb2) * o1);
                pa = pb; pb = pc;
            }
        }
        __syncthreads();
    }
}

__device__ __forceinline__ float log2_sigmoid(float x) { return -log1pf(expf(-x)) * 1.4426950408889634f; }
constexpr int RP = 136 * 2;

__device__ __forceinline__ void ret_local_units(const bf16* Z, const f32x2* rope, const float* dec_f, const float* dec_b, float* LST,
                                                LAS unsigned char* lds, int tid, int lane, int wave, int bid, int G) {
    LAS unsigned char* Ktf = lds; LAS unsigned char* Ktb = lds + 128 * RP; LAS unsigned char* Vt = lds + 2 * 128 * RP;
    const int fr = lane & 15, g = lane >> 4;
    for (int u = bid; u < 16 * NCH; u += G) {
        const int chunk = u & 31, bh = u >> 5, b = bh >> 3, h = bh & 7;
        const float lf2 = log2_sigmoid(dec_f[h]), lb2 = log2_sigmoid(dec_b[h]);
        const size_t rowb = (size_t)b * T + chunk * 128;
#pragma unroll
        for (int rep = 0; rep < 4; ++rep) {
            const int it = tid + 512 * rep, j = it & 127, c = it >> 7;
            const u32x4 kv = *(const u32x4*)(Z + (rowb + j) * ZW + ZN_RK + h * 128 + 8 * c);
            const unsigned kw[4] = {kv.x, kv.y, kv.z, kv.w};
            const float df = exp2f(lf2 * (float)(127 - j)), db = exp2f(lb2 * (float)j);
#pragma unroll
            for (int e = 0; e < 8; ++e) {
                const float x = (e & 1) ? bf_hi(kw[e >> 1]) : bf_lo(kw[e >> 1]);
                const unsigned pf = pk_bf16(x * df, x * db);
                *(LAS bf16*)(Ktf + (8 * c + e) * RP + 2 * j) = (bf16)(pf & 0xffffu); *(LAS bf16*)(Ktb + (8 * c + e) * RP + 2 * j) = (bf16)(pf >> 16);
            }
        }
#pragma unroll
        for (int rep = 0; rep < 4; ++rep) {
            const int it = tid + 512 * rep, j = it & 127, c = it >> 7;
            const u32x4 v = *(const u32x4*)(Z + (rowb + j) * ZW + ZN_RV + h * 128 + 8 * c);
            const unsigned vw[4] = {v.x, v.y, v.z, v.w};
#pragma unroll
            for (int e = 0; e < 8; ++e) *(LAS bf16*)(Vt + (8 * c + e) * RP + 2 * j) = (bf16)((e & 1) ? (vw[e >> 1] >> 16) : (vw[e >> 1] & 0xffffu));
        }
        __syncthreads();
        f32x4 acc[2][8];
#pragma unroll
        for (int d = 0; d < 2; ++d)
#pragma unroll
            for (int i = 0; i < 8; ++i) acc[d][i] = (f32x4){0.f, 0.f, 0.f, 0.f};
#pragma unroll
        for (int ks = 0; ks < 4; ++ks) {
            const bf16x8 bv = *(const LAS bf16x8*)(Vt + (16 * wave + fr) * RP + (32 * ks + 8 * g) * 2);
#pragma unroll
            for (int i = 0; i < 8; ++i) {
                const bf16x8 af = *(const LAS bf16x8*)(Ktf + (16 * i + fr) * RP + (32 * ks + 8 * g) * 2);
                const bf16x8 ab = *(const LAS bf16x8*)(Ktb + (16 * i + fr) * RP + (32 * ks + 8 * g) * 2);
                acc[0][i] = MFMA16(af, bv, acc[0][i]); acc[1][i] = MFMA16(ab, bv, acc[1][i]);
            }
        }
#pragma unroll
        for (int d = 0; d < 2; ++d) { float* Lb = LST + ((size_t)((d * 16 + bh) * NCH + chunk)) * 16384 + (size_t)(16 * wave + fr) * 128 + 4 * g;
#pragma unroll
            for (int i = 0; i < 8; ++i) *(f32x4*)(Lb + 16 * i) = acc[d][i]; }
        __syncthreads();
    }
}

__device__ __forceinline__ void ret_scan(const float* LST, bf16* SST, const float* dec_f, const float* dec_b, int tid, int bid, int G) {
    for (int e = bid * 512 + tid; e < 2 * 16 * 4096; e += G * 512) {
        const int dir = e >> 16, rem = e & 65535, bh = rem >> 12, q4 = rem & 4095, h = bh & 7;
        const float dec = exp2f(log2_sigmoid(dir ? dec_b[h] : dec_f[h]) * 128.0f);
        const size_t base = (size_t)((dir * 16 + bh) * NCH) * 16384 + 4 * (size_t)q4;
        f32x4 s = {0.f, 0.f, 0.f, 0.f};
        if (dir == 0) {
#pragma unroll 8
            for (int i = 0; i < NCH; ++i) { u32x2 w; w.x = pk_bf16(s.x, s.y); w.y = pk_bf16(s.z, s.w); *(u32x2*)(SST + base + (size_t)i * 16384) = w;
                s = *(const f32x4*)(LST + base + (size_t)i * 16384) + s * dec; }
        } else {
#pragma unroll 8
            for (int i = NCH - 1; i >= 0; --i) { u32x2 w; w.x = pk_bf16(s.x, s.y); w.y = pk_bf16(s.z, s.w); *(u32x2*)(SST + base + (size_t)i * 16384) = w;
                s = *(const f32x4*)(LST + base + (size_t)i * 16384) + s * dec; }
        }
    }
}

__device__ __forceinline__ void ret_out_units(const bf16* Z, const f32x2* rope, const float* dec_f, const float* dec_b, const bf16* SST, bf16* YC,
                                              LAS unsigned char* lds, int tid, int lane, int wave, int bid, int G) {
    LAS unsigned char* Kl = lds; LAS unsigned char* Vt = lds + 128 * RP; LAS unsigned char* Pl = lds + 2 * 128 * RP + wave * 16 * RP;
    const int fr = lane & 15, g = lane >> 4;
    for (int u = bid; u < 16 * NCH; u += G) {
        const int chunk = u & 31, bh = u >> 5, b = bh >> 3, h = bh & 7;
        const float lf2 = log2_sigmoid(dec_f[h]), lb2 = log2_sigmoid(dec_b[h]);
        const size_t rowb = (size_t)b * T + chunk * 128;
#pragma unroll
        for (int rep = 0; rep < 4; ++rep) {
            const int it = tid + 512 * rep, j = it >> 4, c = it & 15;
            *(LAS u32x4*)(Kl + j * RP + 16 * c) = *(const u32x4*)(Z + (rowb + j) * ZW + ZN_RK + h * 128 + 8 * c);
        }
#pragma unroll
        for (int rep = 0; rep < 4; ++rep) {
            const int it = tid + 512 * rep, j = it & 127, c = it >> 7;
            const u32x4 v = *(const u32x4*)(Z + (rowb + j) * ZW + ZN_RV + h * 128 + 8 * c);
            const unsigned vw[4] = {v.x, v.y, v.z, v.w};
#pragma unroll
            for (int e = 0; e < 8; ++e) *(LAS bf16*)(Vt + (8 * c + e) * RP + 2 * j) = (bf16)((e & 1) ? (vw[e >> 1] >> 16) : (vw[e >> 1] & 0xffffu));
        }
        const int q = 16 * wave + fr;
        bf16x8 qf[4];
#pragma unroll
        for (int ks = 0; ks < 4; ++ks) qf[ks] = *(const bf16x8*)(Z + (rowb + q) * ZW + ZN_RQ + h * 128 + 32 * ks + 8 * g);
        __syncthreads();
#pragma unroll
        for (int kt = 0; kt < 8; ++kt) {
            f32x4 s = {0.f, 0.f, 0.f, 0.f};
#pragma unroll
            for (int ks = 0; ks < 4; ++ks) { const bf16x8 a = *(const LAS bf16x8*)(Kl + (16 * kt + fr) * RP + (32 * ks + 8 * g) * 2); s = MFMA16(a, qf[ks], s); }
            float pv[4];
#pragma unroll
            for (int r = 0; r < 4; ++r) { const int m = 16 * kt + 4 * g + r, diff = q - m;
                const float dc = diff >= 0 ? exp2f(lf2 * (float)diff) : exp2f(lb2 * (float)(-diff)); pv[r] = s[r] * dc; }
            u32x2 w; w.x = pk_bf16(pv[0], pv[1]); w.y = pk_bf16(pv[2], pv[3]);
            *(LAS u32x2*)(Pl + fr * RP + (16 * kt + 4 * g) * 2) = w;
        }
        LDS_WAIT();
        f32x4 o[8];
#pragma unroll
        for (int i = 0; i < 8; ++i) o[i] = (f32x4){0.f, 0.f, 0.f, 0.f};
#pragma unroll
        for (int ks = 0; ks < 4; ++ks) {
            const bf16x8 pb = *(const LAS bf16x8*)(Pl + fr * RP + (32 * ks + 8 * g) * 2);
#pragma unroll
            for (int i = 0; i < 8; ++i) { const bf16x8 a = *(const LAS bf16x8*)(Vt + (16 * i + fr) * RP + (32 * ks + 8 * g) * 2); o[i] = MFMA16(a, pb, o[i]); }
        }
#pragma unroll
        for (int d = 0; d < 2; ++d) {
            const float qd = d == 0 ? exp2f(lf2 * (float)(q + 1)) : exp2f(lb2 * (float)(128 - q));
            const bf16* Sb = SST + ((size_t)((d * 16 + bh) * NCH + chunk)) * 16384 + (size_t)fr * 128 + 8 * g;
#pragma unroll
            for (int i = 0; i < 8; ++i) {
                f32x4 c = {0.f, 0.f, 0.f, 0.f};
#pragma unroll
                for (int ks = 0; ks < 4; ++ks) { const bf16x8 a = *(const bf16x8*)(Sb + (size_t)(16 * i) * 128 + 32 * ks); c = MFMA16(a, qf[ks], c); }
                o[i] += c * qd;
            }
        }
        float s1 = 0.f;
#pragma unroll
        for (int i = 0; i < 8; ++i) s1 += (o[i].x + o[i].y) + (o[i].z + o[i].w);
        s1 += __shfl_xor(s1, 16); s1 += __shfl_xor(s1, 32);
        const float mu = s1 * (1.0f / 128);
        float s2 = 0.f;
#pragma unroll
        for (int i = 0; i < 8; ++i) { const f32x4 dd = o[i] - mu; s2 += (dd.x * dd.x + dd.y * dd.y) + (dd.z * dd.z + dd.w * dd.w); }
        s2 += __shfl_xor(s2, 16); s2 += __shfl_xor(s2, 32);
        const float rs = 1.0f / sqrtf(s2 * (1.0f / 128) + EPS);
        const bf16* rgp = Z + (rowb + q) * ZW + ZN_RG + h * 128 + 4 * g;
        bf16* yo = YC + (rowb + q) * YCW + YC_RET + h * 128 + 4 * g;
#pragma unroll
        for (int i = 0; i < 8; ++i) {
            const u32x2 rg = *(const u32x2*)(rgp + 16 * i);
            const float g0 = bf_lo(rg.x), g1 = bf_hi(rg.x), g2 = bf_lo(rg.y), g3 = bf_hi(rg.y);
            u32x2 w; w.x = pk_bf16(g0 * ((o[i].x - mu) * rs), g1 * ((o[i].y - mu) * rs));
            w.y = pk_bf16(g2 * ((o[i].z - mu) * rs), g3 * ((o[i].w - mu) * rs));
            *(u32x2*)(yo + 16 * i) = w;
        }
        __syncthreads();
    }
}

typedef short v4i16 __attribute__((ext_vector_type(4)));
__device__ __forceinline__ int swz_b(int row) { return ((row & 3) << 2) | ((row >> 2) & 3); }
__device__ __forceinline__ int off_b(int row, int ch) { return 256 * row + 16 * (ch ^ swz_b(row)); }
__device__ __forceinline__ void dma_tile_b(const bf16* g, size_t gpitch, LAS unsigned char* dst, int rows, int wave, int lane) {
    for (int i = wave; i < rows / 4; i += 8) { const int s = 64 * i + lane, row = s >> 4, ch = (s & 15) ^ swz_b(row);
        __builtin_amdgcn_global_load_lds((const unsigned*)(g + (size_t)row * gpitch + 8 * ch), (LAS unsigned*)(dst + 1024 * i), 16, 0, 0); }
}
__device__ __forceinline__ bf16x8 frag_row_b(const LAS unsigned char* tile, int row, int ks, int g) { return *(const LAS bf16x8*)(tile + off_b(row, 4 * ks + g)); }
__device__ __forceinline__ bf16x8 frag_tr_b(const LAS unsigned char* tile, int lane, int c, int ks) {
    const int g = lane >> 4, q = (lane & 15) >> 2, p = lane & 3, r0 = 32 * ks + 8 * g + q;
    const v4i16 lo = __builtin_amdgcn_ds_read_tr16_b64_v4i16((LAS v4i16*)(tile + off_b(r0, 2 * c + (p >> 1)) + 8 * (p & 1)));
    const v4i16 hi = __builtin_amdgcn_ds_read_tr16_b64_v4i16((LAS v4i16*)(tile + off_b(r0 + 4, 2 * c + (p >> 1)) + 8 * (p & 1)));
    return (bf16x8){lo[0], lo[1], lo[2], lo[3], hi[0], hi[1], hi[2], hi[3]};
}
#define DMA_WAIT_ALL() asm volatile("s_waitcnt vmcnt(0)" ::: "memory")

__device__ __forceinline__ void ret_local_units2(const bf16* Z, const float* dec_f, const float* dec_b, float* LST, LAS unsigned char* lds, int tid, int lane, int wave, int bid, int G) {
    const int fr = lane & 15, g = lane >> 4;
    for (int u0 = bid; u0 < 16 * NCH; u0 += 2 * G) {
#pragma unroll
        for (int s = 0; s < 2; ++s) { const int u = u0 + s * G; if (u < 16 * NCH) {
            const int chunk = u & 31, bh = u >> 5, b = bh >> 3, h = bh & 7; const size_t rowb = (size_t)b * T + chunk * 128;
            dma_tile_b(Z + rowb * ZW + ZN_RK + h * 128, ZW, lds + s * 65536, 128, wave, lane);
            dma_tile_b(Z + rowb * ZW + ZN_RV + h * 128, ZW, lds + s * 65536 + 32768, 128, wave, lane); } }
        DMA_WAIT_ALL(); __syncthreads();
#pragma unroll 1
        for (int s = 0; s < 2; ++s) { const int u = u0 + s * G; if (u < 16 * NCH) {
            const int chunk = u & 31, bh = u >> 5, h = bh & 7;
            const float lf2 = log2_sigmoid(dec_f[h]), lb2 = log2_sigmoid(dec_b[h]);
            const LAS unsigned char* Kt = lds + s * 65536; const LAS unsigned char* Vt = Kt + 32768;
            f32x4 acc[2][8];
#pragma unroll
            for (int d = 0; d < 2; ++d)
#pragma unroll
                for (int i = 0; i < 8; ++i) acc[d][i] = (f32x4){0.f, 0.f, 0.f, 0.f};
#pragma unroll
            for (int ks = 0; ks < 4; ++ks) {
                const bf16x8 bv = frag_tr_b(Vt, lane, wave, ks);
                u32x4 wf, wb; const u32x4 bw = __builtin_bit_cast(u32x4, bv);
                { const int t0 = 32 * ks + 8 * g; float df[8], db[8];
#pragma unroll
                  for (int e = 0; e < 8; ++e) { df[e] = exp2f(lf2 * (float)(127 - (t0 + e))); db[e] = exp2f(lb2 * (float)(t0 + e)); }
                  wf.x = pk_bf16(bf_lo(bw.x) * df[0], bf_hi(bw.x) * df[1]); wf.y = pk_bf16(bf_lo(bw.y) * df[2], bf_hi(bw.y) * df[3]);
                  wf.z = pk_bf16(bf_lo(bw.z) * df[4], bf_hi(bw.z) * df[5]); wf.w = pk_bf16(bf_lo(bw.w) * df[6], bf_hi(bw.w) * df[7]);
                  wb.x = pk_bf16(bf_lo(bw.x) * db[0], bf_hi(bw.x) * db[1]); wb.y = pk_bf16(bf_lo(bw.y) * db[2], bf_hi(bw.y) * db[3]);
                  wb.z = pk_bf16(bf_lo(bw.z) * db[4], bf_hi(bw.z) * db[5]); wb.w = pk_bf16(bf_lo(bw.w) * db[6], bf_hi(bw.w) * db[7]); }
                const bf16x8 bvf = __builtin_bit_cast(bf16x8, wf), bvb = __builtin_bit_cast(bf16x8, wb);
#pragma unroll
                for (int i = 0; i < 8; ++i) { const bf16x8 a = frag_tr_b(Kt, lane, i, ks);
                    acc[0][i] = MFMA16(a, bvf, acc[0][i]); acc[1][i] = MFMA16(a, bvb, acc[1][i]); }
            }
#pragma unroll
            for (int d = 0; d < 2; ++d) { float* Lb = LST + ((size_t)((d * 16 + bh) * NCH + chunk)) * 16384 + (size_t)(16 * wave + fr) * 128 + 4 * g;
#pragma unroll
                for (int i = 0; i < 8; ++i) *(f32x4*)(Lb + 16 * i) = acc[d][i]; }
        } }
        __syncthreads();
    }
}

__device__ __forceinline__ void ret_out_units2(const bf16* Z, const float* dec_f, const float* dec_b, const bf16* SST, bf16* YC, LAS unsigned char* lds, int tid, int lane, int wave, int bid, int G) {
    const LAS unsigned char* Kt = lds; const LAS unsigned char* Vt = lds + 32768; const LAS unsigned char* Sft = lds + 65536; const LAS unsigned char* Sbt = lds + 98304;
    LAS unsigned char* Pt = lds;
    const int fr = lane & 15, g = lane >> 4;
    for (int u = bid; u < 16 * NCH; u += G) {
        const int chunk = u & 31, bh = u >> 5, b = bh >> 3, h = bh & 7;
        const float lf2 = log2_sigmoid(dec_f[h]), lb2 = log2_sigmoid(dec_b[h]);
        const size_t rowb = (size_t)b * T + chunk * 128;
        dma_tile_b(Z + rowb * ZW + ZN_RK + h * 128, ZW, lds, 128, wave, lane);
        dma_tile_b(Z + rowb * ZW + ZN_RV + h * 128, ZW, lds + 32768, 128, wave, lane);
        dma_tile_b(SST + ((size_t)((0 * 16 + bh) * NCH + chunk)) * 16384, 128, lds + 65536, 128, wave, lane);
        dma_tile_b(SST + ((size_t)((1 * 16 + bh) * NCH + chunk)) * 16384, 128, lds + 98304, 128, wave, lane);
        const int q = 16 * wave + fr;
        bf16x8 qf[4];
#pragma unroll
        for (int ks = 0; ks < 4; ++ks) qf[ks] = *(const bf16x8*)(Z + (rowb + q) * ZW + ZN_RQ + h * 128 + 32 * ks + 8 * g);
        u32x2 rg[8];
        { const bf16* rgp = Z + (rowb + q) * ZW + ZN_RG + h * 128 + 4 * g;
#pragma unroll
          for (int i = 0; i < 8; ++i) rg[i] = *(const u32x2*)(rgp + 16 * i); }
        DMA_WAIT_ALL(); __syncthreads();
        u32x2 pw[8];
#pragma unroll
        for (int kt = 0; kt < 8; ++kt) {
            f32x4 s = {0.f, 0.f, 0.f, 0.f};
#pragma unroll
            for (int ks = 0; ks < 4; ++ks) s = MFMA16(frag_row_b(Kt, 16 * kt + fr, ks, g), qf[ks], s);
            float pv[4];
#pragma unroll
            for (int r = 0; r < 4; ++r) { const int m = 16 * kt + 4 * g + r, diff = q - m;
                const float dc = diff >= 0 ? exp2f(lf2 * (float)diff) : exp2f(lb2 * (float)(-diff)); pv[r] = s[r] * dc; }
            pw[kt].x = pk_bf16(pv[0], pv[1]); pw[kt].y = pk_bf16(pv[2], pv[3]);
        }
        __syncthreads();
#pragma unroll
        for (int kt = 0; kt < 8; ++kt) *(LAS u32x2*)(Pt + off_b(q, 2 * kt + (g >> 1)) + 8 * (g & 1)) = pw[kt];
        LDS_WAIT();
        f32x4 o[8];
#pragma unroll
        for (int i = 0; i < 8; ++i) o[i] = (f32x4){0.f, 0.f, 0.f, 0.f};
#pragma unroll
        for (int ks = 0; ks < 4; ++ks) {
            const bf16x8 pb = frag_row_b(Pt, q, ks, g);
#pragma unroll
            for (int i = 0; i < 8; ++i) o[i] = MFMA16(frag_tr_b(Vt, lane, i, ks), pb, o[i]);
        }
#pragma unroll
        for (int d = 0; d < 2; ++d) {
            const float qd = d == 0 ? exp2f(lf2 * (float)(q + 1)) : exp2f(lb2 * (float)(128 - q));
            const LAS unsigned char* St = d == 0 ? Sft : Sbt;
#pragma unroll
            for (int i = 0; i < 8; ++i) {
                f32x4 c = {0.f, 0.f, 0.f, 0.f};
#pragma unroll
                for (int ks = 0; ks < 4; ++ks) c = MFMA16(frag_row_b(St, 16 * i + fr, ks, g), qf[ks], c);
                o[i] += c * qd;
            }
        }
        float s1 = 0.f;
#pragma unroll
        for (int i = 0; i < 8; ++i) s1 += (o[i].x + o[i].y) + (o[i].z + o[i].w);
        s1 += __shfl_xor(s1, 16); s1 += __shfl_xor(s1, 32);
        const float mu = s1 * (1.0f / 128);
        float s2 = 0.f;
#pragma unroll
        for (int i = 0; i < 8; ++i) { const f32x4 dd = o[i] - mu; s2 += (dd.x * dd.x + dd.y * dd.y) + (dd.z * dd.z + dd.w * dd.w); }
        s2 += __shfl_xor(s2, 16); s2 += __shfl_xor(s2, 32);
        const float rs = 1.0f / sqrtf(s2 * (1.0f / 128) + EPS);
        bf16* yo = YC + (rowb + q) * YCW + YC_RET + h * 128 + 4 * g;
#pragma unroll
        for (int i = 0; i < 8; ++i) {
            const float g0 = bf_lo(rg[i].x), g1 = bf_hi(rg[i].x), g2 = bf_lo(rg[i].y), g3 = bf_hi(rg[i].y);
            u32x2 w; w.x = pk_bf16(g0 * ((o[i].x - mu) * rs), g1 * ((o[i].y - mu) * rs));
            w.y = pk_bf16(g2 * ((o[i].z - mu) * rs), g3 * ((o[i].w - mu) * rs));
            *(u32x2*)(yo + 16 * i) = w;
        }
        __syncthreads();
    }
}

constexpr int NP = 72 * 2;
__device__ __forceinline__ void na_units(const bf16* Z, const float* rpb  , bf16* YC, LAS unsigned char* lds, int tid, int lane, int wave, int bid, int G) {
    LAS unsigned char* Kl = lds;
    LAS unsigned char* Vt = lds + 64 * RP;
    LAS unsigned char* Pl = lds + 64 * RP + 128 * NP + wave * 16 * NP;
    LAS float* bias = (LAS float*)(lds + 64 * RP + 128 * NP + 8 * 16 * NP);
    const int fr = lane & 15, g = lane >> 4;
    for (int u = bid; u < 16 * 32; u += G) {
        const int rp = u & 31, bh = u >> 5, b = bh >> 3, h = bh & 7, r0 = 2 * rp;
        for (int i = tid; i < 465; i += 512) bias[i] = rpb[h * 465 + i];
        const int qr = r0 + (wave >> 2), c = 16 * (wave & 3) + fr;
        const size_t rowq = (size_t)b * T + qr * 64 + c;
        bf16x8 qf[4];
#pragma unroll
        for (int ks = 0; ks < 4; ++ks) qf[ks] = *(const bf16x8*)(Z + rowq * ZW + ZN_NQ + h * 128 + 32 * ks + 8 * g);
        const int rs_q = min(max(qr - 4, 0), 56), cs_q = min(max(c - 8, 0), 48);
        const int kr_lo = min(max(r0 - 4, 0), 56), kr_hi = min(max(r0 - 3, 0), 56) + 7;
        float m_run = -INFINITY, l_run = 0.f;
        f32x4 o[8];
#pragma unroll
        for (int i = 0; i < 8; ++i) o[i] = (f32x4){0.f, 0.f, 0.f, 0.f};
        u32x4 kreg[2], vreg[2];
        { const size_t rowk = (size_t)b * T + kr_lo * 64;
#pragma unroll
          for (int rep = 0; rep < 2; ++rep) { const int it = tid + 512 * rep;
              kreg[rep] = *(const u32x4*)(Z + (rowk + (it >> 4)) * ZW + ZN_NK + h * 128 + 8 * (it & 15));
              vreg[rep] = *(const u32x4*)(Z + (rowk + (it & 63)) * ZW + ZN_NV + h * 128 + 8 * (it >> 6)); } }
        for (int kr = kr_lo; kr <= kr_hi; ++kr) {
#pragma unroll
            for (int rep = 0; rep < 2; ++rep) { const int it = tid + 512 * rep, kc = it >> 4, ch = it & 15;
                *(LAS u32x4*)(Kl + kc * RP + 16 * ch) = kreg[rep]; }
#pragma unroll
            for (int rep = 0; rep < 2; ++rep) { const int it = tid + 512 * rep, kc = it & 63, ch = it >> 6;
                const unsigned vw[4] = {vreg[rep].x, vreg[rep].y, vreg[rep].z, vreg[rep].w};
#pragma unroll
                for (int e = 0; e < 8; ++e) *(LAS bf16*)(Vt + (8 * ch + e) * NP + 2 * kc) = (bf16)((e & 1) ? (vw[e >> 1] >> 16) : (vw[e >> 1] & 0xffffu)); }
            __syncthreads();
            if (kr < kr_hi) { const size_t rowk = (size_t)b * T + (kr + 1) * 64;
#pragma unroll
                for (int rep = 0; rep < 2; ++rep) { const int it = tid + 512 * rep;
                    kreg[rep] = *(const u32x4*)(Z + (rowk + (it >> 4)) * ZW + ZN_NK + h * 128 + 8 * (it & 15));
                    vreg[rep] = *(const u32x4*)(Z + (rowk + (it & 63)) * ZW + ZN_NV + h * 128 + 8 * (it >> 6)); } }
            if (kr >= rs_q && kr < rs_q + 8) {
                float s[4][4]; float mx = -INFINITY;
#pragma unroll
                for (int kt = 0; kt < 4; ++kt) {
                    f32x4 a4 = {0.f, 0.f, 0.f, 0.f};
#pragma unroll
                    for (int ks = 0; ks < 4; ++ks) { const bf16x8 a = *(const LAS bf16x8*)(Kl + (16 * kt + fr) * RP + (32 * ks + 8 * g) * 2); a4 = MFMA16(a, qf[ks], a4); }
#pragma unroll
                    for (int r = 0; r < 4; ++r) { const int kc = 16 * kt + 4 * g + r; const bool valid = (kc >= cs_q) && (kc < cs_q + 16);
                        const int bi = valid ? ((kr - qr + 7) * 31 + (kc - c + 15)) : 0;
                        const float sv = valid ? (a4[r] + bias[bi]) : -INFINITY; s[kt][r] = sv; mx = fmaxf(mx, sv); }
                }
                mx = fmaxf(mx, __shfl_xor(mx, 16)); mx = fmaxf(mx, __shfl_xor(mx, 32));
                const float m_new = fmaxf(m_run, mx), alpha = __expf(m_run - m_new);
                float ps = 0.f;
#pragma unroll
                for (int kt = 0; kt < 4; ++kt) {
#pragma unroll
                    for (int r = 0; r < 4; ++r) { s[kt][r] = __expf(s[kt][r] - m_new); ps += s[kt][r]; }
                    u32x2 w; w.x = pk_bf16(s[kt][0], s[kt][1]); w.y = pk_bf16(s[kt][2], s[kt][3]);
                    *(LAS u32x2*)(Pl + fr * NP + (16 * kt + 4 * g) * 2) = w;
                }
                ps += __shfl_xor(ps, 16); ps += __shfl_xor(ps, 32);
                l_run = l_run * alpha + ps; m_run = m_new;
#pragma unroll
                for (int i = 0; i < 8; ++i) o[i] *= alpha;
                LDS_WAIT();
#pragma unroll
                for (int ks = 0; ks < 2; ++ks) {
                    const bf16x8 pb = *(const LAS bf16x8*)(Pl + fr * NP + (32 * ks + 8 * g) * 2);
#pragma unroll
                    for (int i = 0; i < 8; ++i) { const bf16x8 a = *(const LAS bf16x8*)(Vt + (16 * i + fr) * NP + (32 * ks + 8 * g) * 2); o[i] = MFMA16(a, pb, o[i]); }
                }
            }
            __syncthreads();
        }
        const float inv = 1.0f / l_run;
        bf16* yo = YC + rowq * YCW + YC_NA + h * 128 + 4 * g;
#pragma unroll
        for (int i = 0; i < 8; ++i) { u32x2 w; w.x = pk_bf16(o[i].x * inv, o[i].y * inv); w.y = pk_bf16(o[i].z * inv, o[i].w * inv); *(u32x2*)(yo + 16 * i) = w; }
    }
}

__device__ __forceinline__ void na_dma_row(const bf16* Z, size_t rowk, int h, LAS unsigned char* slot, int wave, int lane) {
    dma_tile_b(Z + rowk * ZW + ZN_NK + h * 128, ZW, slot, 64, wave, lane);
    dma_tile_b(Z + rowk * ZW + ZN_NV + h * 128, ZW, slot + 16384, 64, wave, lane);
}
__device__ __forceinline__ void na_units2(const bf16* Z, const float* rpb  , bf16* YC, LAS unsigned char* lds, int tid, int lane, int wave, int bid, int G) {
    LAS unsigned char* Pw = lds + 98304 + wave * 4096;
    LAS float* bias = (LAS float*)(lds + LDSCTL_OFF + 512);
    const int fr = lane & 15, g = lane >> 4;
    for (int u = bid; u < 256; u += G) {
        const int rq = u & 15, bh = u >> 4, b = bh >> 3, h = bh & 7, r0 = 4 * rq;
        for (int i = tid; i < 465; i += 512) bias[i] = rpb[h * 465 + i];
        const int jc = wave & 3, c = 16 * jc + fr, qr0 = r0 + 2 * (wave >> 2);
        bf16x8 qf[2][4];
#pragma unroll
        for (int i = 0; i < 2; ++i)
#pragma unroll
            for (int ks = 0; ks < 4; ++ks) qf[i][ks] = *(const bf16x8*)(Z + ((size_t)b * T + (qr0 + i) * 64 + c) * ZW + ZN_NQ + h * 128 + 32 * ks + 8 * g);
        const int cs_q = min(max(c - 8, 0), 48);
        const int kt_lo = min(max(16 * jc - 8, 0), 48) >> 4, kt_hi = (min(max(16 * jc + 7, 0), 48) + 15) >> 4;
        const int kr_lo = min(max(r0 - 4, 0), 56), kr_hi = min(max(r0 - 1, 0), 56) + 7;
        const int rs0 = min(max(qr0 - 4, 0), 56), rs1 = min(max(qr0 - 3, 0), 56);
        float m_run[2] = {-INFINITY, -INFINITY}, l_run[2] = {0.f, 0.f};
        f32x4 o[2][8];
#pragma unroll
        for (int i = 0; i < 2; ++i)
#pragma unroll
            for (int d = 0; d < 8; ++d) o[i][d] = (f32x4){0.f, 0.f, 0.f, 0.f};
        na_dma_row(Z, (size_t)b * T + kr_lo * 64, h, lds, wave, lane);
        if (kr_lo + 1 <= kr_hi) na_dma_row(Z, (size_t)b * T + (kr_lo + 1) * 64, h, lds + 32768, wave, lane);
        int slot = 0;
        for (int kr = kr_lo; kr <= kr_hi; ++kr) {
            if (kr + 1 <= kr_hi) asm volatile("s_waitcnt vmcnt(4) lgkmcnt(0)" ::: "memory"); else asm volatile("s_waitcnt vmcnt(0) lgkmcnt(0)" ::: "memory");
            __builtin_amdgcn_s_barrier(); asm volatile("" ::: "memory");
            if (kr + 2 <= kr_hi) { const int s2 = slot >= 1 ? slot - 1 : 2; na_dma_row(Z, (size_t)b * T + (kr + 2) * 64, h, lds + s2 * 32768, wave, lane); }
            const LAS unsigned char* Ks = lds + slot * 32768; const LAS unsigned char* Vs = Ks + 16384;
            const bool act0 = (kr >= rs0) && (kr < rs0 + 8), act1 = (kr >= rs1) && (kr < rs1 + 8);
            if (act0 || act1) {
                float s[2][4][4];
#pragma unroll
                for (int kt = 0; kt < 4; ++kt) {
                    if (kt >= kt_lo && kt <= kt_hi) {
                        f32x4 a0 = {0.f, 0.f, 0.f, 0.f}, a1 = {0.f, 0.f, 0.f, 0.f};
#pragma unroll
                        for (int ks = 0; ks < 4; ++ks) { const bf16x8 a = frag_row_b(Ks, 16 * kt + fr, ks, g); a0 = MFMA16(a, qf[0][ks], a0); a1 = MFMA16(a, qf[1][ks], a1); }
#pragma unroll
                        for (int r = 0; r < 4; ++r) { const int kc = 16 * kt + 4 * g + r; const bool valid = (kc >= cs_q) && (kc < cs_q + 16);
                            const int bi0 = valid ? ((kr - qr0 + 7) * 31 + (kc - c + 15)) : 0;
                            const int b0c = min(max(bi0, 0), 464), b1c = min(max(bi0 - 31, 0), 464);
                            s[0][kt][r] = valid ? (a0[r] + bias[b0c]) : -INFINITY; s[1][kt][r] = valid ? (a1[r] + bias[b1c]) : -INFINITY; }
                    } else {
#pragma unroll
                        for (int r = 0; r < 4; ++r) { s[0][kt][r] = -INFINITY; s[1][kt][r] = -INFINITY; }
                    }
                }
#pragma unroll
                for (int i = 0; i < 2; ++i) {
                    if (i == 0 ? act0 : act1) {
                        float mx = -INFINITY;
#pragma unroll
                        for (int kt = 0; kt < 4; ++kt)
#pragma unroll
                            for (int r = 0; r < 4; ++r) mx = fmaxf(mx, s[i][kt][r]);
                        mx = fmaxf(mx, __shfl_xor(mx, 16)); mx = fmaxf(mx, __shfl_xor(mx, 32));
                        const float m_new = fmaxf(m_run[i], mx), alpha = __expf(m_run[i] - m_new);
                        float ps = 0.f;
#pragma unroll
                        for (int kt = 0; kt < 4; ++kt) {
#pragma unroll
                            for (int r = 0; r < 4; ++r) { s[i][kt][r] = __expf(s[i][kt][r] - m_new); ps += s[i][kt][r]; }
                            u32x2 w; w.x = pk_bf16(s[i][kt][0], s[i][kt][1]); w.y = pk_bf16(s[i][kt][2], s[i][kt][3]);
                            *(LAS u32x2*)(Pw + i * 2048 + fr * 128 + 16 * ((2 * kt + (g >> 1)) ^ (fr & 7)) + 8 * (g & 1)) = w;
                        }
                        ps += __shfl_xor(ps, 16); ps += __shfl_xor(ps, 32);
                        l_run[i] = l_run[i] * alpha + ps; m_run[i] = m_new;
#pragma unroll
                        for (int d = 0; d < 8; ++d) o[i][d] *= alpha;
                    }
                }
                LDS_WAIT();
#pragma unroll
                for (int ks = 0; ks < 2; ++ks) {
                    if (ks >= (kt_lo >> 1) && ks <= (kt_hi >> 1)) {
                        const bf16x8 pb0 = *(const LAS bf16x8*)(Pw + 0 * 2048 + fr * 128 + 16 * ((4 * ks + g) ^ (fr & 7)));
                        const bf16x8 pb1 = *(const LAS bf16x8*)(Pw + 1 * 2048 + fr * 128 + 16 * ((4 * ks + g) ^ (fr & 7)));
#pragma unroll
                        for (int d = 0; d < 8; ++d) { const bf16x8 a = frag_tr_b(Vs, lane, d, ks);
                            if (act0) o[0][d] = MFMA16(a, pb0, o[0][d]);
                            if (act1) o[1][d] = MFMA16(a, pb1, o[1][d]); }
                    }
                }
            }
            slot = slot == 2 ? 0 : slot + 1;
        }
#pragma unroll
        for (int i = 0; i < 2; ++i) {
            const float inv = 1.0f / l_run[i];
            bf16* yo = YC + ((size_t)b * T + (qr0 + i) * 64 + c) * YCW + YC_NA + h * 128 + 4 * g;
#pragma unroll
            for (int d = 0; d < 8; ++d) { u32x2 w; w.x = pk_bf16(o[i][d].x * inv, o[i][d].y * inv); w.y = pk_bf16(o[i][d].z * inv, o[i][d].w * inv); *(u32x2*)(yo + 16 * d) = w; }
        }
        __syncthreads();
    }
}

__device__ __forceinline__ void conv_units2(const bf16* Z, bf16* YC, const float* scw, const float* cfw, const float* cfg, const float* cfb,
                                            LAS unsigned char* lds, int tid, int lane, int wave, int bid, int G) {
    const unsigned c00 = 2u * (unsigned)tid;
    LAS unsigned char* U = lds;
    LAS unsigned char* Pb = lds + (CT + 30) * 2048;
    LAS float* red = (LAS float*)(lds + LDSCTL_OFF + 512);
    LAS float* tot = red + 8 * 2 * CT;
    for (int u = bid; u < M / CT; u += G) {
        const int row0 = CT * u, b = row0 >> 12, ts = row0 & 4095;
        unsigned c0 = c00; asm volatile("" : "+v"(c0));
        const bf16* Zb = Z + (size_t)b * T * ZW;
        for (int i = wave; i < 2 * (CT + 30); i += 8) { const int tok = ts - 15 + (i >> 1);
            if (tok >= 0 && tok < T) __builtin_amdgcn_global_load_lds((const unsigned*)(Zb + (size_t)tok * ZW + ZN_U + 512 * (i & 1) + 8 * lane), (LAS unsigned*)(U + 1024 * i), 16, 0, 0);
            else *(LAS u32x4*)(U + 1024 * i + 16 * lane) = (u32x4){0u, 0u, 0u, 0u}; }
        for (int i = wave; i < 2 * (CT + 2); i += 8) { const int tok = ts - 1 + (i >> 1);
            if (tok >= 0 && tok < T) __builtin_amdgcn_global_load_lds((const unsigned*)(Zb + (size_t)tok * ZW + ZN_P + 512 * (i & 1) + 8 * lane), (LAS unsigned*)(Pb + 1024 * i), 16, 0, 0);
            else *(LAS u32x4*)(Pb + 1024 * i + 16 * lane) = (u32x4){0u, 0u, 0u, 0u}; }
        float w[31][2];
#pragma unroll
        for (int k = 0; k < 31; ++k) { const f32x2 t = *(const f32x2*)((cfw + k * 1024) + c0); w[k][0] = t.x; w[k][1] = t.y; }
        unsigned sbv[CT];
#pragma unroll
        for (int t = 0; t < CT; ++t) sbv[t] = *(const unsigned*)((Zb + (size_t)(ts + t) * ZW + ZN_SB) + c0);
        float w3[3][2];
#pragma unroll
        for (int k = 0; k < 3; ++k) { const f32x2 t = *(const f32x2*)((scw + k * 1024) + c0); w3[k][0] = t.x; w3[k][1] = t.y; }
        const f32x2 lg = *(const f32x2*)(cfg + c0), lb = *(const f32x2*)(cfb + c0);
        DMA_WAIT_ALL(); __syncthreads();
        float acc[CT][2];
#pragma unroll
        for (int t = 0; t < CT; ++t) { acc[t][0] = 0.f; acc[t][1] = 0.f; }
#pragma unroll
        for (int j = 0; j < CT + 30; ++j) {
            const unsigned uv = *(const LAS unsigned*)(U + (j * 2048u + c0 * 2u));
            const float u0 = bf_lo(uv), u1 = bf_hi(uv);
#pragma unroll
            for (int t = 0; t < CT; ++t) { const int k = j - t; if (k >= 0 && k <= 30) { acc[t][0] += w[k][0] * u0; acc[t][1] += w[k][1] * u1; } }
            if ((j & 7) == 7) asm volatile("" ::: "memory");
        }
        float st[2 * CT];
#pragma unroll
        for (int t = 0; t < CT; ++t) { st[t] = wave_sum(acc[t][0] + acc[t][1]); st[CT + t] = wave_sum(acc[t][0] * acc[t][0] + acc[t][1] * acc[t][1]); }
        if (lane == 0) {
#pragma unroll
            for (int i = 0; i < 2 * CT; ++i) red[wave * 2 * CT + i] = st[i]; }
        __syncthreads();
        if (tid < 2 * CT) { float s = 0.f;
#pragma unroll
            for (int wv = 0; wv < 8; ++wv) s += red[wv * 2 * CT + tid];
            tot[tid] = s; }
        __syncthreads();
#pragma unroll
        for (int t = 0; t < CT; ++t) {
            const float mu = tot[t] * (1.0f / 1024), var = fmaxf(tot[CT + t] * (1.0f / 1024) - mu * mu, 0.f), rs = 1.0f / sqrtf(var + EPS);
            float y0 = (acc[t][0] - mu) * rs * lg.x + lb.x, y1 = (acc[t][1] - mu) * rs * lg.y + lb.y;
            y0 *= fsigmoid(y0); y1 *= fsigmoid(y1);
            *(unsigned*)(YC + (size_t)(row0 + t) * YCW + YC_CF + c0) = pk_bf16(y0, y1);
        }
        {
            unsigned pa = *(const LAS unsigned*)(Pb + (0 * 2048u + c0 * 2u)), pbv = *(const LAS unsigned*)(Pb + (1 * 2048u + c0 * 2u));
#pragma unroll
            for (int t = 0; t < CT; ++t) {
                const unsigned pc = *(const LAS unsigned*)(Pb + ((t + 2) * 2048u + c0 * 2u));
                const float o0 = w3[0][0] * bf_lo(pa) + w3[1][0] * bf_lo(pbv) + w3[2][0] * bf_lo(pc);
                const float o1 = w3[0][1] * bf_hi(pa) + w3[1][1] * bf_hi(pbv) + w3[2][1] * bf_hi(pc);
                *(unsigned*)(YC + (size_t)(row0 + t) * YCW + YC_SC + c0) = pk_bf16(bf_lo(sbv[t]) * o0, bf_hi(sbv[t]) * o1);
                pa = pbv; pbv = pc;
            }
        }
        __syncthreads();
    }
}

constexpr int CT2 = 32;
__device__ __forceinline__ void conv31_16(const LAS unsigned char* Ub, unsigned c0, const float (&w)[31][2], float (&acc)[16][2]) {
#pragma unroll
    for (int t = 0; t < 16; ++t) { acc[t][0] = 0.f; acc[t][1] = 0.f; }
#pragma unroll
    for (int j = 0; j < 46; ++j) {
        const unsigned uv = *(const LAS unsigned*)(Ub + (j * 2048u + c0 * 2u));
        const float u0 = bf_lo(uv), u1 = bf_hi(uv);
#pragma unroll
        for (int t = 0; t < 16; ++t) { const int k = j - t; if (k >= 0 && k <= 30) { acc[t][0] += w[k][0] * u0; acc[t][1] += w[k][1] * u1; } }
        if ((j & 7) == 7) asm volatile("" ::: "memory");
    }
}
__device__ __forceinline__ void conv_units3(const bf16* Z, bf16* YC, const float* scw, const float* cfw, const float* cfg, const float* cfb,
                                            LAS unsigned char* lds, int tid, int lane, int wave, int bid, int G) {
    const unsigned c00 = 2u * (unsigned)tid;
    LAS unsigned char* U = lds;
    LAS float* red = (LAS float*)(lds + LDSCTL_OFF + 512);
    LAS float* tot = red + 32 * 2 * CT2;
    for (int u = bid; u < M / CT2; u += G) {
        const int row0 = CT2 * u, b = row0 >> 12, ts = row0 & 4095;
        unsigned c0 = c00; asm volatile("" : "+v"(c0));
        const bf16* Zb = Z + (size_t)b * T * ZW;
#pragma unroll 1
        for (int i = wave; i < 2 * (CT2 + 30); i += 8) { const int tok = ts - 15 + (i >> 1);
            if (tok >= 0 && tok < T) __builtin_amdgcn_global_load_lds((const unsigned*)(Zb + (size_t)tok * ZW + ZN_U + 512 * (i & 1) + 8 * lane), (LAS unsigned*)(U + 1024 * i), 16, 0, 0);
            else *(LAS u32x4*)(U + 1024 * i + 16 * lane) = (u32x4){0u, 0u, 0u, 0u}; }
        float w[31][2];
#pragma unroll
        for (int k = 0; k < 31; ++k) { const f32x2 t = *(const f32x2*)((cfw + k * 1024) + c0); w[k][0] = t.x; w[k][1] = t.y; }
        DMA_WAIT_ALL(); __syncthreads();
        float accA[16][2], accB[16][2];
        conv31_16(U, c0, w, accA);
        conv31_16(U + 16 * 2048, c0, w, accB);
        __syncthreads();
#pragma unroll 1
        for (int i = wave; i < 2 * (CT2 + 2); i += 8) { const int tok = ts - 1 + (i >> 1);
            if (tok >= 0 && tok < T) __builtin_amdgcn_global_load_lds((const unsigned*)(Zb + (size_t)tok * ZW + ZN_P + 512 * (i & 1) + 8 * lane), (LAS unsigned*)(U + 1024 * i), 16, 0, 0);
            else *(LAS u32x4*)(U + 1024 * i + 16 * lane) = (u32x4){0u, 0u, 0u, 0u}; }
#pragma unroll
        for (int t = 0; t < CT2; ++t) { const float v0 = t < 16 ? accA[t & 15][0] : accB[t & 15][0], v1 = t < 16 ? accA[t & 15][1] : accB[t & 15][1];
            const float s1 = row16_sum(v0 + v1), s2 = row16_sum(v0 * v0 + v1 * v1);
            if ((lane & 15) == 0) { red[(wave * 4 + (lane >> 4)) * 2 * CT2 + t] = s1; red[(wave * 4 + (lane >> 4)) * 2 * CT2 + CT2 + t] = s2; } }
        LDS_WAIT(); __builtin_amdgcn_s_barrier(); asm volatile("" ::: "memory");
        if (tid < 2 * CT2) { float s = 0.f;
#pragma unroll
            for (int wv = 0; wv < 32; ++wv) s += red[wv * 2 * CT2 + tid];
            tot[tid] = s; }
        LDS_WAIT(); __builtin_amdgcn_s_barrier(); asm volatile("" ::: "memory");
        { const f32x2 lg = *(const f32x2*)(cfg + c0), lb = *(const f32x2*)(cfb + c0);
#pragma unroll
          for (int t = 0; t < CT2; ++t) {
            const float mu = tot[t] * (1.0f / 1024), var = fmaxf(tot[CT2 + t] * (1.0f / 1024) - mu * mu, 0.f), rs = 1.0f / sqrtf(var + EPS);
            const float v0 = t < 16 ? accA[t & 15][0] : accB[t & 15][0], v1 = t < 16 ? accA[t & 15][1] : accB[t & 15][1];
            float y0 = (v0 - mu) * rs * lg.x + lb.x, y1 = (v1 - mu) * rs * lg.y + lb.y;
            y0 *= fsigmoid(y0); y1 *= fsigmoid(y1);
            *(unsigned*)(YC + (size_t)(row0 + t) * YCW + YC_CF + c0) = pk_bf16(y0, y1);
          } }
        {
            float w3[3][2];
#pragma unroll
            for (int k = 0; k < 3; ++k) { const f32x2 t = *(const f32x2*)((scw + k * 1024) + c0); w3[k][0] = t.x; w3[k][1] = t.y; }
            unsigned sbv[CT2];
#pragma unroll
            for (int t = 0; t < CT2; ++t) sbv[t] = *(const unsigned*)((Zb + (size_t)(ts + t) * ZW + ZN_SB) + c0);
            DMA_WAIT_ALL(); __syncthreads();
            unsigned pa = *(const LAS unsigned*)(U + (0 * 2048u + c0 * 2u)), pbv = *(const LAS unsigned*)(U + (1 * 2048u + c0 * 2u));
#pragma unroll
            for (int t = 0; t < CT2; ++t) {
                const unsigned pc = *(const LAS unsigned*)(U + ((t + 2) * 2048u + c0 * 2u));
                const float o0 = w3[0][0] * bf_lo(pa) + w3[1][0] * bf_lo(pbv) + w3[2][0] * bf_lo(pc);
                const float o1 = w3[0][1] * bf_hi(pa) + w3[1][1] * bf_hi(pbv) + w3[2][1] * bf_hi(pc);
                *(unsigned*)(YC + (size_t)(row0 + t) * YCW + YC_SC + c0) = pk_bf16(bf_lo(sbv[t]) * o0, bf_hi(sbv[t]) * o1);
                pa = pbv; pbv = pc;
            }
        }
        __syncthreads();
    }
}

#define PH_BEGIN() int wave = wave0; asm volatile("" : "+s"(wave)); const int lane = lane_id(); const int tid = wave * 64 + lane; \
    int G = G0, bid = bid0; asm volatile("" : "+s"(G), "+s"(bid)); unsigned char* ws = args.ws; asm volatile("" : "+s"(ws)); \
    LAS unsigned char* lds = lds0; asm volatile("" : "+s"(lds)); (void)lane; (void)wave; (void)G; (void)bid; (void)ws; (void)lds
__global__ void __launch_bounds__(512, 2) fwd(Args args) {
    extern __shared__ __attribute__((aligned(16))) unsigned char lds_raw[];
    LAS unsigned char* lds0 = (LAS unsigned char*)lds_raw;
    const int wave0 = __builtin_amdgcn_readfirstlane(threadIdx.x >> 6);
    const int G0 = gridDim.x, bid0 = blockIdx.x;
    volatile LAS unsigned* MISC = (volatile LAS unsigned*)(lds0 + MISC_OFF);
    for (int u = wave0 * 64 + lane_id(); u < (LDS_BYTES - LDSCTL_OFF) / 4; u += 512) ((LAS unsigned*)(lds0 + LDSCTL_OFF))[u] = 0u;
    __syncthreads();
    const int lo = args.ph_lo, hi = args.ph_hi;
    XcdBarrier bar; bar.bar = (unsigned*)(args.ws + WS_CTL) + CW_BAR; bar.x = 0; bar.st = nullptr; bar.wave = wave0;
    if (hi - lo > 1) bar = xcd_barrier_post((unsigned*)(args.ws + WS_CTL) + CW_BAR, MISC + 8, wave0);
#define IN(k) (lo <= (k) && (k) < hi)
#ifndef PROBE_KIND
#define PROBE_KIND (-1)
#endif
    unsigned long long pt_acc = 0ull, pt_t0 = 0ull;
#define PT_BEG(kind) do { if ((kind) == PROBE_KIND) pt_t0 = __builtin_amdgcn_s_memrealtime(); } while (0)
#define PT_END(kind) do { if ((kind) == PROBE_KIND) pt_acc += __builtin_amdgcn_s_memrealtime() - pt_t0; } while (0)
#define SEAM(k) do { if (IN((k) + 1)) { XcdBarrier bb_ = bar; asm volatile("" : "+s"(bb_.bar), "+s"(bb_.x), "+s"(bb_.wave)); xcd_barrier(bb_); } } while (0)

    if (IN(0)) { PT_BEG(10); PH_BEGIN(); for (int rep_ = 0; rep_ < REP_PRO; ++rep_) phase_prologue(args, lds, tid, lane, wave, bid, G); SEAM(0); PT_END(10); }
    if (IN(1)) {
        PT_BEG(11); PH_BEGIN(); const float* MOD = (const float*)(ws + WS_MOD);
        norm_rows(args.in[0], args.out, nullptr, nullptr, nullptr, true, MOD + 1 * D, MOD + 0 * D, args.in[4], (bf16*)(ws + WS_H), bid * 8 + wave, G * 8, lane);
        SEAM(1); PT_END(11);
    }
#define LAYER_BODY(l) do { \
        const int p0 = 2 + 10 * l; \
        if (IN(p0 + 0)) { PT_BEG(0); \
            PH_BEGIN(); \
            pg8::Gemm g{(const bf16*)(ws + WS_H), (const bf16*)(ws + WS_WIN) + (size_t)l * DIN * D, M, DIN, D}; pg8::StaticOrder S; S.init(M, DIN, G, bid); \
            EpiZ E{(bf16*)(ws + WS_Z), (const f32x2*)(ws + WS_ROPE)}; \
            for (int rep_ = 0; rep_ < REP_G1; ++rep_) pg8::gemm_phase<EpiZ, pg8::StaticOrder, true, true>(lds, g, S, E, tid); \
            SEAM(p0 + 0); PT_END(0); \
        } \
        if (IN(p0 + 1)) { PT_BEG(1); \
            PH_BEGIN(); \
            for (int rep_ = 0; rep_ < REP_M1; ++rep_) { PT_BEG(14); ret_local_units2((const bf16*)(ws + WS_Z), args.in[9] + l * NH, args.in[10] + l * NH, (float*)(ws + WS_LST), lds, tid, lane, wave, bid, G); PT_END(14); \
            PT_BEG(15); conv_units3((const bf16*)(ws + WS_Z), (bf16*)(ws + WS_YCAT), args.in[12] + (size_t)l * 3 * 1024, args.in[13] + (size_t)l * 31 * 1024, args.in[14] + (size_t)l * 1024, args.in[15] + (size_t)l * 1024, lds, tid, lane, wave, bid, G); PT_END(15); } \
            SEAM(p0 + 1); PT_END(1); \
        } \
        if (IN(p0 + 2)) { PT_BEG(2); \
            PH_BEGIN(); \
            for (int rep_ = 0; rep_ < REP_M2; ++rep_) { PT_BEG(12); ret_scan((const float*)(ws + WS_LST), (bf16*)(ws + WS_SST), args.in[9] + l * NH, args.in[10] + l * NH, tid, bid, G); PT_END(12); \
            PT_BEG(13); na_units2((const bf16*)(ws + WS_Z), args.in[11] + (size_t)l * NH * 465, (bf16*)(ws + WS_YCAT), lds, tid, lane, wave, bid, G); PT_END(13); } \
            SEAM(p0 + 2); PT_END(2); \
        } \
        if (IN(p0 + 3)) { PT_BEG(3); \
            PH_BEGIN(); \
            for (int rep_ = 0; rep_ < REP_M3; ++rep_) ret_out_units2((const bf16*)(ws + WS_Z), args.in[9] + l * NH, args.in[10] + l * NH, (const bf16*)(ws + WS_SST), (bf16*)(ws + WS_YCAT), lds, tid, lane, wave, bid, G); \
            SEAM(p0 + 3); PT_END(3); \
        } \
        if (IN(p0 + 4)) { PT_BEG(4); \
            PH_BEGIN(); \
            pg8::Gemm g{(const bf16*)(ws + WS_YCAT), (const bf16*)(ws + WS_WCAT) + (size_t)l * D * YCW, M, D, YCW}; pg8::StaticOrder S; S.init(M, D, G, bid); \
            pg8::EpiMerge E{(const bf16*)(ws + WS_Z) + ZN_R1, ZW, (bf16*)(ws + WS_MERGED), D}; \
            for (int rep_ = 0; rep_ < REP_G2; ++rep_) pg8::gemm_phase<pg8::EpiMerge, pg8::StaticOrder, false, true>(lds, g, S, E, tid); \
            SEAM(p0 + 4); PT_END(4); \
        } \
        if (IN(p0 + 5)) { PT_BEG(5); \
            PH_BEGIN(); \
            pg8::Gemm g{(const bf16*)(ws + WS_MERGED), (const bf16*)(ws + WS_WO) + (size_t)l * D * D, M, D, D}; pg8::StaticOrder S; S.init(M, D, G, bid); \
            pg8::EpiBf16<0> E{(bf16*)(ws + WS_Y), D, 0}; \
            for (int rep_ = 0; rep_ < REP_G3; ++rep_) pg8::gemm_phase<pg8::EpiBf16<0>, pg8::StaticOrder, false, true>(lds, g, S, E, tid); \
            SEAM(p0 + 5); PT_END(5); \
        } \
        if (IN(p0 + 6)) { PT_BEG(6); \
            PH_BEGIN(); const float* modl = (const float*)(ws + WS_MOD) + (size_t)l * 2 * MODW; \
            norm_rows(args.out, args.out, (const bf16*)(ws + WS_Y), modl + 2 * D, args.in[5] + (size_t)l * D, true, modl + 4 * D, modl + 3 * D, args.in[6] + (size_t)l * D, (bf16*)(ws + WS_H), bid * 8 + wave, G * 8, lane); \
            SEAM(p0 + 6); PT_END(6); \
        } \
        if (IN(p0 + 7)) { PT_BEG(7); \
            PH_BEGIN(); \
            pg8::Gemm g{(const bf16*)(ws + WS_H), (const bf16*)(ws + WS_W1) + (size_t)l * DFF * D, M, DFF, D}; pg8::StaticOrder S; S.init(M, DFF, G, bid); \
            pg8::EpiBf16<1> E{(bf16*)(ws + WS_U), DFF, 0}; \
            for (int rep_ = 0; rep_ < REP_G4; ++rep_) pg8::gemm_phase<pg8::EpiBf16<1>, pg8::StaticOrder, true, true>(lds, g, S, E, tid); \
            SEAM(p0 + 7); PT_END(7); \
        } \
        if (IN(p0 + 8)) { PT_BEG(8); \
            PH_BEGIN(); \
            pg8::Gemm g{(const bf16*)(ws + WS_U), (const bf16*)(ws + WS_W2) + (size_t)l * D * DFF, M, D, DFF}; pg8::StaticOrder S; S.init(M, D, G, bid); \
            pg8::EpiBf16<0> E{(bf16*)(ws + WS_Y), D, 0}; \
            for (int rep_ = 0; rep_ < REP_G5; ++rep_) pg8::gemm_phase<pg8::EpiBf16<0>, pg8::StaticOrder, false, true>(lds, g, S, E, tid); \
            SEAM(p0 + 8); PT_END(8); \
        } \
        if (IN(p0 + 9)) { PT_BEG(9); \
            PH_BEGIN(); const float* modl = (const float*)(ws + WS_MOD) + (size_t)l * 2 * MODW; \
            const bool nh = (l + 1 < DEPTH); const float* modn = (const float*)(ws + WS_MOD) + (size_t)(nh ? l + 1 : l) * 2 * MODW; \
            norm_rows(args.out, args.out, (const bf16*)(ws + WS_Y), modl + 5 * D, args.in[7] + (size_t)l * D, nh, modn + 1 * D, modn + 0 * D, args.in[4] + (size_t)(nh ? l + 1 : l) * D, (bf16*)(ws + WS_H), bid * 8 + wave, G * 8, lane); \
            SEAM(p0 + 9); PT_END(9); \
        } \
    } while (0)
    LAYER_BODY(0); LAYER_BODY(1); LAYER_BODY(2); LAYER_BODY(3);
    if (PROBE_KIND >= 0 && bid0 == 0) { const unsigned long long t0 = __builtin_amdgcn_s_memrealtime(); while (__builtin_amdgcn_s_memrealtime() - t0 < pt_acc) __builtin_amdgcn_s_sleep(8); }
#undef IN
#undef SEAM
}

extern "C" void kernel_launch(void* const* d_in, const int* in_sizes, int n_in, void* d_out, int out_size, void* d_ws, size_t ws_size, hipStream_t stream) {
    static int grid = 0;
    if (grid == 0) {
        if (n_in != 23 || out_size != M * D || ws_size < WS_END) { fprintf(stderr, "kernel_launch: unexpected problem (n_in %d, out %d, ws %zu)\n", n_in, out_size, ws_size); grid = -1; return; }
        int dev = 0, cus = 0, per_cu = 0;
        if (hipGetDevice(&dev) != hipSuccess || hipDeviceGetAttribute(&cus, hipDeviceAttributeMultiprocessorCount, dev) != hipSuccess) { grid = -1; return; }
        if (hipFuncSetAttribute((const void*)fwd, hipFuncAttributeMaxDynamicSharedMemorySize, LDS_BYTES) != hipSuccess) { fprintf(stderr, "kernel_launch: hipFuncSetAttribute failed\n"); grid = -1; return; }
        if (hipOccupancyMaxActiveBlocksPerMultiprocessor(&per_cu, (const void*)fwd, 512, LDS_BYTES) != hipSuccess || per_cu < 1) fprintf(stderr, "kernel_launch: occupancy query says %d\n", per_cu);
        (void)hipGetLastError();
        grid = cus;
    }
    if (grid < 0) return;
    (void)hipMemsetAsync((char*)d_ws + WS_CTL, 0, CTL_ZERO_BYTES, stream);
    Args a{};
    for (int i = 0; i < 23; ++i) a.in[i] = (const float*)d_in[i];
    a.out = (float*)d_out; a.ws = (unsigned char*)d_ws;
#if MK_SINGLE_LAUNCH
    a.ph_lo = 0; a.ph_hi = N_PHASES;
    hipLaunchKernelGGL(fwd, dim3(grid), dim3(512), LDS_BYTES, stream, a);
#else
    for (int p = 0; p < N_PHASES; ++p) { a.ph_lo = p; a.ph_hi = p + 1; hipLaunchKernelGGL(fwd, dim3(grid), dim3(512), LDS_BYTES, stream, a); }
#endif
}
```
